# Optimizing an MI355X kernel written in HIP

```python
import math
import jax
import jax.numpy as jnp
from jax import lax
import numpy as np

D_MODEL = 2048
BATCH = 4
SEQ = 2048
DEPTH = 2

D_MIX = D_MODEL
S5_WIDTH = D_MIX // 4
S5_GROUP = 16
S5_GROUPS = S5_WIDTH // S5_GROUP
S5_STATE = 64
LRU_WIDTH = (D_MIX - S5_WIDTH) // 2
LRU_HEADS = 8
LRU_HEAD_DIM = LRU_WIDTH // LRU_HEADS
CONV_WIDTH = 4
LRU_C = 8.0
GLA_WIDTH = D_MIX - S5_WIDTH - LRU_WIDTH
GLA_HEADS = 4
GLA_DV = GLA_WIDTH // GLA_HEADS
GLA_DK = GLA_DV // 2
GLA_GATE_RANK = 16
GLA_TAU = 16.0
GLA_CHUNK = 64
D_FF = 256 * ((8 * D_MODEL // 3 + 255) // 256)
N_EXPERTS = 8
TOP_K = 2
D_FF_EXPERT = 7 * D_MODEL // 2
N_ADA = 6
EPS = 1e-6
IN_SIZES = (S5_WIDTH, LRU_WIDTH, LRU_WIDTH, GLA_HEADS * GLA_DK, GLA_HEADS * GLA_DK, GLA_WIDTH, GLA_GATE_RANK, GLA_WIDTH)
D_IN = sum(IN_SIZES)
IN_SPLITS = tuple(int(v) for v in np.cumsum(IN_SIZES)[:-1])

kernel_name = "hybrid_s5_rglru_gla_moe_adaln"

F32 = jnp.float32


def rmsnorm(x, g):
    xf = x.astype(F32)
    y = xf * lax.rsqrt(jnp.mean(xf * xf, axis=-1, keepdims=True) + EPS)
    return (y * g.astype(F32)).astype(x.dtype)


def s5_mixer(u, a_re, a_im, log_dt, b_re, b_im, c_re, c_im, d_skip, w_glu, b_glu):
    bsz, s, _ = u.shape
    ar = a_re.astype(F32)
    ai = a_im.astype(F32)
    dt = jnp.exp(log_dt.astype(F32))[:, None]
    mag = jnp.exp(ar * dt)
    abar_re = mag * jnp.cos(ai * dt)
    abar_im = mag * jnp.sin(ai * dt)
    nr = abar_re - 1.0
    ni = abar_im
    den = ar * ar + ai * ai
    f_re = (nr * ar + ni * ai) / den
    f_im = (ni * ar - nr * ai) / den
    br = b_re.astype(F32)
    bi = b_im.astype(F32)
    bbar_re = f_re[..., None] * br - f_im[..., None] * bi
    bbar_im = f_re[..., None] * bi + f_im[..., None] * br
    ug = u.astype(F32).reshape(bsz, s, S5_GROUPS, S5_GROUP)
    bu_re = jnp.einsum('bsgc,gpc->bsgp', ug, bbar_re)
    bu_im = jnp.einsum('bsgc,gpc->bsgp', ug, bbar_im)
    a_re_b = jnp.broadcast_to(abar_re, bu_re.shape)
    a_im_b = jnp.broadcast_to(abar_im, bu_im.shape)

    def combine(left, right):
        a1r, a1i, b1r, b1i = left
        a2r, a2i, b2r, b2i = right
        return (a2r * a1r - a2i * a1i,
                a2r * a1i + a2i * a1r,
                a2r * b1r - a2i * b1i + b2r,
                a2r * b1i + a2i * b1r + b2i)

    _, _, h_re, h_im = lax.associative_scan(combine, (a_re_b, a_im_b, bu_re, bu_im), axis=1)
    y = (jnp.einsum('bsgp,gcp->bsgc', h_re, c_re.astype(F32))
         - jnp.einsum('bsgp,gcp->bsgc', h_im, c_im.astype(F32))
         + d_skip.astype(F32).reshape(S5_GROUPS, S5_GROUP) * ug)
    z = jax.nn.gelu(y.reshape(bsz, s, S5_WIDTH))
    zz = z @ w_glu.astype(F32) + b_glu.astype(F32)
    val, gate = jnp.split(zz, 2, axis=-1)
    return val * jax.nn.sigmoid(gate)


def rglru_mixer(xb, gb, conv_w, conv_b, w_a, b_a, w_x, b_x, lam):
    bsz, s, _ = xb.shape
    xf = xb.astype(F32)
    xc = lax.conv_general_dilated(
        xf, conv_w.astype(F32)[:, None, :], window_strides=(1,),
        padding=[(CONV_WIDTH - 1, 0)], dimension_numbers=('NWC', 'WIO', 'NWC'),
        feature_group_count=LRU_WIDTH) + conv_b.astype(F32)
    xh = xc.reshape(bsz, s, LRU_HEADS, LRU_HEAD_DIM)
    r = jax.nn.sigmoid(jnp.einsum('bshi,hij->bshj', xh, w_a.astype(F32))
                       + b_a.astype(F32).reshape(LRU_HEADS, LRU_HEAD_DIM))
    i = jax.nn.sigmoid(jnp.einsum('bshi,hij->bshj', xh, w_x.astype(F32))
                       + b_x.astype(F32).reshape(LRU_HEADS, LRU_HEAD_DIM))
    log_a = LRU_C * r * jax.nn.log_sigmoid(lam.astype(F32)).reshape(LRU_HEADS, LRU_HEAD_DIM)
    a = jnp.exp(log_a)
    mult = jnp.sqrt(jnp.maximum(-jnp.expm1(2.0 * log_a), 0.0))
    bt = mult * i * xh

    def combine(left, right):
        a1, b1 = left
        a2, b2 = right
        return a2 * a1, a2 * b1 + b2

    _, h = lax.associative_scan(combine, (a.reshape(bsz, s, LRU_WIDTH), bt.reshape(bsz, s, LRU_WIDTH)), axis=1)
    return h * jax.nn.gelu(gb.astype(F32))


def gla_mixer(q, k, v, g_low, og, w_g2, b_g2, head_g):
    bsz, s, _ = q.shape
    n = s // GLA_CHUNK

    def blocks(t, d):
        return t.astype(F32).reshape(bsz, n, GLA_CHUNK, GLA_HEADS, d).transpose(0, 3, 1, 2, 4)

    qb = blocks(q, GLA_DK) * (GLA_DK ** -0.5)
    kb = blocks(k, GLA_DK)
    vb = blocks(v, GLA_DV)
    gate_logit = g_low.astype(F32) @ w_g2.astype(F32) + b_g2.astype(F32)
    log_alpha = blocks(jax.nn.log_sigmoid(gate_logit) / GLA_TAU, GLA_DK)
    bcum = jnp.cumsum(log_alpha, axis=3)
    b_last = bcum[:, :, :, -1:, :]
    q_dec = qb * jnp.exp(bcum)
    k_in = kb * jnp.exp(-bcum)
    k_out = kb * jnp.exp(b_last - bcum)
    causal = jnp.tril(jnp.ones((GLA_CHUNK, GLA_CHUNK), dtype=bool))
    att = jnp.where(causal, jnp.einsum('bhnid,bhnjd->bhnij', q_dec, k_in), 0.0)
    o_intra = jnp.einsum('bhnij,bhnjv->bhniv', att, vb)
    delta = jnp.einsum('bhncd,bhncv->nbhdv', k_out, vb)
    gamma = jnp.moveaxis(jnp.exp(b_last[:, :, :, 0, :]), 2, 0)

    def step(state, inp):
        gam, dlt = inp
        return gam[..., None] * state + dlt, state

    state0 = jnp.zeros((bsz, GLA_HEADS, GLA_DK, GLA_DV), F32)
    _, s_start = lax.scan(step, state0, (gamma, delta))
    o_inter = jnp.einsum('bhncd,nbhdv->bhncv', q_dec, s_start)
    o = (o_intra + o_inter).transpose(0, 2, 3, 1, 4).reshape(bsz, s, GLA_HEADS, GLA_DV)
    o = o * lax.rsqrt(jnp.mean(o * o, axis=-1, keepdims=True) + EPS) * head_g.astype(F32)
    return o.reshape(bsz, s, GLA_WIDTH) * jax.nn.silu(og.astype(F32))


def swiglu(h, w1, w3, w2):
    return (jax.nn.silu(h @ w1) * (h @ w3)) @ w2


def moe_swiglu(h, w_router, w1, w3, w2):
    bsz, s, d = h.shape
    hf = h.reshape(bsz * s, d)
    logits = hf.astype(F32) @ w_router.astype(F32)
    top_v, top_i = lax.top_k(logits, TOP_K)
    gates = jax.nn.softmax(top_v, axis=-1)
    combine = jnp.sum(jax.nn.one_hot(top_i, N_EXPERTS, dtype=F32) * gates[..., None], axis=1)
    out = jnp.zeros((bsz * s, d), F32)
    for e in range(N_EXPERTS):
        out = out + combine[:, e:e + 1] * swiglu(hf, w1[e], w3[e], w2[e]).astype(F32)
    return out.reshape(bsz, s, d).astype(h.dtype)


def setup_inputs(seed: int = 0) -> dict:
    key = jax.random.key(seed)
    ks = iter(jax.random.split(key, 64))

    def nrm(shape, scale):
        return jax.random.normal(next(ks), shape, F32) * scale

    def gain(shape):
        return 1.0 + 0.02 * jax.random.normal(next(ks), shape, F32)

    L = DEPTH
    ND = (DEPTH + 1) // 2
    NM = DEPTH // 2
    G, P = S5_GROUPS, S5_STATE
    x = nrm((BATCH, SEQ, D_MODEL), 1.0)
    c = nrm((BATCH, D_MODEL), 1.0)
    ada_w = nrm((L, D_MODEL, N_ADA * D_MODEL), 0.5 * D_MODEL ** -0.5)
    ada_b = nrm((L, N_ADA * D_MODEL), 0.02)
    norm_mix_g = gain((L, D_MODEL))
    norm_ffn_g = gain((L, D_MODEL))
    w_in = nrm((L, D_MODEL, D_IN), D_MODEL ** -0.5)
    s5_a_re = -0.5 + nrm((L, G, P), 0.01)
    s5_a_im = math.pi * jnp.arange(P, dtype=F32) + nrm((L, G, P), 0.01)
    s5_log_dt = jax.random.uniform(next(ks), (L, G), F32, math.log(1e-3), math.log(1e-1))
    s5_b_re = nrm((L, G, P, S5_GROUP), (2.0 * S5_GROUP) ** -0.5)
    s5_b_im = nrm((L, G, P, S5_GROUP), (2.0 * S5_GROUP) ** -0.5)
    s5_c_re = nrm((L, G, S5_GROUP, P), (2.0 * P) ** -0.5)
    s5_c_im = nrm((L, G, S5_GROUP, P), (2.0 * P) ** -0.5)
    s5_d = nrm((L, S5_WIDTH), 1.0)
    s5_w_glu = nrm((L, S5_WIDTH, 2 * S5_WIDTH), S5_WIDTH ** -0.5)
    s5_b_glu = nrm((L, 2 * S5_WIDTH), 0.02)
    s5_norm_g = gain((L, S5_WIDTH))
    lru_conv_w = nrm((L, CONV_WIDTH, LRU_WIDTH), CONV_WIDTH ** -0.5)
    lru_conv_b = nrm((L, LRU_WIDTH), 0.02)
    lru_w_a = nrm((L, LRU_HEADS, LRU_HEAD_DIM, LRU_HEAD_DIM), LRU_HEAD_DIM ** -0.5)
    lru_b_a = nrm((L, LRU_WIDTH), 0.02)
    lru_w_x = nrm((L, LRU_HEADS, LRU_HEAD_DIM, LRU_HEAD_DIM), LRU_HEAD_DIM ** -0.5)
    lru_b_x = nrm((L, LRU_WIDTH), 0.02)
    a_pow_c = jax.random.uniform(next(ks), (L, LRU_WIDTH), F32, 0.9, 0.999)
    a0 = a_pow_c ** (1.0 / LRU_C)
    lru_lambda = jnp.log(a0) - jnp.log1p(-a0)
    lru_norm_g = gain((L, LRU_WIDTH))
    gla_w_g2 = nrm((L, GLA_GATE_RANK, GLA_HEADS * GLA_DK), GLA_GATE_RANK ** -0.5)
    gla_b_g2 = nrm((L, GLA_HEADS * GLA_DK), 0.02)
    gla_head_g = gain((L, GLA_DV))
    w_out = nrm((L, D_MIX, D_MODEL), D_MIX ** -0.5)
    ffn_w1 = nrm((ND, D_MODEL, D_FF), D_MODEL ** -0.5)
    ffn_w3 = nrm((ND, D_MODEL, D_FF), D_MODEL ** -0.5)
    ffn_w2 = nrm((ND, D_FF, D_MODEL), D_FF ** -0.5)
    moe_router = nrm((NM, D_MODEL, N_EXPERTS), D_MODEL ** -0.5)
    moe_w1 = nrm((NM, N_EXPERTS, D_MODEL, D_FF_EXPERT), D_MODEL ** -0.5)
    moe_w3 = nrm((NM, N_EXPERTS, D_MODEL, D_FF_EXPERT), D_MODEL ** -0.5)
    moe_w2 = nrm((NM, N_EXPERTS, D_FF_EXPERT, D_MODEL), D_FF_EXPERT ** -0.5)
    final_norm_g = gain((D_MODEL,))
    return {"x": x, "c": c, "ada_w": ada_w, "ada_b": ada_b, "norm_mix_g": norm_mix_g,
            "norm_ffn_g": norm_ffn_g, "w_in": w_in,
            "s5_a_re": s5_a_re, "s5_a_im": s5_a_im, "s5_log_dt": s5_log_dt,
            "s5_b_re": s5_b_re, "s5_b_im": s5_b_im, "s5_c_re": s5_c_re, "s5_c_im": s5_c_im,
            "s5_d": s5_d, "s5_w_glu": s5_w_glu, "s5_b_glu": s5_b_glu, "s5_norm_g": s5_norm_g,
            "lru_conv_w": lru_conv_w, "lru_conv_b": lru_conv_b, "lru_w_a": lru_w_a,
            "lru_b_a": lru_b_a, "lru_w_x": lru_w_x, "lru_b_x": lru_b_x,
            "lru_lambda": lru_lambda, "lru_norm_g": lru_norm_g,
            "gla_w_g2": gla_w_g2, "gla_b_g2": gla_b_g2, "gla_head_g": gla_head_g,
            "w_out": w_out, "ffn_w1": ffn_w1, "ffn_w3": ffn_w3, "ffn_w2": ffn_w2,
            "moe_router": moe_router, "moe_w1": moe_w1, "moe_w3": moe_w3, "moe_w2": moe_w2,
            "final_norm_g": final_norm_g}


def reference(x, c, ada_w, ada_b, norm_mix_g, norm_ffn_g, w_in,
              s5_a_re, s5_a_im, s5_log_dt, s5_b_re, s5_b_im, s5_c_re, s5_c_im,
              s5_d, s5_w_glu, s5_b_glu, s5_norm_g,
              lru_conv_w, lru_conv_b, lru_w_a, lru_b_a, lru_w_x, lru_b_x, lru_lambda, lru_norm_g,
              gla_w_g2, gla_b_g2, gla_head_g, w_out,
              ffn_w1, ffn_w3, ffn_w2, moe_router, moe_w1, moe_w3, moe_w2, final_norm_g):
    bsz = x.shape[0]
    cs = jax.nn.silu(c)
    for l in range(DEPTH):
        mod = (cs @ ada_w[l] + ada_b[l]).reshape(bsz, N_ADA, 1, D_MODEL)
        shift1, scale1, gate1, shift2, scale2, gate2 = (mod[:, i] for i in range(N_ADA))
        h = rmsnorm(x, norm_mix_g[l]) * (1.0 + scale1) + shift1
        proj = h @ w_in[l]
        u_s5, x_lru, g_lru, q, k, v, g_low, og = jnp.split(proj, IN_SPLITS, axis=-1)
        y_s5 = rmsnorm(s5_mixer(u_s5, s5_a_re[l], s5_a_im[l], s5_log_dt[l], s5_b_re[l], s5_b_im[l],
                                s5_c_re[l], s5_c_im[l], s5_d[l], s5_w_glu[l], s5_b_glu[l]), s5_norm_g[l])
        y_lru = rmsnorm(rglru_mixer(x_lru, g_lru, lru_conv_w[l], lru_conv_b[l], lru_w_a[l], lru_b_a[l],
                                    lru_w_x[l], lru_b_x[l], lru_lambda[l]), lru_norm_g[l])
        y_gla = gla_mixer(q, k, v, g_low, og, gla_w_g2[l], gla_b_g2[l], gla_head_g[l])
        mix = jnp.concatenate([y_s5, y_lru, y_gla], axis=-1).astype(x.dtype) @ w_out[l]
        x = x + gate1 * mix
        h = rmsnorm(x, norm_ffn_g[l]) * (1.0 + scale2) + shift2
        if l % 2 == 0:
            f = swiglu(h, ffn_w1[l // 2], ffn_w3[l // 2], ffn_w2[l // 2])
        else:
            f = moe_swiglu(h, moe_router[l // 2], moe_w1[l // 2], moe_w3[l // 2], moe_w2[l // 2])
        x = x + gate2 * f
    return rmsnorm(x, final_norm_g)
```

```cpp
#include <hip/hip_runtime.h>
#include <cstdio>
#include <cstdint>

#ifndef N_LAUNCH_MODE
#define N_LAUNCH_MODE 0
#endif
#ifndef DBG_OUTSCALE
#define DBG_OUTSCALE 1.0f
#endif

#define DI __device__ __forceinline__
#define GAS __attribute__((address_space(1)))
#define LAS __attribute__((address_space(3)))
typedef unsigned short bf16;
typedef float f32x4 __attribute__((ext_vector_type(4)));
typedef float f32x2 __attribute__((ext_vector_type(2)));
typedef short bf16x8 __attribute__((ext_vector_type(8)));
typedef unsigned u32x4 __attribute__((ext_vector_type(4)));
typedef unsigned u32x2 __attribute__((ext_vector_type(2)));

constexpr int DM = 2048, NBATCH = 4, SEQ = 2048, T = NBATCH * SEQ, DEPTH = 2;
constexpr int DIN_SRC = 4368;
constexpr int PROJ_LD = 4608;
constexpr int C_U = 0, C_XL = 512, C_GL = 1280, C_Q = 2048, C_K = 2432, C_V = 2816, C_OG = 3584, C_GLOW = 4352;
constexpr int DFF = 5632, DFFE = 7168, NE = 8;
constexpr int NADA = 6;
constexpr float EPS = 1e-6f;
constexpr int MOE_ROWS = 18432;
constexpr int NWAVES = 8, NTHREADS = 512;
constexpr float SC_X = 16.f, SC_W13 = 256.f, SC_H = 16.f, SC_W2 = 512.f;

constexpr size_t MiB = 1u << 20;
constexpr size_t WS_CTL = 0, CTL_BYTES = 1 * MiB;
constexpr size_t WS_MOD = 1 * MiB;
constexpr size_t WS_S5C = 2 * MiB;
constexpr size_t S5C_STRIDE = 512 * 1024, S5C_ABAR = 0, S5C_ABARL = 16384, S5C_BBAR = 32768, S5C_CMAT = 32768 + 131072;
constexpr size_t WS_LRUW = 3 * MiB;
constexpr size_t LRUW_STRIDE = 512 * 1024, LRUW_X = 147456;
constexpr size_t WS_S5E = 4 * MiB;
constexpr size_t WS_ROUTE = 6 * MiB;
constexpr size_t WS_CNTBLK = 6 * MiB + 512 * 1024;
constexpr size_t WS_GAMMA = 7 * MiB;
constexpr size_t WS_WIN = 8 * MiB;
constexpr size_t WS_WOUT = 44 * MiB;
constexpr size_t WS_WGLU = 60 * MiB;
constexpr size_t WS_F13 = 62 * MiB;
constexpr size_t WS_F2 = 106 * MiB;
constexpr size_t WS_M13 = 128 * MiB;
constexpr size_t WS_M2 = 576 * MiB;
constexpr size_t WS_H = 800 * MiB;
constexpr size_t WS_PROJ = 832 * MiB;
constexpr size_t WS_LRUA = 904 * MiB;
constexpr size_t WS_LRUB = 928 * MiB;
constexpr size_t WS_GLAD = 952 * MiB;
constexpr size_t WS_Z = 988 * MiB;
constexpr size_t WS_S5PRE = 996 * MiB;
constexpr size_t WS_MIX = 1012 * MiB;
constexpr size_t WS_X1 = 1044 * MiB;
constexpr size_t WS_XCUR = 1108 * MiB;
constexpr size_t WS_HID = 1172 * MiB;
constexpr size_t WS_AS = 1424 * MiB;
constexpr size_t WS_Y = 1496 * MiB;
constexpr size_t WS_GLAS = WS_HID;
constexpr size_t WS_GLABC = WS_HID + 32 * MiB;
constexpr size_t WS_END = 1640 * MiB;

constexpr int CW_CNT = 64;
constexpr int CW_BAR = 4096;

constexpr int SCR_BYTES = 143360;
constexpr int LDSCTL_OFF = SCR_BYTES;
constexpr int LDS_BYTES = 147456;

#define LDS_WAIT() asm volatile("s_waitcnt lgkmcnt(0)" ::: "memory")
#define VM_WAIT() asm volatile("s_waitcnt vmcnt(0)" ::: "memory")
DI int lane_id() { unsigned m = ~0u; asm volatile("" : "+s"(m)); return (int)__builtin_amdgcn_mbcnt_hi(m, __builtin_amdgcn_mbcnt_lo(m, 0u)); }
DI unsigned pk_bf16(float lo, float hi) { unsigned r; asm("v_cvt_pk_bf16_f32 %0, %1, %2" : "=v"(r) : "v"(lo), "v"(hi)); return r; }
DI bf16 f2bf(float f) { return (bf16)(pk_bf16(f, 0.f) & 0xffffu); }
DI bf16 f2bf_sw(float f) { unsigned u = __builtin_bit_cast(unsigned, f); return (bf16)((u + 0x7fffu + ((u >> 16) & 1u)) >> 16); }
DI float bf2f(unsigned b) { return __builtin_bit_cast(float, b << 16); }
DI float bflo(unsigned w) { return __builtin_bit_cast(float, w << 16); }
DI float bfhi(unsigned w) { return __builtin_bit_cast(float, w & 0xffff0000u); }
template <int O> DI float xor_add(float v) { return v + __builtin_bit_cast(float, __builtin_amdgcn_ds_swizzle(__builtin_bit_cast(int, v), (O << 10) | 0x1f)); }
DI float half_sum(float v) { v = xor_add<1>(v); v = xor_add<2>(v); v = xor_add<4>(v); v = xor_add<8>(v); v = xor_add<16>(v); return v; }
DI float wave_sum(float v) {
    v = half_sum(v);
    return __builtin_bit_cast(float, __builtin_amdgcn_readlane(__builtin_bit_cast(int, v), 0)) + __builtin_bit_cast(float, __builtin_amdgcn_readlane(__builtin_bit_cast(int, v), 32));
}
DI float sigmoidf_(float x) { return __builtin_amdgcn_rcpf(1.f + __expf(-x)); }
DI float siluf_(float x) { return x * __builtin_amdgcn_rcpf(1.f + __expf(-x)); }
DI float gelu_tanh(float y) { const float u = 1.5957691216057308f * (y + 0.044715f * y * y * y); return y * __builtin_amdgcn_rcpf(1.f + __expf(-u)); }
DI float logsigmoidf_(float x) { return fminf(x, 0.f) - log1pf(__expf(-fabsf(x))); }
DI float logsigmoid_fast(float x) { return fminf(x, 0.f) - __logf(1.f + __expf(-fabsf(x))); }

#define XB_TMO      128
#define XB_XCNT(j)  (256  + 64 * (j))
#define XB_XSUB(j)  (1280 + 64 * (j))
#define XB_XGEN(j)  (2304 + 64 * (j))
#define XB_TOP      3328
#define XB_TOPGEN   3392
#define XCD_BAR_WORDS 3456
#define XB_SPIN_CAP (1u << 18)
__device__ __forceinline__ unsigned xb_ld(unsigned* p)              { return __hip_atomic_load(p, __ATOMIC_RELAXED, __HIP_MEMORY_SCOPE_AGENT); }
__device__ __forceinline__ unsigned xb_add(unsigned* p, unsigned v) { asm volatile("" : "+s"(v)); return __hip_atomic_fetch_add(p, v, __ATOMIC_RELAXED, __HIP_MEMORY_SCOPE_AGENT); }
__device__ __forceinline__ unsigned xb_xcc_id() { return (unsigned)__builtin_amdgcn_s_getreg((3 << 11) | 20) & 0xFu; }
#define XB_SPIN(cond, bar) do { unsigned _sp = 0; while (cond) { __builtin_amdgcn_s_sleep(1); \
    if ((++_sp & 255u) == 0u) { if (xb_ld(&(bar)[XB_TMO])) break; if (_sp > XB_SPIN_CAP) { atomicAdd(&(bar)[XB_TMO], 1u); break; } } } } while (0)
struct XcdBarrier { unsigned* bar; unsigned x; volatile LAS unsigned* st; int wave; };
__device__ __forceinline__ XcdBarrier xcd_barrier_post(unsigned* bar, volatile LAS unsigned* st, int wave) {
    XcdBarrier b; b.bar = bar; b.x = xb_xcc_id(); b.st = st; b.wave = wave;
    if (wave == 0 && lane_id() == 0) (void)xb_add(&bar[XB_XCNT(b.x)], 1u);
    return b;
}
__device__ __forceinline__ void xcd_barrier_complete(unsigned* bar, unsigned x, unsigned& nloc, unsigned& nx) {
    const unsigned G = gridDim.x * gridDim.y * gridDim.z;
    unsigned sum, cnt, mine, sp = 0u;
    for (;;) {
        sum = 0u; cnt = 0u; mine = 0u;
#pragma unroll
        for (unsigned j = 0; j < 16; ++j) { const unsigned c = xb_ld(&bar[XB_XCNT(j)]); sum += c; cnt += (c > 0u) ? 1u : 0u; mine = (j == x) ? c : mine; }
        if (sum == G) break;
        __builtin_amdgcn_s_sleep(1);
        if ((++sp & 255u) == 0u) { if (xb_ld(&bar[XB_TMO])) break; if (sp > XB_SPIN_CAP) { atomicAdd(&bar[XB_TMO], 1u); break; } }
    }
    nloc = mine > 0u ? mine : 1u; nx = cnt > 0u ? cnt : 1u;
}
__device__ __forceinline__ void xcd_barrier(const XcdBarrier& b) {
    asm volatile("s_waitcnt vmcnt(0)" ::: "memory");
    __syncthreads();
    if (b.wave == 0 && lane_id() == 0) {
        unsigned* bar = b.bar;
        __builtin_amdgcn_s_waitcnt(0);
        unsigned nloc = b.st[0], nx = b.st[1];
        if (nloc == 0u) { xcd_barrier_complete(bar, b.x, nloc, nx); b.st[0] = nloc; b.st[1] = nx; }
        const unsigned old = xb_add(&bar[XB_XSUB(b.x)], 1u);
        const unsigned gen = old / nloc;
        if (old + 1u == (gen + 1u) * nloc) {
            __builtin_amdgcn_fence(__ATOMIC_RELEASE, "agent");
            asm volatile("s_waitcnt vmcnt(0)" ::: "memory");
            const unsigned og = xb_add(&bar[XB_TOP], 1u);
            const unsigned tg = og / nx;
            if (og + 1u == (tg + 1u) * nx) xb_add(&bar[XB_TOPGEN], 1u);
            else XB_SPIN(xb_ld(&bar[XB_TOPGEN]) == tg, bar);
            __builtin_amdgcn_fence(__ATOMIC_ACQUIRE, "agent");
            xb_add(&bar[XB_XGEN(b.x)], 1u);
            asm volatile("s_waitcnt vmcnt(0)" ::: "memory");
        } else {
            XB_SPIN(xb_ld(&bar[XB_XGEN(b.x)]) == gen, bar);
            __builtin_amdgcn_fence(__ATOMIC_ACQUIRE, "agent");
            asm volatile("s_waitcnt vmcnt(0)" ::: "memory");
        }
    }
    __syncthreads();
}

namespace pg8 {
constexpr int BM = 256, BK = 64, HALF = 128, HTB = HALF * BK * 2, STAGE_BYTES = 8 * HTB, NXCD = 8, WGM = 8;
__host__ __device__ __forceinline__ int lds_byte(int r, int c) { const int st = (r >> 4) * 2 + (c >> 5), rr = r & 15, cc = c & 31, ob = rr * 64 + cc * 2; return st * 1024 + (ob ^ (((ob >> 9) & 1) << 5)); }
__host__ __device__ __forceinline__ void stage_rc(int b_, int& R, int& C) { const unsigned b = (unsigned)b_, st = b >> 10, sb = b & 1023u, swz = sb ^ (((sb >> 9) & 1u) << 5); R = (int)((st >> 1) * 16u + (swz >> 6)); C = (int)((st & 1u) * 32u + ((swz & 63u) >> 1)); }
__host__ __device__ __forceinline__ int perm32(int rho) { const int n = rho >> 4, i = rho & 15; return 8 * (i >> 2) + 4 * n + (i & 3); }

struct Unit { int pm, pn; long boff; int q; };
struct Gemm { const bf16* A; const bf16* Bt; int K; };

__device__ __forceinline__ int xcd_remap(int wgid, int nwg) { const int q = nwg / NXCD, r = nwg % NXCD, xcd = wgid % NXCD, off = wgid / NXCD; return (xcd < r ? xcd * (q + 1) : r * (q + 1) + (xcd - r) * q) + off; }
struct StaticOrder {
    int nM, nN, nwg, G, c;
    __device__ void init(int M, int N, int G_, int c_) { nM = M / BM; nN = N / BM; nwg = nM * nN; G = G_; c = c_; }
    __device__ bool next(int i, Unit& u) const {
        const long L = (long)i * G + c; if (L >= nwg) return false;
        const int wgid = xcd_remap((int)L, nwg);
        const int nig = WGM * nN, gid = wgid / nig, fm = gid * WGM, gsz = (nM - fm) < WGM ? (nM - fm) : WGM;
        u.pm = fm + ((wgid % nig) % gsz); u.pn = (wgid % nig) / gsz; u.boff = 0; return true;
    }
};
struct GroupedOrder {
    volatile LAS unsigned* ts; int nN, nwg, lim, G, c; long estride;
    __device__ void init(volatile LAS unsigned* ts_, int N, int G_, int c_, long estride_, int lim_ = 1 << 30) { ts = ts_; nN = N / BM; nwg = __builtin_amdgcn_readfirstlane((int)ts_[8] * nN); lim = nwg < lim_ ? nwg : lim_; G = G_; c = c_; estride = estride_; }
    __device__ bool next(int i, Unit& u) const {
        const long L = (long)i * G + c; if (L >= lim) return false;
        const int wgid = xcd_remap((int)L, nwg);
        int e = 0;
#pragma unroll
        for (int k = 1; k < 8; ++k) if (wgid >= (int)ts[k] * nN) e = k;
        const int t0 = (int)ts[e], te = (int)ts[e + 1] - t0, Lp = wgid - t0 * nN;
        u.pn = __builtin_amdgcn_readfirstlane(Lp / te); u.pm = __builtin_amdgcn_readfirstlane(t0 + Lp % te); u.boff = (long)__builtin_amdgcn_readfirstlane(e) * estride; return true;
    }
};

struct TailOrder {
    volatile LAS unsigned* ts; int nN, nwg, first, G, c; long estride, qstride;
    __device__ void init(volatile LAS unsigned* ts_, int N, int first_, int G_, int c_, long estride_, long qstride_) { ts = ts_; nN = N / BM; nwg = __builtin_amdgcn_readfirstlane((int)ts_[8] * nN); first = first_; G = G_; c = c_; estride = estride_; qstride = qstride_; }
    __device__ bool next(int i, Unit& u) const {
        const int s = i * G + c, L = first + (s & 7) + 8 * (s >> 5), q = (s >> 3) & 3;
        if (L >= nwg) return false;
        const int wgid = xcd_remap(L, nwg);
        int e = 0;
#pragma unroll
        for (int k = 1; k < 8; ++k) if (wgid >= (int)ts[k] * nN) e = k;
        const int t0 = (int)ts[e], te = (int)ts[e + 1] - t0, Lp = wgid - t0 * nN;
        u.pn = __builtin_amdgcn_readfirstlane(Lp / te); u.pm = __builtin_amdgcn_readfirstlane(t0 + Lp % te); u.q = q; u.boff = (long)__builtin_amdgcn_readfirstlane(e) * estride + (long)q * qstride; return true;
    }
};

__device__ __forceinline__ void glds16(const char* sbase, unsigned voff, unsigned m0v) {
    unsigned keep;
    asm volatile("s_mov_b32 %0, m0\n\ts_mov_b32 m0, %3\n\ts_nop 0\n\tglobal_load_lds_dwordx4 %1, %2\n\ts_mov_b32 m0, %0" : "=&s"(keep) : "v"(voff), "s"(sbase), "s"(m0v) : "memory");
}
template <class Epi, class Sched>
__device__ __forceinline__ void gemm_phase(LAS unsigned char* lds, const Gemm g, const Sched& S, const Epi& E, const int wid) {
    int lane = lane_id(); asm volatile("" : "+v"(lane));
    const int tid = wid * 64 + lane, wr = wid >> 2, wc = wid & 3, fr = lane & 15, fq = lane >> 4;
    const int K = g.K, nt = K / BK;
    unsigned voffA; { int R, C; stage_rc(tid * 16, R, C); voffA = (unsigned)(R * K + C) * 2u; }
    const size_t rstep = (size_t)64 * K * 2;
    const size_t kstep = (size_t)(BK * 2);
    const size_t hstep = (size_t)HALF * K * 2;
    const size_t tstep = 2 * hstep;
    const unsigned ldsb = (unsigned)(unsigned long)lds + (unsigned)wid * 1024u;
    const int aoff = lds_byte(wr * 64 + fr, fq * 8), boff = lds_byte(wc * 32 + fr, fq * 8);
#define PG8_SA(b, h) (((b) * 2 + (h)) * HTB)
#define PG8_SB(b, h) ((4 + (b) * 2 + (h)) * HTB)
#define PG8_STAGE(bufoff, gbase) do { _Pragma("unroll") for (int _i = 0; _i < 2; ++_i) glds16((const char*)(gbase) + _i * rstep, voffA, ldsb + (unsigned)((bufoff) + _i * 8192)); } while (0)
#define PG8_LDA(dst, b, h) do { _Pragma("unroll") for (int m = 0; m < 4; ++m) _Pragma("unroll") for (int k = 0; k < 2; ++k) dst[m][k] = *(const LAS bf16x8*)(lds + PG8_SA(b, h) + aoff + m * 2048 + k * 1024); } while (0)
#define PG8_LDB(dst, b, h) do { _Pragma("unroll") for (int n = 0; n < 2; ++n) _Pragma("unroll") for (int k = 0; k < 2; ++k) dst[n][k] = *(const LAS bf16x8*)(lds + PG8_SB(b, h) + boff + n * 2048 + k * 1024); } while (0)
#define PG8_MMA(ai, bj, At, Bt) do { __builtin_amdgcn_s_setprio(1); _Pragma("unroll") for (int m = 0; m < 4; ++m) _Pragma("unroll") for (int n = 0; n < 2; ++n) _Pragma("unroll") for (int k = 0; k < 2; ++k) \
        acc[ai][bj][m][n] = __builtin_amdgcn_mfma_f32_16x16x32_bf16(Bt[n][k], At[m][k], acc[ai][bj][m][n], 0, 0, 0); __builtin_amdgcn_s_setprio(0); } while (0)
#define PG8_WAIT_V(n) asm volatile("s_waitcnt vmcnt(" #n ")" ::: "memory")
#define PG8_WAIT_L(n) asm volatile("s_waitcnt lgkmcnt(" #n ")" ::: "memory")
#define PG8_BAR __builtin_amdgcn_s_barrier()
#define PG8_SCHED __builtin_amdgcn_sched_barrier(0)
    Unit cur, nxt; int ui = 0;
    if (!S.next(0, cur)) return;
    f32x4 acc[2][2][4][2];
#pragma unroll
    for (int a = 0; a < 2; ++a)
#pragma unroll
        for (int b = 0; b < 2; ++b)
#pragma unroll
            for (int m = 0; m < 4; ++m)
#pragma unroll
                for (int n = 0; n < 2; ++n) acc[a][b][m][n] = (f32x4){0.f, 0.f, 0.f, 0.f};
    bf16x8 At[4][2], B0[2][2], B1[2][2];
    const char* cA = (const char*)g.A + (size_t)cur.pm * tstep; const char* cB = (const char*)g.Bt + cur.boff + (size_t)cur.pn * tstep;
    PG8_STAGE(PG8_SB(0, 0), cB); PG8_STAGE(PG8_SB(0, 1), cB + hstep); PG8_STAGE(PG8_SA(0, 0), cA); PG8_STAGE(PG8_SA(0, 1), cA + hstep);
    if (wr == 1) PG8_BAR;
    PG8_WAIT_V(2); PG8_BAR;
    PG8_STAGE(PG8_SB(1, 0), cB + kstep); PG8_STAGE(PG8_SA(1, 0), cA + kstep); PG8_STAGE(PG8_SB(1, 1), cB + hstep + kstep);
    PG8_WAIT_V(6); PG8_BAR;
    for (;;) {
        const bool has_next = S.next(ui + 1, nxt);
        const char* nA = has_next ? (const char*)g.A + (size_t)nxt.pm * tstep : cA; const char* nB = has_next ? (const char*)g.Bt + nxt.boff + (size_t)nxt.pn * tstep : cB;
        for (int t = 0; t < nt; t += 2) {
            const bool last = (t == nt - 2);
            const char* a1 = cA + (size_t)(t + 1) * kstep;
            const char* a2 = last ? nA : cA + (size_t)(t + 2) * kstep; const char* b2 = last ? nB : cB + (size_t)(t + 2) * kstep;
            const char* a3 = a2 + kstep; const char* b3 = b2 + kstep;
            PG8_LDB(B0, 0, 0); PG8_LDB(B1, 0, 1); PG8_SCHED; PG8_LDA(At, 0, 0); PG8_STAGE(PG8_SA(1, 1), a1 + hstep);
            PG8_WAIT_V(8); PG8_WAIT_L(0); PG8_BAR; PG8_MMA(0, 0, At, B0); PG8_MMA(0, 1, At, B1); PG8_BAR; PG8_SCHED;
            PG8_LDA(At, 0, 1); PG8_STAGE(PG8_SB(0, 0), b2); PG8_STAGE(PG8_SB(0, 1), b2 + hstep); PG8_STAGE(PG8_SA(0, 0), a2);
            PG8_WAIT_V(8); PG8_WAIT_L(0); PG8_BAR; PG8_MMA(1, 0, At, B0); PG8_MMA(1, 1, At, B1); PG8_BAR; PG8_SCHED;
            PG8_LDB(B0, 1, 0); PG8_LDB(B1, 1, 1); PG8_SCHED; PG8_LDA(At, 1, 0); PG8_STAGE(PG8_SA(0, 1), a2 + hstep);
            PG8_WAIT_V(8); PG8_WAIT_L(0); PG8_BAR; PG8_MMA(0, 0, At, B0); PG8_MMA(0, 1, At, B1); PG8_BAR; PG8_SCHED;
            PG8_LDA(At, 1, 1); PG8_STAGE(PG8_SB(1, 0), b3); PG8_STAGE(PG8_SB(1, 1), b3 + hstep); PG8_STAGE(PG8_SA(1, 0), a3);
            PG8_WAIT_V(8); PG8_WAIT_L(0); PG8_BAR; PG8_MMA(1, 0, At, B0); PG8_MMA(1, 1, At, B1); PG8_BAR; PG8_SCHED;
        }
        { int lz = lane_id(); asm volatile("" : "+v"(lz)); E(acc, cur, wid >> 2, wid & 3, lz & 15, lz >> 4); }
        if (!has_next) break;
        { float z0 = 0.f; asm volatile("" : "+v"(z0));
#pragma unroll
        for (int a = 0; a < 2; ++a)
#pragma unroll
            for (int b = 0; b < 2; ++b)
#pragma unroll
                for (int m = 0; m < 4; ++m)
#pragma unroll
                    for (int n = 0; n < 2; ++n) acc[a][b][m][n] = (f32x4){z0, z0, z0, z0}; }
        cur = nxt; cA = nA; cB = nB; ++ui;
    }
    PG8_WAIT_V(0);
    if (wr == 0) PG8_BAR;
    PG8_BAR;
#undef PG8_SA
#undef PG8_SB
#undef PG8_STAGE
#undef PG8_LDA
#undef PG8_LDB
#undef PG8_MMA
#undef PG8_WAIT_V
#undef PG8_WAIT_L
#undef PG8_BAR
#undef PG8_SCHED
}

typedef int i32x8 __attribute__((ext_vector_type(8)));
typedef int i32x4 __attribute__((ext_vector_type(4)));
__device__ __forceinline__ i32x8 ld32(const LAS unsigned char* p) { const i32x4 a = *(const LAS i32x4*)p, b = *(const LAS i32x4*)(p + 1024); return __builtin_shufflevector(a, b, 0, 1, 2, 3, 4, 5, 6, 7); }
template <bool NARROW = false, class Epi, class Sched>
__device__ __forceinline__ void gemm_phase8(LAS unsigned char* lds, const Gemm g, const Sched& S, const Epi& E, const int wid) {
    int lane = lane_id(); asm volatile("" : "+v"(lane));
    const int tid = wid * 64 + lane, wr = wid >> 2, wc = wid & 3, fr = lane & 15, fq = lane >> 4;
    const int K = g.K, nt = K / BK;
    unsigned voffA; { int R, C; stage_rc(tid * 16, R, C); voffA = (unsigned)(R * K + C) * 2u; }
    const size_t rstep = (size_t)64 * K * 2;
    const size_t kstep = (size_t)(BK * 2);
    const size_t hstep = (size_t)HALF * K * 2;
    const size_t tstep = 2 * hstep;
    const size_t bh = NARROW ? 0 : hstep;
    const unsigned ldsb = (unsigned)(unsigned long)lds + (unsigned)wid * 1024u;
    const int aoff = lds_byte(wr * 64 + fr, fq * 8), boff = NARROW ? lds_byte(wc * 16 + fr, fq * 8) : lds_byte(wc * 32 + fr, fq * 8);
#define PG8_SA(b, h) (((b) * 2 + (h)) * HTB)
#define PG8_SB(b, h) ((4 + (b) * 2 + (h)) * HTB)
#define PG8_STAGE(bufoff, gbase) do { _Pragma("unroll") for (int _i = 0; _i < 2; ++_i) glds16((const char*)(gbase) + _i * rstep, voffA, ldsb + (unsigned)((bufoff) + _i * 8192)); } while (0)
#define PG8_LDA(dst, b, h) do { _Pragma("unroll") for (int m = 0; m < 4; ++m) dst[m] = ld32(lds + PG8_SA(b, h) + aoff + m * 2048); } while (0)
#define PG8_LDB(dst, b, h) do { _Pragma("unroll") for (int n = 0; n < (NARROW ? 1 : 2); ++n) dst[n] = ld32(lds + PG8_SB(b, h) + boff + n * 2048); } while (0)
#define PG8_MMA(ai, bj, At, Bt) do { __builtin_amdgcn_s_setprio(1); _Pragma("unroll") for (int m = 0; m < 4; ++m) _Pragma("unroll") for (int n = 0; n < (NARROW ? 1 : 2); ++n) \
        asm volatile("v_mfma_scale_f32_16x16x128_f8f6f4 %0, %1, %2, %0, %3, %3 op_sel_hi:[0,0,0]" : "+v"(acc[ai][bj][m][n]) : "v"(Bt[n]), "v"(At[m]), "v"(mxscale)); __builtin_amdgcn_s_setprio(0); } while (0)
#define PG8_WAIT_V(n) asm volatile("s_waitcnt vmcnt(" #n ")" ::: "memory")
#define PG8_WAIT_L(n) asm volatile("s_waitcnt lgkmcnt(" #n ")" ::: "memory")
#define PG8_BAR __builtin_amdgcn_s_barrier()
#define PG8_SCHED __builtin_amdgcn_sched_barrier(0)
    const int mxscale = 0x7F7F7F7F;
    Unit cur, nxt; int ui = 0;
    if (!S.next(0, cur)) return;
    f32x4 acc[2][2][4][2];
#pragma unroll
    for (int a = 0; a < 2; ++a)
#pragma unroll
        for (int b = 0; b < 2; ++b)
#pragma unroll
            for (int m = 0; m < 4; ++m)
#pragma unroll
                for (int n = 0; n < 2; ++n) acc[a][b][m][n] = (f32x4){0.f, 0.f, 0.f, 0.f};
    i32x8 At[4], B0[2], B1[2];
    const char* cA = (const char*)g.A + (size_t)cur.pm * tstep; const char* cB = (const char*)g.Bt + cur.boff + (size_t)cur.pn * tstep;
    PG8_STAGE(PG8_SB(0, 0), cB); PG8_STAGE(PG8_SB(0, 1), cB + bh); PG8_STAGE(PG8_SA(0, 0), cA); PG8_STAGE(PG8_SA(0, 1), cA + hstep);
    if (wr == 1) PG8_BAR;
    PG8_WAIT_V(2); PG8_BAR;
    PG8_STAGE(PG8_SB(1, 0), cB + kstep); PG8_STAGE(PG8_SA(1, 0), cA + kstep); PG8_STAGE(PG8_SB(1, 1), cB + bh + kstep);
    PG8_WAIT_V(6); PG8_BAR;
    for (;;) {
        const bool has_next = S.next(ui + 1, nxt);
        const char* nA = has_next ? (const char*)g.A + (size_t)nxt.pm * tstep : cA; const char* nB = has_next ? (const char*)g.Bt + nxt.boff + (size_t)nxt.pn * tstep : cB;
        for (int t = 0; t < nt; t += 2) {
            const bool last = (t == nt - 2);
            const char* a1 = cA + (size_t)(t + 1) * kstep;
            const char* a2 = last ? nA : cA + (size_t)(t + 2) * kstep; const char* b2 = last ? nB : cB + (size_t)(t + 2) * kstep;
            const char* a3 = a2 + kstep; const char* b3 = b2 + kstep;
            PG8_LDB(B0, 0, 0); if constexpr (!NARROW) PG8_LDB(B1, 0, 1); PG8_SCHED; PG8_LDA(At, 0, 0); PG8_STAGE(PG8_SA(1, 1), a1 + hstep);
            PG8_WAIT_V(8); PG8_WAIT_L(0); PG8_BAR; PG8_MMA(0, 0, At, B0); if constexpr (!NARROW) PG8_MMA(0, 1, At, B1); PG8_BAR; PG8_SCHED;
            PG8_LDA(At, 0, 1); PG8_STAGE(PG8_SB(0, 0), b2); PG8_STAGE(PG8_SB(0, 1), b2 + bh); PG8_STAGE(PG8_SA(0, 0), a2);
            PG8_WAIT_V(8); PG8_WAIT_L(0); PG8_BAR; PG8_MMA(1, 0, At, B0); if constexpr (!NARROW) PG8_MMA(1, 1, At, B1); PG8_BAR; PG8_SCHED;
            PG8_LDB(B0, 1, 0); if constexpr (!NARROW) PG8_LDB(B1, 1, 1); PG8_SCHED; PG8_LDA(At, 1, 0); PG8_STAGE(PG8_SA(0, 1), a2 + hstep);
            PG8_WAIT_V(8); PG8_WAIT_L(0); PG8_BAR; PG8_MMA(0, 0, At, B0); if constexpr (!NARROW) PG8_MMA(0, 1, At, B1); PG8_BAR; PG8_SCHED;
            PG8_LDA(At, 1, 1); PG8_STAGE(PG8_SB(1, 0), b3); PG8_STAGE(PG8_SB(1, 1), b3 + bh); PG8_STAGE(PG8_SA(1, 0), a3);
            PG8_WAIT_V(8); PG8_WAIT_L(0); PG8_BAR; PG8_MMA(1, 0, At, B0); if constexpr (!NARROW) PG8_MMA(1, 1, At, B1); PG8_BAR; PG8_SCHED;
        }
        if (wr == 0) PG8_BAR;
        asm volatile("s_nop 15\n\ts_nop 15" ::: "memory");
        { int lz = lane_id(); asm volatile("" : "+v"(lz)); E(acc, cur, wid >> 2, wid & 3, lz & 15, lz >> 4); }
        if (!has_next) break;
        { float z0 = 0.f; asm volatile("" : "+v"(z0));
#pragma unroll
        for (int a = 0; a < 2; ++a)
#pragma unroll
            for (int b = 0; b < 2; ++b)
#pragma unroll
                for (int m = 0; m < 4; ++m)
#pragma unroll
                    for (int n = 0; n < 2; ++n) acc[a][b][m][n] = (f32x4){z0, z0, z0, z0}; }
        cur = nxt; cA = nA; cB = nB; ++ui;
        if (wr == 1) PG8_BAR;
    }
    PG8_WAIT_V(0);
    PG8_BAR;
#undef PG8_SA
#undef PG8_SB
#undef PG8_STAGE
#undef PG8_LDA
#undef PG8_LDB
#undef PG8_MMA
#undef PG8_WAIT_V
#undef PG8_WAIT_L
#undef PG8_BAR
#undef PG8_SCHED
}

struct EpiBf16Perm {
    bf16* O; int ldc;
    __device__ __forceinline__ void operator()(const f32x4 (&acc)[2][2][4][2], const Unit& u, int wr, int wc, int fr, int fq) const {
        const int row0 = u.pm * BM + wr * 64 + fr, col0 = u.pn * BM + wc * 32 + 8 * fq;
#pragma unroll
        for (int ai = 0; ai < 2; ++ai)
#pragma unroll
            for (int m = 0; m < 4; ++m) { bf16* rowp = O + (size_t)(row0 + ai * HALF + m * 16) * ldc + col0;
#pragma unroll
                for (int bj = 0; bj < 2; ++bj) { const f32x4 v0 = acc[ai][bj][m][0], v1 = acc[ai][bj][m][1];
                    u32x4 w; w.x = pk_bf16(v0[0], v0[1]); w.y = pk_bf16(v0[2], v0[3]); w.z = pk_bf16(v1[0], v1[1]); w.w = pk_bf16(v1[2], v1[3]);
                    *(u32x4*)(rowp + bj * HALF) = w; } }
    }
};
struct EpiSwiglu {
    bf16* O; int ldo;
    __device__ __forceinline__ void operator()(const f32x4 (&acc)[2][2][4][2], const Unit& u, int wr, int wc, int fr, int fq) const {
        const int row0 = u.pm * BM + wr * 64 + fr, col0 = u.pn * HALF + wc * 16 + 4 * fq;
#pragma unroll
        for (int ai = 0; ai < 2; ++ai)
#pragma unroll
            for (int m = 0; m < 4; ++m) { bf16* rowp = O + (size_t)(row0 + ai * HALF + m * 16) * ldo + col0;
#pragma unroll
                for (int bj = 0; bj < 2; ++bj) { const f32x4 a = acc[ai][bj][m][0], b = acc[ai][bj][m][1];
                    u32x2 w; w.x = pk_bf16(siluf_(a[0]) * b[0], siluf_(a[1]) * b[1]); w.y = pk_bf16(siluf_(a[2]) * b[2], siluf_(a[3]) * b[3]);
                    *(u32x2*)(rowp + bj * 64) = w; } }
    }
};
DI unsigned pk4_fp8(float a, float b, float c, float d) {
    float cm = 448.f; asm volatile("" : "+s"(cm));
    a = __builtin_amdgcn_fmed3f(a, -cm, cm); b = __builtin_amdgcn_fmed3f(b, -cm, cm); c = __builtin_amdgcn_fmed3f(c, -cm, cm); d = __builtin_amdgcn_fmed3f(d, -cm, cm);
    int w = __builtin_amdgcn_cvt_pk_fp8_f32(a, b, 0, false); w = __builtin_amdgcn_cvt_pk_fp8_f32(c, d, w, true); return (unsigned)w; }
struct EpiSwiglu8 {
    unsigned char* O; int ldo; float inv, oscale;
    __device__ __forceinline__ void operator()(const f32x4 (&acc)[2][2][4][2], const Unit& u, int wr, int wc, int fr, int fq) const {
        const int row0 = u.pm * BM + wr * 64 + fr, col0 = u.pn * HALF + wc * 16 + 4 * fq;
#pragma unroll
        for (int ai = 0; ai < 2; ++ai)
#pragma unroll
            for (int m = 0; m < 4; ++m) { unsigned char* rowp = O + (size_t)(row0 + ai * HALF + m * 16) * ldo + col0;
#pragma unroll
                for (int bj = 0; bj < 2; ++bj) { const f32x4 a = acc[ai][bj][m][0] * inv, b = acc[ai][bj][m][1] * (inv * oscale);
                    *(unsigned*)(rowp + bj * 64) = pk4_fp8(siluf_(a[0]) * b[0], siluf_(a[1]) * b[1], siluf_(a[2]) * b[2], siluf_(a[3]) * b[3]); } }
    }
};
struct EpiGlu {
    float* O; const float* bias;
    __device__ __forceinline__ void operator()(const f32x4 (&acc)[2][2][4][2], const Unit& u, int wr, int wc, int fr, int fq) const {
        const int row0 = u.pm * BM + wr * 64 + fr, col0 = u.pn * HALF + wc * 16 + 4 * fq;
        f32x4 bv[2], bg[2];
#pragma unroll
        for (int bj = 0; bj < 2; ++bj) { bv[bj] = *(const f32x4*)(bias + col0 + bj * 64); bg[bj] = *(const f32x4*)(bias + 512 + col0 + bj * 64); }
#pragma unroll
        for (int ai = 0; ai < 2; ++ai)
#pragma unroll
            for (int m = 0; m < 4; ++m) { float* rowp = O + (size_t)(row0 + ai * HALF + m * 16) * 512 + col0;
#pragma unroll
                for (int bj = 0; bj < 2; ++bj) { const f32x4 a = acc[ai][bj][m][0] + bv[bj], b = acc[ai][bj][m][1] + bg[bj];
                    f32x4 o; o[0] = a[0] * sigmoidf_(b[0]); o[1] = a[1] * sigmoidf_(b[1]); o[2] = a[2] * sigmoidf_(b[2]); o[3] = a[3] * sigmoidf_(b[3]);
                    *(f32x4*)(rowp + bj * 64) = o; } }
    }
};
struct EpiResid {
    float* O; const float* X; const float* gate; float scale;
    __device__ __forceinline__ void operator()(const f32x4 (&acc)[2][2][4][2], const Unit& u, int wr, int wc, int fr, int fq) const {
        const int row0 = u.pm * BM + wr * 64 + fr, col0 = u.pn * BM + wc * 32 + 4 * fq;
        const float* gp = gate + (size_t)(u.pm >> 3) * (NADA * DM) + col0;
        f32x4 gv[2][2];
#pragma unroll
        for (int bj = 0; bj < 2; ++bj)
#pragma unroll
            for (int n = 0; n < 2; ++n) gv[bj][n] = *(const f32x4*)(gp + bj * HALF + n * 16) * scale;
#pragma unroll
        for (int ai = 0; ai < 2; ++ai)
#pragma unroll
            for (int m = 0; m < 4; ++m) { const size_t off = (size_t)(row0 + ai * HALF + m * 16) * DM + col0;
#pragma unroll
                for (int bj = 0; bj < 2; ++bj)
#pragma unroll
                    for (int n = 0; n < 2; ++n) { const f32x4 xv = *(const f32x4*)(X + off + bj * HALF + n * 16);
                        *(f32x4*)(O + off + bj * HALF + n * 16) = xv + gv[bj][n] * acc[ai][bj][m][n]; } }
    }
};
struct EpiOut {
    float* O; const float* X; const float* gate; float scale;
    __device__ __forceinline__ void operator()(const f32x4 (&acc)[2][2][4][2], const Unit& u, int wr, int wc, int fr, int fq) const {
        const int row0 = u.pm * BM + wr * 64 + fr, col0 = u.pn * BM + wc * 32 + 4 * fq;
        f32x4 gv[2][2];
        if (X) { const float* gp = gate + (size_t)(u.pm >> 3) * (NADA * DM) + col0;
#pragma unroll
            for (int bj = 0; bj < 2; ++bj)
#pragma unroll
                for (int n = 0; n < 2; ++n) gv[bj][n] = *(const f32x4*)(gp + bj * HALF + n * 16) * scale; }
        else {
#pragma unroll
            for (int bj = 0; bj < 2; ++bj)
#pragma unroll
                for (int n = 0; n < 2; ++n) gv[bj][n] = (f32x4){scale, scale, scale, scale}; }
#pragma unroll
        for (int ai = 0; ai < 2; ++ai)
#pragma unroll
            for (int m = 0; m < 4; ++m) { const size_t off = (size_t)(row0 + ai * HALF + m * 16) * DM + col0;
#pragma unroll
                for (int bj = 0; bj < 2; ++bj)
#pragma unroll
                    for (int n = 0; n < 2; ++n) { f32x4 o = gv[bj][n] * acc[ai][bj][m][n]; if (X) o += *(const f32x4*)(X + off + bj * HALF + n * 16);
                        *(f32x4*)(O + off + bj * HALF + n * 16) = o; } }
    }
};
struct EpiF32 {
    float* O; int ldc; float scale;
    __device__ __forceinline__ void operator()(const f32x4 (&acc)[2][2][4][2], const Unit& u, int wr, int wc, int fr, int fq) const {
        const int row0 = u.pm * BM + wr * 64 + fr, col0 = u.pn * BM + wc * 32 + 4 * fq;
#pragma unroll
        for (int ai = 0; ai < 2; ++ai)
#pragma unroll
            for (int m = 0; m < 4; ++m) { float* rowp = O + (size_t)(row0 + ai * HALF + m * 16) * ldc + col0;
#pragma unroll
                for (int bj = 0; bj < 2; ++bj)
#pragma unroll
                    for (int n = 0; n < 2; ++n) *(f32x4*)(rowp + bj * HALF + n * 16) = acc[ai][bj][m][n] * scale; }
    }
};
struct EpiF32Narrow {
    float* O; int ldc; float scale;
    __device__ __forceinline__ void operator()(const f32x4 (&acc)[2][2][4][2], const Unit& u, int wr, int wc, int fr, int fq) const {
        const int row0 = u.pm * BM + wr * 64 + fr, col0 = u.pn * BM + 64 * u.q + wc * 16 + 4 * fq;
#pragma unroll
        for (int ai = 0; ai < 2; ++ai)
#pragma unroll
            for (int m = 0; m < 4; ++m) *(f32x4*)(O + (size_t)(row0 + ai * HALF + m * 16) * ldc + col0) = acc[ai][0][m][0] * scale;
    }
};
}

struct Args { const float* in[38]; float* out; unsigned char* ws; unsigned long long hoff, hbytes; int ph_lo, ph_hi, li, pad; };
enum { I_X = 0, I_C, I_ADAW, I_ADAB, I_NMIXG, I_NFFNG, I_WIN, I_S5ARE, I_S5AIM, I_S5LOGDT, I_S5BRE, I_S5BIM, I_S5CRE, I_S5CIM, I_S5D, I_S5WGLU, I_S5BGLU, I_S5NG,
       I_LCONVW, I_LCONVB, I_LWA, I_LBA, I_LWX, I_LBX, I_LLAM, I_LNG, I_GWG2, I_GBG2, I_GHG, I_WOUT, I_F1, I_F3, I_F2, I_ROUTER, I_M1, I_M3, I_M2, I_FNG };

#define GAS __attribute__((address_space(1)))
template <class T> DI T* as_global(T* p) { return (T*)(GAS T*)p; }
DI const float* INP(const Args& a, int i) { asm volatile("" : "+s"(i)); return as_global(a.in[i]); }
struct Frame {
    LAS unsigned char* lds;
    volatile LAS unsigned* MISC;
    unsigned* ctl;
    GAS unsigned char* ws;
    int tid, lane, wave, G, bid;
};

DI void conv_item(const float* src0, const float* src1, int ldsrc, int K, bf16* dst, int kb, int pb, int mode, LAS float* scr, int lane) {
    const int p = pb * 64 + lane, g = p >> 5, rho = p & 31, n = rho >> 4, i = rho & 15;
    const float* sp = src0; bool valid = true;
    if (mode == 0) sp = src0 + p;
    else if (mode == 1) { const int lc = (g << 5) + pg8::perm32(rho); const int sc = lc < 3584 ? lc : (lc < 4352 ? lc + 16 : (lc < 4368 ? lc - 4352 + 3584 : -1)); valid = sc >= 0; sp = src0 + (valid ? sc : 0); }
    else if (mode == 2) sp = (n ? src1 : src0) + 16 * g + i;
    else sp = src0 + n * 512 + 16 * g + i;
    const int k0 = kb * 64;
    sp += (size_t)k0 * ldsrc;
#pragma unroll 16
    for (int kk = 0; kk < 64; ++kk) { const float v = valid ? sp[(size_t)kk * ldsrc] : 0.f; scr[kk * 65 + lane] = v; }
    LDS_WAIT();
    const int c = lane & 7;
#pragma unroll
    for (int j = 0; j < 8; ++j) { const int rr = (lane >> 3) + 8 * j; const LAS float* s = scr + (8 * c) * 65 + rr;
        u32x4 o; o.x = pk_bf16(s[0 * 65], s[1 * 65]); o.y = pk_bf16(s[2 * 65], s[3 * 65]); o.z = pk_bf16(s[4 * 65], s[5 * 65]); o.w = pk_bf16(s[6 * 65], s[7 * 65]);
        *(u32x4*)(dst + (size_t)(pb * 64 + rr) * K + k0 + 8 * c) = o; }
    LDS_WAIT();
}

template <bool GATED>
DI void conv_item8(const float* src0, const float* src1, int ldsrc, int K8, unsigned char* dst, int kb, int cb, float scale, LAS unsigned* scr, int lane) {
    constexpr int NC = GATED ? 128 : 64, ST = NC + 1;
    const int k0 = kb * 128;
    const float* p0 = src0 + (size_t)k0 * ldsrc + 64 * cb + lane;
    const float* p1 = GATED ? src1 + (size_t)k0 * ldsrc + 64 * cb + lane : src0;
#pragma unroll 4
    for (int kq = 0; kq < 32; ++kq) {
        const float* r0 = p0 + (size_t)(4 * kq) * ldsrc;
        scr[kq * ST + lane] = pg8::pk4_fp8(r0[0] * scale, r0[ldsrc] * scale, r0[2 * (size_t)ldsrc] * scale, r0[3 * (size_t)ldsrc] * scale);
        if (GATED) { const float* r1 = p1 + (size_t)(4 * kq) * ldsrc;
            scr[kq * ST + 64 + lane] = pg8::pk4_fp8(r1[0] * scale, r1[ldsrc] * scale, r1[2 * (size_t)ldsrc] * scale, r1[3 * (size_t)ldsrc] * scale); }
    }
    LDS_WAIT();
    const int c = lane & 7;
#pragma unroll
    for (int j = 0; j < NC / 8; ++j) { const int rr = (lane >> 3) + 8 * j;
        const int col = GATED ? (((rr >> 4) & 1) * 64 + (rr >> 5) * 16 + (rr & 15)) : rr;
        const LAS unsigned* q = scr + (4 * c) * ST + col;
        u32x4 o; o.x = q[0]; o.y = q[ST]; o.z = q[2 * ST]; o.w = q[3 * ST];
        *(u32x4*)(dst + (size_t)(NC * cb + rr) * K8 + k0 + 16 * c) = o; }
    LDS_WAIT();
}

DI void sincos_d(double x, double& s, double& c) {
    const double k = rint(x * 0.63661977236758134308);
    const double r = fma(-k, 6.123233995736766e-17, fma(-k, 1.5707963267948966, x));
    const double r2 = r * r;
    double sp = -1.0 / 1307674368000.0;
    sp = fma(sp, r2, 1.0 / 6227020800.0); sp = fma(sp, r2, -1.0 / 39916800.0); sp = fma(sp, r2, 1.0 / 362880.0); sp = fma(sp, r2, -1.0 / 5040.0); sp = fma(sp, r2, 1.0 / 120.0); sp = fma(sp, r2, -1.0 / 6.0); sp = fma(sp, r2, 1.0);
    const double sr = sp * r;
    double cp = 1.0 / 20922789888000.0;
    cp = fma(cp, r2, -1.0 / 87178291200.0); cp = fma(cp, r2, 1.0 / 479001600.0); cp = fma(cp, r2, -1.0 / 3628800.0); cp = fma(cp, r2, 1.0 / 40320.0); cp = fma(cp, r2, -1.0 / 720.0); cp = fma(cp, r2, 1.0 / 24.0); cp = fma(cp, r2, -0.5); cp = fma(cp, r2, 1.0);
    const int q = ((int)k) & 3;
    s = (q == 0) ? sr : (q == 1) ? cp : (q == 2) ? -sr : -cp;
    c = (q == 0) ? cp : (q == 1) ? -sr : (q == 2) ? -cp : sr;
}

DI void p0_s5_consts(const Frame& F, const Args& a) {
    const int gt = F.bid * NTHREADS + F.tid;
    if (gt >= DEPTH * 32 * 64) return;
    const int l = gt >> 11, g = (gt >> 6) & 31, p = gt & 63;
    unsigned char* base = (unsigned char*)(F.ws + WS_S5C + (size_t)l * S5C_STRIDE);
    const double ar = INP(a, I_S5ARE)[(l * 32 + g) * 64 + p], ai = INP(a, I_S5AIM)[(l * 32 + g) * 64 + p];
    const double dt = exp((double)INP(a, I_S5LOGDT)[l * 32 + g]);
    const double mag = exp(ar * dt); double sn, cs; sincos_d(ai * dt, sn, cs);
    const double abr = mag * cs, abi = mag * sn;
    const double nr = abr - 1.0, ni = abi, den = ar * ar + ai * ai;
    const double fre = (nr * ar + ni * ai) / den, fim = (ni * ar - nr * ai) / den;
    float* abar = (float*)(base + S5C_ABAR); abar[(g * 64 + p) * 2] = (float)abr; abar[(g * 64 + p) * 2 + 1] = (float)abi;
    double pr = abr, pi = abi;
#pragma unroll
    for (int s = 0; s < 6; ++s) { const double tr = pr * pr - pi * pi, ti = 2.0 * pr * pi; pr = tr; pi = ti; }
    float* abarL = (float*)(base + S5C_ABARL); abarL[(g * 64 + p) * 2] = (float)pr; abarL[(g * 64 + p) * 2 + 1] = (float)pi;
    bf16* bbar = (bf16*)(base + S5C_BBAR);
    const float* bre = INP(a, I_S5BRE) + ((size_t)(l * 32 + g) * 64 + p) * 16; const float* bim = INP(a, I_S5BIM) + ((size_t)(l * 32 + g) * 64 + p) * 16;
#pragma unroll
    for (int c = 0; c < 16; ++c) { const double br = bre[c], bi = bim[c];
        bbar[((size_t)g * 128 + p) * 16 + c] = f2bf((float)(fre * br - fim * bi));
        bbar[((size_t)g * 128 + 64 + p) * 16 + c] = f2bf((float)(fre * bi + fim * br)); }
    bf16* cmat = (bf16*)(base + S5C_CMAT);
    const float* cre = INP(a, I_S5CRE) + (size_t)(l * 32 + g) * 16 * 64; const float* cim = INP(a, I_S5CIM) + (size_t)(l * 32 + g) * 16 * 64;
#pragma unroll
    for (int c = 0; c < 16; ++c) { cmat[((size_t)g * 16 + c) * 128 + p] = f2bf(cre[c * 64 + p]); cmat[((size_t)g * 16 + c) * 128 + 64 + p] = f2bf(-cim[c * 64 + p]); }
}
DI void p0_lru_w(const Frame& F, const Args& a) {
    const int total = DEPTH * 2 * 8 * 96 * 96;
    const float* pwa = INP(a, I_LWA); const float* pwx = INP(a, I_LWX);
    for (int idx = F.bid * NTHREADS + F.tid; idx < total; idx += F.G * NTHREADS) {
        int r = idx; const int i = r % 96; r /= 96; const int j = r % 96; r /= 96; const int h = r % 8; r /= 8; const int which = r & 1, l = r >> 1;
        const float* src = (which ? pwx : pwa) + (((size_t)l * 8 + h) * 96 + i) * 96 + j;
        bf16* dst = (bf16*)(F.ws + WS_LRUW + (size_t)l * LRUW_STRIDE + (which ? LRUW_X : 0));
        dst[((size_t)h * 96 + j) * 96 + i] = f2bf(*src);
    }
}
DI void p0_ada(const Frame& F, const Args& a) {
    LAS float* red = (LAS float*)F.lds;
    const int cq = F.lane & 15, kr = F.lane >> 4;
    for (int task = F.bid; task < DEPTH * 192; task += F.G) {
        const int l = task / 192, cg = task % 192;
        const float* W = INP(a, I_ADAW) + (size_t)l * DM * (NADA * DM) + 64 * cg + 4 * cq;
        const float* cin = INP(a, I_C);
        f32x4 acc[4];
#pragma unroll
        for (int b = 0; b < 4; ++b) acc[b] = (f32x4){0.f, 0.f, 0.f, 0.f};
#pragma unroll 4
        for (int it = 0; it < 64; ++it) { const int k = 256 * F.wave + 4 * it + kr;
            const f32x4 wv = *(const f32x4*)(W + (size_t)k * (NADA * DM));
#pragma unroll
            for (int b = 0; b < 4; ++b) { const float cs = siluf_(cin[b * DM + k]); acc[b] += cs * wv; } }
#pragma unroll
        for (int b = 0; b < 4; ++b)
#pragma unroll
            for (int e = 0; e < 4; ++e) acc[b][e] = xor_add<16>(acc[b][e]);
        if ((kr & 1) == 0) {
#pragma unroll
            for (int b = 0; b < 4; ++b) *(LAS f32x4*)(red + ((F.wave * 2 + (kr >> 1)) * 4 + b) * 64 + 4 * cq) = acc[b]; }
        __syncthreads();
        if (F.tid < 256) { const int b = F.tid >> 6, col = F.tid & 63; float s = INP(a, I_ADAB)[(size_t)l * (NADA * DM) + 64 * cg + col];
#pragma unroll
            for (int w = 0; w < 16; ++w) s += red[(w * 4 + b) * 64 + col];
            ((float*)(F.ws + WS_MOD))[((size_t)l * 4 + b) * (NADA * DM) + 64 * cg + col] = s; }
        __syncthreads();
    }
}
DI void p0_convert(const Frame& F, const Args& a) {
    LAS float* scr = (LAS float*)(F.lds + F.wave * 16896);
    const int gw = F.bid * NWAVES + F.wave, NGW = F.G * NWAVES;
    constexpr int I_WIN_ = 32 * 72, I_WOUT_ = 32 * 32, I_GLU_ = 8 * 16, I_F13_ = 32 * 176, I_F2_ = 44 * 32, I_M13_ = 16 * 112, I_M2_ = 56 * 32;
    constexpr int TOTAL = 2 * I_WIN_ + 2 * I_WOUT_ + 2 * I_GLU_ + I_F13_ + I_F2_ + 8 * I_M13_ + 8 * I_M2_;
    for (int it = gw; it < TOTAL; it += NGW) {
        int r = it;
        if (r < 2 * I_WIN_) { const int l = r / I_WIN_; r %= I_WIN_; conv_item(INP(a, I_WIN) + (size_t)l * DM * DIN_SRC, nullptr, DIN_SRC, DM, (bf16*)(F.ws + WS_WIN) + (size_t)l * PROJ_LD * DM, r / 72, r % 72, 1, scr, F.lane); continue; } r -= 2 * I_WIN_;
        if (r < 2 * I_WOUT_) { const int l = r / I_WOUT_; r %= I_WOUT_; conv_item(INP(a, I_WOUT) + (size_t)l * DM * DM, nullptr, DM, DM, (bf16*)(F.ws + WS_WOUT) + (size_t)l * DM * DM, r / 32, r % 32, 0, scr, F.lane); continue; } r -= 2 * I_WOUT_;
        if (r < 2 * I_GLU_) { const int l = r / I_GLU_; r %= I_GLU_; conv_item(INP(a, I_S5WGLU) + (size_t)l * 512 * 1024, nullptr, 1024, 512, (bf16*)(F.ws + WS_WGLU) + (size_t)l * 1024 * 512, r / 16, r % 16, 3, scr, F.lane); continue; } r -= 2 * I_GLU_;
        if (r < I_F13_) { conv_item(INP(a, I_F1), INP(a, I_F3), DFF, DM, (bf16*)(F.ws + WS_F13), r / 176, r % 176, 2, scr, F.lane); continue; } r -= I_F13_;
        if (r < I_F2_) { conv_item8<false>(INP(a, I_F2), nullptr, DM, DFF, (unsigned char*)(F.ws + WS_F2), r / 32, r % 32, SC_W2, (LAS unsigned*)scr, F.lane); continue; } r -= I_F2_;
        if (r < 8 * I_M13_) { const int e = r / I_M13_; r %= I_M13_; conv_item8<true>(INP(a, I_M1) + (size_t)e * DM * DFFE, INP(a, I_M3) + (size_t)e * DM * DFFE, DFFE, DM, (unsigned char*)(F.ws + WS_M13 + (size_t)e * 2 * DFFE * DM), 8 * ((r >> 3) / 112) + (r & 7), (r >> 3) % 112, SC_W13, (LAS unsigned*)scr, F.lane);     continue; } r -= 8 * I_M13_;
        { const int e = r / I_M2_; r %= I_M2_; conv_item8<false>(INP(a, I_M2) + (size_t)e * DFFE * DM, nullptr, DM, DFFE, (unsigned char*)(F.ws + WS_M2 + (size_t)e * DM * DFFE), 8 * ((r >> 3) / 32) + (r & 7), (r >> 3) % 32, SC_W2, (LAS unsigned*)scr, F.lane); }
    }
}

template <bool ROUTER, bool OUT8>
DI void norm_phase(const Frame& F, const Args& a, const float* xin, const float* g, const float* mod  , int shift_idx, int scale_idx, const float* wrouter) {
    bf16* H = (bf16*)(F.ws + WS_H);
    LAS float* wr = (LAS float*)F.lds;
    volatile LAS unsigned* bcnt = F.MISC + 32;
    LAS unsigned* rows = (LAS unsigned*)(F.lds + 65536);
    if (ROUTER) {
        for (int i0 = F.tid; i0 < DM * NE; i0 += 8 * NTHREADS) { float w8[8];
#pragma unroll
            for (int q = 0; q < 8; ++q) w8[q] = wrouter[i0 + NTHREADS * q];
#pragma unroll
            for (int q = 0; q < 8; ++q) { const int i = i0 + NTHREADS * q, d = i >> 3, e = i & 7; wr[e * DM + d] = w8[q]; } }
        if (F.tid < 8) bcnt[F.tid] = 0u;
        __syncthreads();
    }
    const int gw = F.bid * NWAVES + F.wave;
    int rslot = 0;
    f32x4 vnx[8];
    if (gw < T) {
#pragma unroll
        for (int j = 0; j < 8; ++j) vnx[j] = ((const f32x4*)(xin + (size_t)gw * DM) + F.lane)[64 * j]; }
    for (int row = gw; row < T; row += F.G * NWAVES, ++rslot) {
        const int b = row >> 11;
        f32x4 v[8]; float ss = 0.f;
#pragma unroll
        for (int j = 0; j < 8; ++j) v[j] = vnx[j];
        { const int rown = row + F.G * NWAVES < T ? row + F.G * NWAVES : row;
          const f32x4* xn = (const f32x4*)(xin + (size_t)rown * DM) + F.lane;
#pragma unroll
          for (int j = 0; j < 8; ++j) vnx[j] = xn[64 * j]; }
#pragma unroll
        for (int j = 0; j < 8; ++j) ss += (v[j][0] * v[j][0] + v[j][1] * v[j][1]) + (v[j][2] * v[j][2] + v[j][3] * v[j][3]);
        const float rstd = rsqrtf(wave_sum(ss) * (1.f / DM) + EPS);
        const f32x4* gp = (const f32x4*)g + F.lane; const f32x4* sc = (const f32x4*)(mod + (size_t)b * (NADA * DM) + scale_idx * DM) + F.lane; const f32x4* sh = (const f32x4*)(mod + (size_t)b * (NADA * DM) + shift_idx * DM) + F.lane;
        u32x2* o8 = (u32x2*)(H + (size_t)row * DM) + F.lane;
#pragma unroll
        for (int j = 0; j < 8; ++j) { const f32x4 gg = gp[64 * j], s1 = sc[64 * j], s0 = sh[64 * j];
            v[j] = v[j] * rstd * gg * (1.f + s1) + s0;
            if (OUT8) ((unsigned*)((unsigned char*)H + (size_t)row * DM))[F.lane + 64 * j] = pg8::pk4_fp8(v[j][0] * SC_X, v[j][1] * SC_X, v[j][2] * SC_X, v[j][3] * SC_X);
            else { u32x2 w; w.x = pk_bf16(v[j][0], v[j][1]); w.y = pk_bf16(v[j][2], v[j][3]); o8[64 * j] = w; } }
        if (ROUTER) {
            float lg[8];
#pragma unroll
            for (int e = 0; e < 8; ++e) { float s = 0.f;
#pragma unroll
                for (int j = 0; j < 8; ++j) { const f32x4 w4 = *(const LAS f32x4*)(wr + e * DM + 256 * j + 4 * F.lane); s += (v[j][0] * w4[0] + v[j][1] * w4[1]) + (v[j][2] * w4[2] + v[j][3] * w4[3]); }
                lg[e] = wave_sum(s); }
            if (F.lane == 0) {
                int e0 = 0; float v0 = lg[0];
#pragma unroll
                for (int e = 1; e < 8; ++e) if (lg[e] > v0) { v0 = lg[e]; e0 = e; }
                int e1 = -1; float v1 = -3.4e38f;
#pragma unroll
                for (int e = 0; e < 8; ++e) if (e != e0 && lg[e] > v1) { v1 = lg[e]; e1 = e; }
                const float ex = __expf(v1 - v0), g0 = 1.f / (1.f + ex), g1 = ex / (1.f + ex);
                const unsigned p0 = 0u, p1 = 0u;
                LAS unsigned* rec = rows + (F.wave * 4 + rslot) * 8;
                rec[0] = (unsigned)e0; rec[1] = (unsigned)e1; rec[2] = p0; rec[3] = p1; rec[4] = __builtin_bit_cast(unsigned, g0); rec[5] = __builtin_bit_cast(unsigned, g1);
            }
        }
    }
    if (ROUTER) {
        __syncthreads();
        if (F.tid == 0) {
            for (int r = 0; r < 32; ++r) { LAS unsigned* rec = rows + r * 8; const unsigned e0 = rec[0], e1 = rec[1];
                const unsigned q0 = bcnt[e0]; bcnt[e0] = q0 + 1u; const unsigned q1 = bcnt[e1]; bcnt[e1] = q1 + 1u; rec[2] = q0; rec[3] = q1; }
            unsigned* cb = (unsigned*)(F.ws + WS_CNTBLK) + (size_t)F.bid * 32;
            for (int e = 0; e < 8; ++e) cb[e] = bcnt[e];
        }
        __syncthreads();
        if (F.tid < 32) { LAS unsigned* rec = rows + F.tid * 8; const int w = F.tid >> 2, rs = F.tid & 3; const int row = F.bid * NWAVES + w + rs * F.G * NWAVES;
            if (row < T) { unsigned* out = (unsigned*)(F.ws + WS_ROUTE) + (size_t)row * 8;
                out[0] = rec[0]; out[1] = rec[1]; out[2] = rec[2]; out[3] = rec[3]; out[4] = rec[4]; out[5] = rec[5]; } }
        __syncthreads();
    }
}
DI void s5norm_phase(const Frame& F, const float* g) {
    const float* P = (const float*)(F.ws + WS_S5PRE); bf16* MIX = (bf16*)(F.ws + WS_MIX);
    for (int row = F.bid * NWAVES + F.wave; row < T; row += F.G * NWAVES) {
        const f32x4* xr = (const f32x4*)(P + (size_t)row * 512) + F.lane;
        f32x4 v[2]; float ss = 0.f;
#pragma unroll
        for (int j = 0; j < 2; ++j) { v[j] = xr[64 * j]; ss += (v[j][0] * v[j][0] + v[j][1] * v[j][1]) + (v[j][2] * v[j][2] + v[j][3] * v[j][3]); }
        const float rstd = rsqrtf(wave_sum(ss) * (1.f / 512.f) + EPS);
        u32x2* o8 = (u32x2*)(MIX + (size_t)row * DM) + F.lane;
#pragma unroll
        for (int j = 0; j < 2; ++j) { const f32x4 gg = ((const f32x4*)g)[F.lane + 64 * j]; v[j] = v[j] * rstd * gg;
            u32x2 w; w.x = pk_bf16(v[j][0], v[j][1]); w.y = pk_bf16(v[j][2], v[j][3]); o8[64 * j] = w; }
    }
}
DI void moe_tiles(const Frame& F) {
    LAS unsigned* tbl = (LAS unsigned*)F.lds;
    const unsigned* cb = (const unsigned*)(F.ws + WS_CNTBLK);
    __syncthreads();
    for (int i = F.tid; i < F.G * 8; i += NTHREADS) tbl[i] = cb[(i >> 3) * 32 + (i & 7)];
    __syncthreads();
    if (F.tid < 8) { unsigned tot = 0, base = 0;
        for (int b = 0; b < F.G; ++b) { if (b == F.bid) base = tot; tot += tbl[b * 8 + F.tid]; }
        F.MISC[32 + F.tid] = tot; F.MISC[40 + F.tid] = base; }
    __syncthreads();
    if (F.tid == 0) { unsigned s = 0;
        for (int e = 0; e < 8; ++e) { F.MISC[16 + e] = s; s += (F.MISC[32 + e] + 255u) >> 8; }
        F.MISC[24] = s; }
    __syncthreads();
}
DI void dense_tiles(const Frame& F) {
    __syncthreads();
    if (F.tid == 0) { F.MISC[16] = 0u; for (int e = 1; e <= 8; ++e) F.MISC[16 + e] = (unsigned)(T / 256); }
    __syncthreads();
}
DI void moe_sort_phase(const Frame& F) {
    moe_tiles(F);
    const bf16* H = (const bf16*)(F.ws + WS_H); bf16* AS = (bf16*)(F.ws + WS_AS);
    for (int row = F.bid * NWAVES + F.wave; row < T; row += F.G * NWAVES) {
        unsigned* rt = (unsigned*)(F.ws + WS_ROUTE) + (size_t)row * 8;
        const unsigned e0 = rt[0], e1 = rt[1], q0 = rt[2], q1 = rt[3];
        const unsigned p0 = F.MISC[16 + e0] * 256u + F.MISC[40 + e0] + q0, p1 = F.MISC[16 + e1] * 256u + F.MISC[40 + e1] + q1;
        const u32x4* src = (const u32x4*)((const unsigned char*)H + (size_t)row * DM) + F.lane;
        u32x4* d0 = (u32x4*)((unsigned char*)AS + (size_t)p0 * DM) + F.lane; u32x4* d1 = (u32x4*)((unsigned char*)AS + (size_t)p1 * DM) + F.lane;
#pragma unroll
        for (int j = 0; j < 2; ++j) { const u32x4 v = src[64 * j]; d0[64 * j] = v; d1[64 * j] = v; }
        if (F.lane == 0) { rt[6] = p0; rt[7] = p1; }
    }
}
DI void final_phase(const Frame& F, const Args& a, const float* mod) {
    const float* X1 = (const float*)(F.ws + WS_X1); const float* Y = (const float*)(F.ws + WS_Y);
    const f32x4* fng = (const f32x4*)INP(a, I_FNG);
    for (int row = F.bid * NWAVES + F.wave; row < T; row += F.G * NWAVES) {
        const int b = row >> 11;
        const unsigned* rt = (const unsigned*)(F.ws + WS_ROUTE) + (size_t)row * 8;
        const float g0 = __builtin_bit_cast(float, rt[4]), g1 = __builtin_bit_cast(float, rt[5]); const unsigned p0 = rt[6], p1 = rt[7];
        const f32x4* xr = (const f32x4*)(X1 + (size_t)row * DM) + F.lane; const f32x4* y0 = (const f32x4*)(Y + (size_t)p0 * DM) + F.lane; const f32x4* y1 = (const f32x4*)(Y + (size_t)p1 * DM) + F.lane;
        const f32x4* gt = (const f32x4*)(mod + (size_t)b * (NADA * DM) + 5 * DM) + F.lane;
        f32x4 v[8]; float ss = 0.f;
#pragma unroll
        for (int j = 0; j < 8; ++j) {
#if defined(DBG_ROUTE_ONLY)
            v[j] = xr[64 * j] + gt[64 * j] * (g0 * (float)(p0 % 97u) * 0.01f + g1 * (float)(p1 % 89u) * 0.01f + (float)rt[0] * 0.1f - (float)rt[1] * 0.05f);
#elif defined(DBG_SKIP_MOE)
            v[j] = xr[64 * j];
#else
            v[j] = xr[64 * j] + gt[64 * j] * (g0 * y0[64 * j] + g1 * y1[64 * j]);
#endif
            ss += (v[j][0] * v[j][0] + v[j][1] * v[j][1]) + (v[j][2] * v[j][2] + v[j][3] * v[j][3]); }
        const float rstd = rsqrtf(wave_sum(ss) * (1.f / DM) + EPS);
        f32x4* o = (f32x4*)(as_global(a.out) + (size_t)row * DM) + F.lane;
#pragma unroll
        for (int j = 0; j < 8; ++j) o[64 * j] = DBG_OUTSCALE * v[j] * rstd * fng[F.lane + 64 * j];
    }
}

template <bool FULL>
DI void s5_task(const Frame& F, const Args& a, int l, int task, LAS unsigned char* wl) {
    const int lane = F.lane, fr = lane & 15, fq = lane >> 4;
    const int b = task >> 10, g = (task >> 5) & 31, j = task & 31;
    const unsigned char* cb = (const unsigned char*)(F.ws + WS_S5C + (size_t)l * S5C_STRIDE);
    const f32x2 ab = ((const f32x2*)(cb + S5C_ABAR))[g * 64 + lane];
    const bf16* bbar = (const bf16*)(cb + S5C_BBAR) + (size_t)g * 128 * 16;
    const bf16* PJ = (const bf16*)(F.ws + WS_PROJ);
    volatile LAS float* BU = (volatile LAS float*)wl;
    bf16x8 Bf[8];
    const bf16x8 zero8 = (bf16x8){0, 0, 0, 0, 0, 0, 0, 0};
#pragma unroll
    for (int nb = 0; nb < 8; ++nb) Bf[nb] = (fq < 2) ? *(const bf16x8*)(bbar + (16 * nb + fr) * 16 + 8 * fq) : zero8;
    bf16x8 Cf[4]; float dv = 0.f;
    float hr = 0.f, hi = 0.f;
    float* E = (float*)(F.ws + WS_S5E) + (size_t)((b * 32 + g) * 32) * 128;
    if (FULL) {
        const bf16* cmat = (const bf16*)(cb + S5C_CMAT) + (size_t)g * 16 * 128;
#pragma unroll
        for (int ks = 0; ks < 4; ++ks) Cf[ks] = *(const bf16x8*)(cmat + fr * 128 + 32 * ks + 8 * fq);
        dv = INP(a, I_S5D)[l * 512 + g * 16 + fr];
        const f32x2 aL = ((const f32x2*)(cb + S5C_ABARL))[g * 64 + lane];
        int i = 0;
        for (; i + 8 <= j; i += 8) { float er[8], ei[8];
#pragma unroll
            for (int q = 0; q < 8; ++q) { er[q] = E[(i + q) * 128 + lane]; ei[q] = E[(i + q) * 128 + 64 + lane]; }
#pragma unroll
            for (int q = 0; q < 8; ++q) { const float nr = fmaf(aL[0], hr, fmaf(-aL[1], hi, er[q])), ni = fmaf(aL[0], hi, fmaf(aL[1], hr, ei[q])); hr = nr; hi = ni; } }
        for (; i < j; ++i) { const float er = E[i * 128 + lane], ei = E[i * 128 + 64 + lane];
            const float nr = fmaf(aL[0], hr, fmaf(-aL[1], hi, er)), ni = fmaf(aL[0], hi, fmaf(aL[1], hr, ei)); hr = nr; hi = ni; }
    }
    const size_t row0 = (size_t)b * SEQ + 64 * j;
    bf16x8 Afs[4];
#pragma unroll
    for (int sub = 0; sub < 4; ++sub) Afs[sub] = (fq < 2) ? *(const bf16x8*)(PJ + (row0 + 16 * sub + fr) * PROJ_LD + C_U + g * 16 + 8 * fq) : zero8;
#pragma unroll
    for (int sub = 0; sub < 4; ++sub) {
        const size_t r0 = row0 + 16 * sub;
        const bf16x8 Af = Afs[sub];
        f32x4 dd[8];
#pragma unroll
        for (int nb = 0; nb < 8; ++nb) dd[nb] = __builtin_amdgcn_mfma_f32_16x16x32_bf16(Af, Bf[nb], (f32x4){0.f, 0.f, 0.f, 0.f}, 0, 0, 0);
        asm volatile("s_nop 15\n\ts_nop 15" : "+v"(dd[0]), "+v"(dd[1]), "+v"(dd[2]), "+v"(dd[3]), "+v"(dd[4]), "+v"(dd[5]), "+v"(dd[6]), "+v"(dd[7]));
#pragma unroll
        for (int nb = 0; nb < 8; ++nb) {
#pragma unroll
            for (int jj = 0; jj < 4; ++jj) BU[(4 * fq + jj) * 132 + 16 * nb + fr] = dd[nb][jj]; }
        LDS_WAIT();
        volatile LAS bf16* HT = (volatile LAS bf16*)(wl + 8448);
        bf16 uu[4];
        if (FULL) {
#pragma unroll
            for (int jj = 0; jj < 4; ++jj) uu[jj] = PJ[(r0 + 4 * fq + jj) * PROJ_LD + C_U + g * 16 + fr]; }
#pragma unroll
        for (int t = 0; t < 16; ++t) { const float br = BU[t * 132 + lane], bi = BU[t * 132 + 64 + lane];
            const float nr = fmaf(ab[0], hr, fmaf(-ab[1], hi, br)), ni = fmaf(ab[0], hi, fmaf(ab[1], hr, bi)); hr = nr; hi = ni;
            if (FULL) { HT[t * 136 + lane] = f2bf_sw(nr); HT[t * 136 + 64 + lane] = f2bf_sw(ni); } }
        LDS_WAIT();
        if (FULL) {
            bf16x8 hf[4];
#pragma unroll
            for (int ks = 0; ks < 4; ++ks) hf[ks] = *(const LAS bf16x8*)((const LAS bf16*)(wl + 8448) + fr * 136 + 32 * ks + 8 * fq);
            asm volatile("s_waitcnt vmcnt(0) lgkmcnt(0)\n\ts_nop 7" : "+v"(hf[0]), "+v"(hf[1]), "+v"(hf[2]), "+v"(hf[3]));
            f32x4 y = (f32x4){0.f, 0.f, 0.f, 0.f};
#pragma unroll
            for (int ks = 0; ks < 4; ++ks) y = __builtin_amdgcn_mfma_f32_16x16x32_bf16(hf[ks], Cf[ks], y, 0, 0, 0);
            asm volatile("s_nop 15\n\ts_nop 15" : "+v"(y));
            bf16* Z = (bf16*)(F.ws + WS_Z);
#pragma unroll
            for (int jj = 0; jj < 4; ++jj) { const size_t r = r0 + 4 * fq + jj; Z[r * 512 + g * 16 + fr] = f2bf(gelu_tanh(y[jj] + dv * bf2f(uu[jj]))); }
        }
    }
    if (!FULL) { E[j * 128 + lane] = hr; E[j * 128 + 64 + lane] = hi; }
}

DI void lru_gate_task(const Frame& F, const Args& a, int l, int task) {
    const int lane = F.lane, fr = lane & 15, fq = lane >> 4;
    const int b = task >> 9, j = (task >> 3) & 63, hd = task & 7;
    const bf16* PJ = (const bf16*)(F.ws + WS_PROJ);
    const float* cw = INP(a, I_LCONVW) + (size_t)l * 4 * 768; const float* cbias = INP(a, I_LCONVB) + (size_t)l * 768;
    const bf16* waT = (const bf16*)(F.ws + WS_LRUW + (size_t)l * LRUW_STRIDE) + (size_t)hd * 96 * 96; const bf16* wxT = (const bf16*)(F.ws + WS_LRUW + (size_t)l * LRUW_STRIDE + LRUW_X) + (size_t)hd * 96 * 96;
    const size_t rbase = (size_t)b * SEQ + 32 * j;
    bf16x8 X[2][3];
#pragma unroll
    for (int ks = 0; ks < 3; ++ks) {
        const int ch = hd * 96 + 32 * ks + 8 * fq;
        f32x4 w0[4], w1[4];
#pragma unroll
        for (int k = 0; k < 4; ++k) { w0[k] = *(const f32x4*)(cw + k * 768 + ch); w1[k] = *(const f32x4*)(cw + k * 768 + ch + 4); }
        const f32x4 c0 = *(const f32x4*)(cbias + ch), c1 = *(const f32x4*)(cbias + ch + 4);
#pragma unroll
        for (int m = 0; m < 2; ++m) {
            const int ts = 32 * j + 16 * m + fr;
            float xc[8];
#pragma unroll
            for (int e = 0; e < 4; ++e) { xc[e] = c0[e]; xc[4 + e] = c1[e]; }
            u32x4 xt[4];
#pragma unroll
            for (int k = 0; k < 4; ++k) { const int tt = ts - 3 + k; xt[k] = *(const u32x4*)(PJ + ((size_t)b * SEQ + (tt < 0 ? 0 : tt)) * PROJ_LD + C_XL + ch); }
#pragma unroll
            for (int k = 0; k < 4; ++k) { const int tt = ts - 3 + k; const u32x4 z4 = {0u, 0u, 0u, 0u}; const u32x4 xv = tt < 0 ? z4 : xt[k];
                    xc[0] += w0[k][0] * bflo(xv.x); xc[1] += w0[k][1] * bfhi(xv.x); xc[2] += w0[k][2] * bflo(xv.y); xc[3] += w0[k][3] * bfhi(xv.y);
                    xc[4] += w1[k][0] * bflo(xv.z); xc[5] += w1[k][1] * bfhi(xv.z); xc[6] += w1[k][2] * bflo(xv.w); xc[7] += w1[k][3] * bfhi(xv.w); }
            u32x4 pk; pk.x = pk_bf16(xc[0], xc[1]); pk.y = pk_bf16(xc[2], xc[3]); pk.z = pk_bf16(xc[4], xc[5]); pk.w = pk_bf16(xc[6], xc[7]);
            X[m][ks] = __builtin_bit_cast(bf16x8, pk);
        }
        asm volatile("" ::: "memory");
    }
    float* LA = (float*)(F.ws + WS_LRUA); float* LB = (float*)(F.ws + WS_LRUB);
    const float* pba = INP(a, I_LBA) + l * 768; const float* pbx = INP(a, I_LBX) + l * 768; const float* plam = INP(a, I_LLAM) + l * 768;
    for (int nb = 0; nb < 6; ++nb) {
        bf16x8 WA[3], WX[3];
#pragma unroll
        for (int ks = 0; ks < 3; ++ks) { WA[ks] = *(const bf16x8*)(waT + (16 * nb + fr) * 96 + 32 * ks + 8 * fq); WX[ks] = *(const bf16x8*)(wxT + (16 * nb + fr) * 96 + 32 * ks + 8 * fq); }
        const int ch0 = hd * 96 + 16 * nb + 4 * fq;
        const f32x4 ba = *(const f32x4*)(pba + ch0), bx = *(const f32x4*)(pbx + ch0), lam = *(const f32x4*)(plam + ch0);
        const f32x4 cb4 = *(const f32x4*)(cbias + ch0);
        f32x4 cwk[4]; u32x2 xtap[2][4];
#pragma unroll
        for (int k = 0; k < 4; ++k) { cwk[k] = *(const f32x4*)(cw + k * 768 + ch0);
#pragma unroll
            for (int m = 0; m < 2; ++m) { const int tt = 32 * j + 16 * m + fr - 3 + k; xtap[m][k] = *(const u32x2*)(PJ + ((size_t)b * SEQ + (tt < 0 ? 0 : tt)) * PROJ_LD + C_XL + ch0); } }
        asm volatile("" : "+v"(cwk[0]), "+v"(cwk[1]), "+v"(cwk[2]), "+v"(cwk[3]));
        asm volatile("" : "+v"(xtap[0][0]), "+v"(xtap[0][1]), "+v"(xtap[0][2]), "+v"(xtap[0][3]), "+v"(xtap[1][0]), "+v"(xtap[1][1]), "+v"(xtap[1][2]), "+v"(xtap[1][3]));
        f32x4 ls;
#pragma unroll
        for (int e = 0; e < 4; ++e) ls[e] = 8.f * logsigmoid_fast(lam[e]);
#pragma unroll
        for (int m = 0; m < 2; ++m) {
            f32x4 da = (f32x4){0.f, 0.f, 0.f, 0.f}, dx = (f32x4){0.f, 0.f, 0.f, 0.f};
#pragma unroll
            for (int ks = 0; ks < 3; ++ks) { da = __builtin_amdgcn_mfma_f32_16x16x32_bf16(WA[ks], X[m][ks], da, 0, 0, 0); dx = __builtin_amdgcn_mfma_f32_16x16x32_bf16(WX[ks], X[m][ks], dx, 0, 0, 0); }
            asm volatile("s_nop 15\n\ts_nop 15" : "+v"(da), "+v"(dx));
            const int ts = 32 * j + 16 * m + fr;
            f32x4 xc = cb4;
#pragma unroll
            for (int k = 0; k < 4; ++k) { const int tt = ts - 3 + k;
                u32x2 xv = xtap[m][k]; const f32x4 w = cwk[k];
                if (tt < 0) { xv.x = 0u; xv.y = 0u; }
                    xc[0] += w[0] * bflo(xv.x); xc[1] += w[1] * bfhi(xv.x); xc[2] += w[2] * bflo(xv.y); xc[3] += w[3] * bfhi(xv.y); }
            f32x4 av, bv;
#pragma unroll
            for (int e = 0; e < 4; ++e) { const float r = sigmoidf_(da[e] + ba[e]), ig = sigmoidf_(dx[e] + bx[e]); const float la = r * ls[e];
                av[e] = __expf(la); bv[e] = sqrtf(fmaxf(1.f - av[e] * av[e], 0.f)) * ig * xc[e]; }
            const size_t o = (rbase + 16 * m + fr) * 768 + ch0;
            *(f32x4*)(LA + o) = av; *(f32x4*)(LB + o) = bv;
        }
    }
}
DI void lru_scan_task(const Frame& F, int task) {
    const int b = task / 384, rem = task % 384, j = rem / 12, cg = rem % 12;
    float* LA = (float*)(F.ws + WS_LRUA) + ((size_t)b * SEQ + 64 * j) * 768 + 64 * cg + F.lane; float* LB = (float*)(F.ws + WS_LRUB) + ((size_t)b * SEQ + 64 * j) * 768 + 64 * cg + F.lane;
    float h = 0.f, cum = 1.f;
    for (int t0 = 0; t0 < 64; t0 += 32) { float av[32], bv[32];
#pragma unroll
        for (int t = 0; t < 32; ++t) { av[t] = LA[(size_t)(t0 + t) * 768]; bv[t] = LB[(size_t)(t0 + t) * 768]; }
#pragma unroll
        for (int t = 0; t < 32; ++t) { h = fmaf(av[t], h, bv[t]); cum *= av[t]; LB[(size_t)(t0 + t) * 768] = h; LA[(size_t)(t0 + t) * 768] = cum; } }
}
DI void lru_out_task(const Frame& F, const Args& a, int l, int task) {
    const int b = task >> 5, j = task & 31;
    const float* LA = (const float*)(F.ws + WS_LRUA) + (size_t)b * SEQ * 768; const float* LB = (const float*)(F.ws + WS_LRUB) + (size_t)b * SEQ * 768;
    LAS float* HS = (LAS float*)F.lds;
    for (int ch = F.tid; ch < 768; ch += NTHREADS) { float H = 0.f;
        int i = 0;
        for (; i + 8 <= j; i += 8) { float ap[8], e[8];
#pragma unroll
            for (int q = 0; q < 8; ++q) { ap[q] = LA[(size_t)(64 * (i + q) + 63) * 768 + ch]; e[q] = LB[(size_t)(64 * (i + q) + 63) * 768 + ch]; }
#pragma unroll
            for (int q = 0; q < 8; ++q) H = fmaf(ap[q], H, e[q]); }
        for (; i < j; ++i) { const float ap = LA[(size_t)(64 * i + 63) * 768 + ch], e = LB[(size_t)(64 * i + 63) * 768 + ch]; H = fmaf(ap, H, e); }
        HS[ch] = H; }
    __syncthreads();
    const bf16* PJ = (const bf16*)(F.ws + WS_PROJ); bf16* MIX = (bf16*)(F.ws + WS_MIX);
    const float* ng = INP(a, I_LNG) + l * 768;
    const f32x4 g4r[3] = {*(const f32x4*)(ng + 4 * F.lane), *(const f32x4*)(ng + 4 * F.lane + 256), *(const f32x4*)(ng + 4 * F.lane + 512)};
    for (int rr0 = F.wave; rr0 < 64; rr0 += 2 * NWAVES) {
      f32x4 hl2[2][3], ca2[2][3]; u32x2 gv2[2][3];
#pragma unroll
      for (int u = 0; u < 2; ++u) { const size_t t = 64 * j + rr0 + NWAVES * u, row = (size_t)b * SEQ + t;
#pragma unroll
          for (int q = 0; q < 3; ++q) { const int ch = 4 * F.lane + 256 * q; hl2[u][q] = *(const f32x4*)(LB + t * 768 + ch); ca2[u][q] = *(const f32x4*)(LA + t * 768 + ch); gv2[u][q] = *(const u32x2*)(PJ + row * PROJ_LD + C_GL + ch); } }
#pragma unroll
      for (int u = 0; u < 2; ++u) {
        const size_t t = 64 * j + rr0 + NWAVES * u, row = (size_t)b * SEQ + t;
        f32x4 v[3]; float ss = 0.f;
#pragma unroll
        for (int q = 0; q < 3; ++q) { const int ch = 4 * F.lane + 256 * q;
            const f32x4 hl = hl2[u][q], ca = ca2[u][q], hs = *(const LAS f32x4*)(HS + ch);
            const u32x2 gv = gv2[u][q];
            const float gg[4] = {bflo(gv.x), bfhi(gv.x), bflo(gv.y), bfhi(gv.y)};
#pragma unroll
            for (int e = 0; e < 4; ++e) { const float h = fmaf(ca[e], hs[e], hl[e]); v[q][e] = h * gelu_tanh(gg[e]); ss += v[q][e] * v[q][e]; } }
        const float rstd = rsqrtf(wave_sum(ss) * (1.f / 768.f) + EPS);
#pragma unroll
        for (int q = 0; q < 3; ++q) { const int ch = 4 * F.lane + 256 * q; const f32x4 o = v[q] * rstd * g4r[q];
            u32x2 w; w.x = pk_bf16(o[0], o[1]); w.y = pk_bf16(o[2], o[3]); *(u32x2*)(MIX + row * DM + 512 + ch) = w; }
      }
    }
    __syncthreads();
}

constexpr int GL_BC = 0, GL_WG = 24832, GL_K = 31488, GL_V = 57600;
constexpr int GB_Q = 31488, GB_K = 57600, GB_V = 83712;
DI void gla_bcum(const Frame& F, const Args& a, int l, int hd, size_t r0, LAS float* bc, LAS float* wg) {
    const bf16* PJ = (const bf16*)(F.ws + WS_PROJ);
    { const float* pg = INP(a, I_GWG2) + (size_t)l * 16 * 384 + hd * 96; float w3[3];
#pragma unroll
      for (int q = 0; q < 3; ++q) { const int i = F.tid + NTHREADS * q; w3[q] = pg[(i / 96) * 384 + i % 96]; }
#pragma unroll
      for (int q = 0; q < 3; ++q) wg[F.tid + NTHREADS * q] = w3[q]; }
    if (F.tid < 96) wg[1536 + F.tid] = INP(a, I_GBG2)[l * 384 + hd * 96 + F.tid];
    __syncthreads();
    { const int t = F.tid >> 3, dg = F.tid & 7;
      const u32x4 g0 = *(const u32x4*)(PJ + (r0 + t) * PROJ_LD + C_GLOW), g1 = *(const u32x4*)(PJ + (r0 + t) * PROJ_LD + C_GLOW + 8);
      const float gl[16] = {bflo(g0.x), bfhi(g0.x), bflo(g0.y), bfhi(g0.y), bflo(g0.z), bfhi(g0.z), bflo(g0.w), bfhi(g0.w), bflo(g1.x), bfhi(g1.x), bflo(g1.y), bfhi(g1.y), bflo(g1.z), bfhi(g1.z), bflo(g1.w), bfhi(g1.w)};
#pragma unroll
      for (int q = 0; q < 12; ++q) { const int d = dg + 8 * q; float acc = wg[1536 + d];
#pragma unroll
          for (int r = 0; r < 16; ++r) acc = fmaf(gl[r], wg[r * 96 + d], acc);
          bc[t * 97 + d] = logsigmoid_fast(acc) * (1.f / 16.f); } }
    __syncthreads();
    { const int d = F.tid % 96, seg = F.tid / 96; float v[16]; float s_ = 0.f;
      if (F.tid < 384) {
#pragma unroll
          for (int t = 0; t < 16; ++t) { s_ += bc[(16 * seg + t) * 97 + d]; v[t] = s_; }
          wg[1632 + seg * 96 + d] = s_; }
      __syncthreads();
      if (F.tid < 384) { float pre = 0.f;
#pragma unroll
          for (int q = 0; q < 3; ++q) pre += (q < seg) ? wg[1632 + q * 96 + d] : 0.f;
#pragma unroll
          for (int t = 0; t < 16; ++t) bc[(16 * seg + t) * 97 + d] = v[t] + pre; } }
    __syncthreads();
}
constexpr int G2_QD = 31488, G2_KI = 44800, G2_VT = 58112, G2_KO = 85760, G2_AT = 85760, G2_RED = 99584;
DI bf16x8 ldfrag(const LAS bf16* tile, int ST, int r0, int k0, int fr, int fq) { return *(const LAS bf16x8*)(tile + (r0 + fr) * ST + k0 + 8 * fq); }
#define MFMA_GUARD_IN4(a, b, c, d)  asm volatile("s_waitcnt vmcnt(0) lgkmcnt(0)\n\ts_nop 7" : "+v"(a), "+v"(b), "+v"(c), "+v"(d))
#define MFMA_GUARD_OUT(x)           asm volatile("s_nop 15\n\ts_nop 15" : "+v"(x))
DI void gla_stage_vt(const Frame& F, size_t r0, int hd, LAS bf16* VT) {
    const bf16* PJ = (const bf16*)(F.ws + WS_PROJ);
    u32x4 v3[3];
#pragma unroll
    for (int q = 0; q < 3; ++q) { const int it = F.tid + NTHREADS * q, t = it & 63, vc = it >> 6; v3[q] = *(const u32x4*)(PJ + (r0 + t) * PROJ_LD + C_V + hd * 192 + 8 * vc); }
#pragma unroll
    for (int q = 0; q < 3; ++q) { const int it = F.tid + NTHREADS * q, t = it & 63, vc = it >> 6;
        const u32x4 vv = v3[q];
        LAS bf16* p = VT + (8 * vc) * 72 + t;
        p[0 * 72] = (bf16)(vv.x & 0xffffu); p[1 * 72] = (bf16)(vv.x >> 16); p[2 * 72] = (bf16)(vv.y & 0xffffu); p[3 * 72] = (bf16)(vv.y >> 16);
        p[4 * 72] = (bf16)(vv.z & 0xffffu); p[5 * 72] = (bf16)(vv.z >> 16); p[6 * 72] = (bf16)(vv.w & 0xffffu); p[7 * 72] = (bf16)(vv.w >> 16);
        LDS_WAIT(); }
}
DI void gla_a_task(const Frame& F, const Args& a, int l, int unit) {
    const int bh = unit >> 5, n = unit & 31, b = bh >> 2, hd = bh & 3;
    const size_t r0 = (size_t)b * SEQ + 64 * n;
    LAS float* bc = (LAS float*)(F.lds + GL_BC); LAS float* wg = (LAS float*)(F.lds + GL_WG);
    LAS bf16* VT = (LAS bf16*)(F.lds + G2_VT); LAS bf16* KO = (LAS bf16*)(F.lds + G2_KO);
    const bf16* PJ = (const bf16*)(F.ws + WS_PROJ);
    gla_bcum(F, a, l, hd, r0, bc, wg);
    { float* G = (float*)(F.ws + WS_GLABC) + (size_t)unit * 6144;
      for (int i = F.tid; i < 6144; i += NTHREADS) G[i] = bc[(i / 96) * 97 + i % 96]; }
    u32x4 k2[2];
#pragma unroll
    for (int q = 0; q < 2; ++q) { const int it = F.tid + NTHREADS * q, t = it & 63, dc = (it >> 6) % 12; k2[q] = *(const u32x4*)(PJ + (r0 + t) * PROJ_LD + C_K + hd * 96 + 8 * dc); }
#pragma unroll
    for (int q = 0; q < 2; ++q) { const int it = F.tid + NTHREADS * q, t = it & 63, dc = it >> 6;
        if (it < 64 * 12) { const u32x4 kv = k2[q];
        const float kk[8] = {bflo(kv.x), bfhi(kv.x), bflo(kv.y), bfhi(kv.y), bflo(kv.z), bfhi(kv.z), bflo(kv.w), bfhi(kv.w)};
#pragma unroll
        for (int e = 0; e < 8; ++e) { const int d = 8 * dc + e; KO[d * 72 + t] = f2bf_sw(kk[e] * __expf(bc[63 * 97 + d] - bc[t * 97 + d])); } } }
    gla_stage_vt(F, r0, hd, VT);
    __syncthreads();
    const int fr = F.lane & 15, fq = F.lane >> 4;
    float* DT = (float*)(F.ws + WS_GLAD) + (size_t)unit * 96 * 192;
    for (int q = 0; q < 9; ++q) { const int idx = F.wave * 9 + q, mb = idx / 6, nb = idx - 6 * mb;
        bf16x8 a0 = ldfrag(VT, 72, 16 * mb, 0, fr, fq), a1 = ldfrag(VT, 72, 16 * mb, 32, fr, fq), b0 = ldfrag(KO, 72, 16 * nb, 0, fr, fq), b1 = ldfrag(KO, 72, 16 * nb, 32, fr, fq);
        MFMA_GUARD_IN4(a0, a1, b0, b1);
        f32x4 d = __builtin_amdgcn_mfma_f32_16x16x32_bf16(a0, b0, (f32x4){0.f, 0.f, 0.f, 0.f}, 0, 0, 0);
        d = __builtin_amdgcn_mfma_f32_16x16x32_bf16(a1, b1, d, 0, 0, 0);
        MFMA_GUARD_OUT(d);
#pragma unroll
        for (int jj = 0; jj < 4; ++jj) DT[(16 * mb + 4 * fq + jj) * 96 + 16 * nb + fr] = d[jj]; }
    if (F.tid < 96) ((float*)(F.ws + WS_GAMMA))[(size_t)unit * 96 + F.tid] = __expf(bc[63 * 97 + F.tid]);
    __syncthreads();
}
DI void gla_scan_phase(const Frame& F) {
    const float* DL = (const float*)(F.ws + WS_GLAD); const float* GM = (const float*)(F.ws + WS_GAMMA); bf16* ST = (bf16*)(F.ws + WS_GLAS);
    for (int idx = F.bid * NTHREADS + F.tid; idx < 16 * 18432; idx += F.G * NTHREADS) {
        const int bh = idx / 18432, e = idx - bh * 18432, d = e % 96;
        const float* p = DL + (size_t)bh * 32 * 18432 + e; const float* gp = GM + (size_t)bh * 32 * 96 + d; bf16* sp = ST + (size_t)bh * 32 * 18432 + e;
        float S = 0.f; float dl[32], gm[32];
#pragma unroll
        for (int n = 0; n < 32; ++n) { dl[n] = p[(size_t)n * 18432]; gm[n] = gp[n * 96]; }
#pragma unroll
        for (int n = 0; n < 32; ++n) { sp[(size_t)n * 18432] = f2bf_sw(S); S = fmaf(gm[n], S, dl[n]); }
    }
}
DI void gla_b_task(const Frame& F, const Args& a, int l, int unit) {
    const int bh = unit >> 5, n = unit & 31, b = bh >> 2, hd = bh & 3;
    const size_t r0 = (size_t)b * SEQ + 64 * n;
    LAS float* bc = (LAS float*)(F.lds + GL_BC); LAS float* wg = (LAS float*)(F.lds + GL_WG);
    LAS bf16* QD = (LAS bf16*)(F.lds + G2_QD); LAS bf16* KI = (LAS bf16*)(F.lds + G2_KI); LAS bf16* VT = (LAS bf16*)(F.lds + G2_VT); LAS bf16* AT = (LAS bf16*)(F.lds + G2_AT);
    LAS float* red = (LAS float*)(F.lds + G2_RED);
    const bf16* PJ = (const bf16*)(F.ws + WS_PROJ);
    { const float* G = (const float*)(F.ws + WS_GLABC) + (size_t)unit * 6144;
      float g12[12];
#pragma unroll
      for (int q = 0; q < 12; ++q) g12[q] = G[F.tid + NTHREADS * q];
      asm volatile("" : "+v"(g12[0]), "+v"(g12[1]), "+v"(g12[2]), "+v"(g12[3]), "+v"(g12[4]), "+v"(g12[5]), "+v"(g12[6]), "+v"(g12[7]), "+v"(g12[8]), "+v"(g12[9]), "+v"(g12[10]), "+v"(g12[11]));
#pragma unroll
      for (int q = 0; q < 12; ++q) { const int i = F.tid + NTHREADS * q; bc[(i / 96) * 97 + i % 96] = g12[q]; } }
    __syncthreads();
    const float qscale = 0.10206207261596575f;
    u32x4 q2[2], k2[2];
#pragma unroll
    for (int q = 0; q < 2; ++q) { const int it = F.tid + NTHREADS * q, t = it & 63, dc = (it >> 6) % 12;
        q2[q] = *(const u32x4*)(PJ + (r0 + t) * PROJ_LD + C_Q + hd * 96 + 8 * dc); k2[q] = *(const u32x4*)(PJ + (r0 + t) * PROJ_LD + C_K + hd * 96 + 8 * dc); }
    asm volatile("" : "+v"(q2[0]), "+v"(q2[1]), "+v"(k2[0]), "+v"(k2[1]));
#pragma unroll
    for (int q = 0; q < 2; ++q) { const int it = F.tid + NTHREADS * q, t = it & 63, dc = it >> 6;
        if (it < 64 * 12) {
        const u32x4 qv = q2[q], kv = k2[q];
        const float qq[8] = {bflo(qv.x), bfhi(qv.x), bflo(qv.y), bfhi(qv.y), bflo(qv.z), bfhi(qv.z), bflo(qv.w), bfhi(qv.w)};
        const float kk[8] = {bflo(kv.x), bfhi(kv.x), bflo(kv.y), bfhi(kv.y), bflo(kv.z), bfhi(kv.z), bflo(kv.w), bfhi(kv.w)};
        float qo[8], ko[8];
#pragma unroll
        for (int e = 0; e < 8; ++e) { const float bcv = bc[t * 97 + 8 * dc + e]; qo[e] = qq[e] * qscale * __expf(bcv); ko[e] = kk[e] * __expf(-bcv); }
        u32x4 qp, kp; qp.x = pk_bf16(qo[0], qo[1]); qp.y = pk_bf16(qo[2], qo[3]); qp.z = pk_bf16(qo[4], qo[5]); qp.w = pk_bf16(qo[6], qo[7]);
        kp.x = pk_bf16(ko[0], ko[1]); kp.y = pk_bf16(ko[2], ko[3]); kp.z = pk_bf16(ko[4], ko[5]); kp.w = pk_bf16(ko[6], ko[7]);
        *(LAS u32x4*)(QD + t * 104 + 8 * dc) = qp; *(LAS u32x4*)(KI + t * 104 + 8 * dc) = kp; } }
    gla_stage_vt(F, r0, hd, VT);
    __syncthreads();
    const int fr = F.lane & 15, fq = F.lane >> 4;
    { const int mb = F.wave >> 1;
      bf16x8 qa0 = ldfrag(QD, 104, 16 * mb, 0, fr, fq), qa1 = ldfrag(QD, 104, 16 * mb, 32, fr, fq), qa2 = ldfrag(QD, 104, 16 * mb, 64, fr, fq);
#pragma unroll
      for (int h = 0; h < 2; ++h) { const int nb = 2 * (F.wave & 1) + h;
          bf16x8 k0 = ldfrag(KI, 104, 16 * nb, 0, fr, fq), k1 = ldfrag(KI, 104, 16 * nb, 32, fr, fq), k2 = ldfrag(KI, 104, 16 * nb, 64, fr, fq);
          MFMA_GUARD_IN4(k0, k1, k2, qa0); asm volatile("" : "+v"(qa1), "+v"(qa2));
          f32x4 d = __builtin_amdgcn_mfma_f32_16x16x32_bf16(qa0, k0, (f32x4){0.f, 0.f, 0.f, 0.f}, 0, 0, 0);
          d = __builtin_amdgcn_mfma_f32_16x16x32_bf16(qa1, k1, d, 0, 0, 0);
          d = __builtin_amdgcn_mfma_f32_16x16x32_bf16(qa2, k2, d, 0, 0, 0);
          MFMA_GUARD_OUT(d);
#pragma unroll
          for (int jj = 0; jj < 4; ++jj) { const int i = 16 * mb + 4 * fq + jj, jc = 16 * nb + fr; AT[i * 72 + jc] = f2bf_sw(jc <= i ? d[jj] : 0.f); } } }
    __syncthreads();
    const int mb = F.wave & 3, nb0 = 6 * (F.wave >> 2);
    const bf16* SG = (const bf16*)(F.ws + WS_GLAS) + (size_t)unit * 18432;
    bf16x8 at0 = ldfrag(AT, 72, 16 * mb, 0, fr, fq), at1 = ldfrag(AT, 72, 16 * mb, 32, fr, fq);
    bf16x8 qa0 = ldfrag(QD, 104, 16 * mb, 0, fr, fq), qa1 = ldfrag(QD, 104, 16 * mb, 32, fr, fq), qa2 = ldfrag(QD, 104, 16 * mb, 64, fr, fq);
    f32x4 o[6];
    bf16x8 vf[6][2], sf[6][3];
#pragma unroll
    for (int q = 0; q < 6; ++q) { const int nb = nb0 + q; const bf16* sp = SG + (16 * nb + fr) * 96 + 8 * fq;
        sf[q][0] = *(const bf16x8*)(sp); sf[q][1] = *(const bf16x8*)(sp + 32); sf[q][2] = *(const bf16x8*)(sp + 64);
        vf[q][0] = ldfrag(VT, 72, 16 * nb, 0, fr, fq); vf[q][1] = ldfrag(VT, 72, 16 * nb, 32, fr, fq); }
    asm volatile("s_waitcnt vmcnt(0) lgkmcnt(0)\n\ts_nop 7" : "+v"(at0), "+v"(at1), "+v"(qa0), "+v"(qa1), "+v"(qa2));
#pragma unroll
    for (int q = 0; q < 6; ++q) {
        asm volatile("" : "+v"(vf[q][0]), "+v"(vf[q][1]), "+v"(sf[q][0]), "+v"(sf[q][1]), "+v"(sf[q][2]));
        f32x4 d = __builtin_amdgcn_mfma_f32_16x16x32_bf16(at0, vf[q][0], (f32x4){0.f, 0.f, 0.f, 0.f}, 0, 0, 0);
        d = __builtin_amdgcn_mfma_f32_16x16x32_bf16(at1, vf[q][1], d, 0, 0, 0);
        d = __builtin_amdgcn_mfma_f32_16x16x32_bf16(qa0, sf[q][0], d, 0, 0, 0);
        d = __builtin_amdgcn_mfma_f32_16x16x32_bf16(qa1, sf[q][1], d, 0, 0, 0);
        d = __builtin_amdgcn_mfma_f32_16x16x32_bf16(qa2, sf[q][2], d, 0, 0, 0);
        o[q] = d; }
    asm volatile("s_nop 15\n\ts_nop 15" : "+v"(o[0]), "+v"(o[1]), "+v"(o[2]), "+v"(o[3]), "+v"(o[4]), "+v"(o[5]));
    float ss[4];
#pragma unroll
    for (int jj = 0; jj < 4; ++jj) { float s_ = 0.f;
#pragma unroll
        for (int q = 0; q < 6; ++q) s_ += o[q][jj] * o[q][jj];
        s_ = xor_add<1>(s_); s_ = xor_add<2>(s_); s_ = xor_add<4>(s_); s_ = xor_add<8>(s_); ss[jj] = s_; }
    if (fr == 0) {
#pragma unroll
        for (int jj = 0; jj < 4; ++jj) red[(F.wave >> 2) * 64 + 16 * mb + 4 * fq + jj] = ss[jj]; }
    __syncthreads();
    bf16* MIX = (bf16*)(F.ws + WS_MIX);
    const float* hg = INP(a, I_GHG) + l * 192;
#pragma unroll
    for (int jj = 0; jj < 4; ++jj) { const int i = 16 * mb + 4 * fq + jj; const float rstd = rsqrtf((red[i] + red[64 + i]) * (1.f / 192.f) + EPS);
        const size_t row = r0 + i;
#pragma unroll
        for (int q = 0; q < 6; ++q) { const int v = 16 * (nb0 + q) + fr; const float og = bf2f(PJ[row * PROJ_LD + C_OG + hd * 192 + v]);
            MIX[row * DM + 1280 + hd * 192 + v] = f2bf(o[q][jj] * rstd * hg[v] * siluf_(og)); } }
    __syncthreads();
}

#ifdef DBG_HASH
constexpr int CW_HASH = 1024;
struct HashJob { int after_ph; size_t off; size_t bytes; };
__device__ __forceinline__ void hash_phase(const Frame& F, size_t off, size_t bytes, int slot) {
    const unsigned* w = (const unsigned*)(F.ws + off); const size_t n = bytes / 4;
    unsigned acc = 0u;
    for (size_t i = (size_t)F.bid * NTHREADS + F.tid; i < n; i += (size_t)F.G * NTHREADS) acc += w[i] * (unsigned)(2u * (unsigned)i + 1u);
#pragma unroll
    for (int o = 1; o < 64; o <<= 1) acc += __shfl_xor(acc, o);
    if (F.lane == 0) __hip_atomic_fetch_add(F.ctl + CW_HASH + slot * 64, acc, __ATOMIC_RELAXED, __HIP_MEMORY_SCOPE_AGENT);
}
__device__ __forceinline__ void emit_phase(const Frame& F, float* out) {
    const size_t total = (size_t)T * DM, seg = total / 16;
    for (size_t i = (size_t)F.bid * NTHREADS + F.tid; i < total; i += (size_t)F.G * NTHREADS) {
        const int k = (int)(i / seg); const unsigned h = __hip_atomic_load(F.ctl + CW_HASH + k * 64, __ATOMIC_RELAXED, __HIP_MEMORY_SCOPE_AGENT);
        const float amp = __builtin_ldexpf(1.f, -k);
        out[i] = amp * (float)((h >> (unsigned)(i & 31)) & 1u);
    }
}
#endif
#ifndef LB_W
#define LB_W 2
#endif
__global__ void __launch_bounds__(NTHREADS, LB_W) mega_fwd(Args args) {
    extern __shared__ __attribute__((aligned(16))) unsigned char lds_raw[];
    Frame F;
    F.lds = (LAS unsigned char*)lds_raw;
    F.MISC = (volatile LAS unsigned*)(F.lds + LDSCTL_OFF);
    F.wave = __builtin_amdgcn_readfirstlane((int)threadIdx.x >> 6); F.lane = lane_id(); F.tid = F.wave * 64 + F.lane;
    F.G = gridDim.x; F.bid = blockIdx.x;
    F.ws = (GAS unsigned char*)args.ws; F.ctl = (unsigned*)(F.ws + WS_CTL);
#ifdef DBG_POISON
    for (int u = F.tid; u < SCR_BYTES / 4; u += NTHREADS) ((LAS unsigned*)F.lds)[u] = 0xFFFFFFFFu;
#endif
    for (int u = F.tid; u < (LDS_BYTES - LDSCTL_OFF) / 4; u += NTHREADS) ((LAS unsigned*)(F.lds + LDSCTL_OFF))[u] = 0u;
    __syncthreads();
    XcdBarrier bar = xcd_barrier_post(F.ctl + CW_BAR + args.li * XCD_BAR_WORDS, F.MISC + 8, F.wave);
    const int lo = args.ph_lo, hi = args.ph_hi;
#ifdef DBG_HASH
    if (lo >= 200) { emit_phase(F, args.out); return; }
    if (lo >= 100) { hash_phase(F, (size_t)args.hoff, (size_t)args.hbytes, lo - 100); return; }
#endif
#ifndef PHMASK
#define PHMASK 0xFFFF
#endif
#define PH(k, id) if (((PHMASK >> (k)) & 1) && (id) >= lo && (id) < hi)
#define REFRESH() do { int lz_ = lane_id(); asm volatile("" : "+v"(lz_)); F.lane = lz_; F.tid = F.wave * 64 + lz_; asm volatile("" : "+s"(F.ws)); } while (0)
#define SEAM(id) do { if ((id) > lo) xcd_barrier(bar); REFRESH(); } while (0)
    const float* MOD = (const float*)(F.ws + WS_MOD);

    PH(0, 0) { p0_s5_consts(F, args); p0_lru_w(F, args); p0_ada(F, args); p0_convert(F, args); }

    for (int l = 0; l < DEPTH; ++l) {
        const int pb = 1 + 12 * l;
        const float* mod = MOD + (size_t)l * 4 * (NADA * DM);
        const float* xin = (l == 0) ? INP(args, I_X) : (const float*)(F.ws + WS_XCUR);
        PH(1, pb + 0) { SEAM(pb + 0); norm_phase<false, false>(F, args, xin, INP(args, I_NMIXG) + l * DM, mod, 0, 1, nullptr); }
        PH(2, pb + 1) { SEAM(pb + 1);
            pg8::Gemm g{(const bf16*)(F.ws + WS_H), (const bf16*)(F.ws + WS_WIN) + (size_t)l * PROJ_LD * DM, DM}; pg8::StaticOrder S; S.init(T, PROJ_LD, F.G, F.bid);
            pg8::EpiBf16Perm E{(bf16*)(F.ws + WS_PROJ), PROJ_LD};
            pg8::gemm_phase(F.lds, g, S, E, F.wave); }
        PH(3, pb + 2) { SEAM(pb + 2);
#ifndef M1_NO_GLA
            for (int u = F.bid; u < 512; u += F.G) gla_a_task(F, args, l, u);
#endif
            __syncthreads();
#ifndef M1_NO_S5
            for (int bt = F.bid; bt < 512; bt += F.G) s5_task<false>(F, args, l, ((bt >> 7) << 10) | ((8 * (bt & 3) + F.wave) << 5) | ((bt >> 2) & 31), F.lds + F.wave * 16384);
#endif
#ifndef M1_NO_LRU
            for (int t = F.bid * NWAVES + F.wave; t < 2048; t += F.G * NWAVES) lru_gate_task(F, args, l, t);
#endif
 }
        PH(4, pb + 3) { SEAM(pb + 3);
            for (int bt = F.bid; bt < 512; bt += F.G) s5_task<true>(F, args, l, ((bt >> 7) << 10) | ((8 * (bt & 3) + F.wave) << 5) | ((bt >> 2) & 31), F.lds + F.wave * 16384);
            for (int t = F.bid * NWAVES + F.wave; t < 1536; t += F.G * NWAVES) lru_scan_task(F, t);
            gla_scan_phase(F); }
        PH(5, pb + 4) { SEAM(pb + 4);
            { pg8::Gemm g{(const bf16*)(F.ws + WS_Z), (const bf16*)(F.ws + WS_WGLU) + (size_t)l * 1024 * 512, 512}; pg8::StaticOrder S; S.init(T, 1024, F.G, F.bid);
              pg8::EpiGlu E{(float*)(F.ws + WS_S5PRE), INP(args, I_S5BGLU) + l * 1024};
              pg8::gemm_phase(F.lds, g, S, E, F.wave); }
            REFRESH();
            __syncthreads();
#ifndef T_NO_A
            for (int u = (F.bid + 128 >= F.G) ? F.bid + 128 - F.G : F.bid + 128; u < 128; u += F.G) lru_out_task(F, args, l, u);
#endif
#ifndef T_NO_B
            for (int u = F.bid; u < 512; u += F.G) gla_b_task(F, args, l, u);
#endif
 }
        PH(6, pb + 5) { SEAM(pb + 5); s5norm_phase(F, INP(args, I_S5NG) + l * 512); }
        PH(7, pb + 6) { SEAM(pb + 6);
            pg8::Gemm g{(const bf16*)(F.ws + WS_MIX), (const bf16*)(F.ws + WS_WOUT) + (size_t)l * DM * DM, DM}; pg8::StaticOrder S; S.init(T, DM, F.G, F.bid);
            pg8::EpiResid E{(float*)(F.ws + WS_X1), xin, mod + 2 * DM, 1.f};
            pg8::gemm_phase(F.lds, g, S, E, F.wave); }
        PH(8, pb + 7) { SEAM(pb + 7);
            if (l & 1) norm_phase<true, true>(F, args, (const float*)(F.ws + WS_X1), INP(args, I_NFFNG) + l * DM, mod, 3, 4, INP(args, I_ROUTER) + (size_t)(l >> 1) * DM * NE);
            else norm_phase<false, false>(F, args, (const float*)(F.ws + WS_X1), INP(args, I_NFFNG) + l * DM, mod, 3, 4, nullptr); }
        const bool moe = (l & 1) != 0;
        if (moe) { PH(9, pb + 8) { SEAM(pb + 8); moe_sort_phase(F); } }
        if (moe) {
            PH(10, pb + 9) { SEAM(pb + 9); moe_tiles(F);
                pg8::Gemm g{(const bf16*)(F.ws + WS_AS), (const bf16*)(F.ws + WS_M13), DM / 2}; pg8::GroupedOrder S; S.init(F.MISC + 16, 2 * DFFE, F.G, F.bid, (long)2 * DFFE * DM);
                pg8::EpiSwiglu8 E{(unsigned char*)(F.ws + WS_HID), DFFE, 1.f / (SC_X * SC_W13), SC_H};
                pg8::gemm_phase8(F.lds, g, S, E, F.wave); }
            PH(11, pb + 10) { SEAM(pb + 10); moe_tiles(F);
                pg8::Gemm g{(const bf16*)(F.ws + WS_HID), (const bf16*)(F.ws + WS_M2), DFFE / 2}; pg8::GroupedOrder S; S.init(F.MISC + 16, DM, F.G, F.bid, (long)DM * DFFE, 2 * F.G);
                pg8::EpiF32 E{(float*)(F.ws + WS_Y), DM, 1.f / (SC_H * SC_W2)};
                pg8::gemm_phase8(F.lds, g, S, E, F.wave);
                pg8::TailOrder ST; ST.init(F.MISC + 16, DM, 2 * F.G, F.G, F.bid, (long)DM * DFFE, (long)64 * DFFE);
                pg8::EpiF32Narrow EN{(float*)(F.ws + WS_Y), DM, 1.f / (SC_H * SC_W2)};
                pg8::gemm_phase8<true>(F.lds, g, ST, EN, F.wave); }
        } else {
            PH(10, pb + 9) { SEAM(pb + 9);
                pg8::Gemm g{(const bf16*)(F.ws + WS_H), (const bf16*)(F.ws + WS_F13), DM}; pg8::StaticOrder S; S.init(T, 2 * DFF, F.G, F.bid);
                pg8::EpiSwiglu8 E{(unsigned char*)(F.ws + WS_HID), DFF, 1.f, SC_H};
                pg8::gemm_phase(F.lds, g, S, E, F.wave); }
            PH(11, pb + 10) { SEAM(pb + 10);
                pg8::Gemm g{(const bf16*)(F.ws + WS_HID), (const bf16*)(F.ws + WS_F2), DFF / 2}; pg8::StaticOrder S; S.init(T, DM, F.G, F.bid);
                pg8::EpiResid E{(float*)(F.ws + WS_XCUR), (const float*)(F.ws + WS_X1), mod + 5 * DM, 1.f / (SC_H * SC_W2)};
                pg8::gemm_phase8(F.lds, g, S, E, F.wave); }
        }
        if (moe) { PH(12, pb + 11) { SEAM(pb + 11); final_phase(F, args, mod); } }
    }
#undef PH
#undef SEAM
}

extern "C" void kernel_launch(void* const* d_in, const int* in_sizes, int n_in, void* d_out, int out_size, void* d_ws, size_t ws_size, hipStream_t stream) {
    static int grid = 0;
    if (grid == 0) {
        if (n_in != 38 || out_size != T * DM || ws_size < WS_END) { fprintf(stderr, "kernel_launch: unexpected shapes (n_in %d out %d ws %zu)\n", n_in, out_size, ws_size); grid = -1; return; }
        int dev = 0, cus = 0, per_cu = 0;
        if (hipGetDevice(&dev) != hipSuccess || hipDeviceGetAttribute(&cus, hipDeviceAttributeMultiprocessorCount, dev) != hipSuccess) { grid = -1; return; }
        if (hipFuncSetAttribute((const void*)mega_fwd, hipFuncAttributeMaxDynamicSharedMemorySize, LDS_BYTES) != hipSuccess) { fprintf(stderr, "kernel_launch: hipFuncSetAttribute failed\n"); grid = -1; return; }
        if (hipOccupancyMaxActiveBlocksPerMultiprocessor(&per_cu, (const void*)mega_fwd, NTHREADS, LDS_BYTES) != hipSuccess || per_cu < 1) { fprintf(stderr, "kernel_launch: occupancy query says %d\n", per_cu); }
        (void)hipGetLastError();
        grid = cus;
    }
    if (grid < 0) return;
    (void)hipMemsetAsync((char*)d_ws + WS_CTL, 0, CTL_BYTES, stream);
#ifdef DBG_POISON
    (void)hipMemsetAsync((char*)d_ws + CTL_BYTES, 0xFF, WS_END - CTL_BYTES, stream);
#endif
    Args a{};
    for (int i = 0; i < 38; ++i) a.in[i] = (const float*)d_in[i];
    a.out = (float*)d_out; a.ws = (unsigned char*)d_ws; a.pad = 0; a.hoff = 0; a.hbytes = 0;
    constexpr int NPH = 1 + 12 * DEPTH;
#if N_LAUNCH_MODE == 0
    a.ph_lo = 0; a.ph_hi = NPH; a.li = 0;
    hipLaunchKernelGGL(mega_fwd, dim3(grid), dim3(NTHREADS), LDS_BYTES, stream, a);
#else
    int li = 0;
    for (int ph = 0; ph < NPH; ++ph) {
        const int l = (ph - 1) / 12, k = (ph - 1) % 12;
        if (ph > 0) { if ((l & 1) == 0 && (k == 8 || k == 11)) continue; }
        a.ph_lo = ph; a.ph_hi = ph + 1; a.li = li++;
        hipLaunchKernelGGL(mega_fwd, dim3(grid), dim3(NTHREADS), LDS_BYTES, stream, a);
#ifdef DBG_HASH
        {
            static const HashJob jobs[16] = {
                {0, 1 * MiB, 3 * MiB}, {0, WS_WIN, WS_H - WS_WIN},
                {1, WS_H, 32 * MiB}, {2, WS_PROJ, 72 * MiB}, {3, WS_S5E, 2 * MiB}, {3, WS_LRUA, 84 * MiB},
                {4, WS_Z, 8 * MiB}, {4, WS_LRUA, 48 * MiB}, {4, WS_GLAD, 36 * MiB},
                {5, WS_S5PRE, 16 * MiB}, {5, WS_MIX, 32 * MiB}, {6, WS_MIX, 32 * MiB}, {7, WS_X1, 64 * MiB}, {8, WS_H, 32 * MiB}, {10, WS_HID, (size_t)T * DFF * 2}, {11, WS_XCUR, 64 * MiB} };
            for (int k = 0; k < 16; ++k) if (jobs[k].after_ph == ph) { Args h = a; h.ph_lo = 100 + k; h.ph_hi = 101 + k; h.hoff = jobs[k].off; h.hbytes = jobs[k].bytes; hipLaunchKernelGGL(mega_fwd, dim3(grid), dim3(NTHREADS), LDS_BYTES, stream, h); }
        }
#endif
    }
#ifdef DBG_HASH
    { Args h = a; h.ph_lo = 200; h.ph_hi = 201; hipLaunchKernelGGL(mega_fwd, dim3(grid), dim3(NTHREADS), LDS_BYTES, stream, h); }
#endif
#endif
}
```

```cpp
#include <hip/hip_runtime.h>
#include <cstdio>
#include <cstdint>

#ifndef N_LAUNCH_MODE
#define N_LAUNCH_MODE 0
#endif
#ifndef DBG_OUTSCALE
#define DBG_OUTSCALE 1.0f
#endif

#define DI __device__ __forceinline__
#define GAS __attribute__((address_space(1)))
#define LAS __attribute__((address_space(3)))
typedef unsigned short bf16;
typedef float f32x4 __attribute__((ext_vector_type(4)));
typedef float f32x2 __attribute__((ext_vector_type(2)));
typedef short bf16x8 __attribute__((ext_vector_type(8)));
typedef unsigned u32x4 __attribute__((ext_vector_type(4)));
typedef unsigned u32x2 __attribute__((ext_vector_type(2)));

constexpr int DM = 2048, NBATCH = 4, SEQ = 2048, T = NBATCH * SEQ, DEPTH = 2;
constexpr int DIN_SRC = 4368;
constexpr int PROJ_LD = 4608;
constexpr int C_U = 0, C_XL = 512, C_GL = 1280, C_Q = 2048, C_K = 2432, C_V = 2816, C_OG = 3584, C_GLOW = 4352;
constexpr int DFF = 5632, DFFE = 7168, NE = 8;
constexpr int NADA = 6;
constexpr float EPS = 1e-6f;
constexpr int MOE_ROWS = 18432;
constexpr int NWAVES = 8, NTHREADS = 512;
constexpr float SC_X = 16.f, SC_W13 = 256.f, SC_H = 16.f, SC_W2 = 512.f;

constexpr size_t MiB = 1u << 20;
constexpr size_t WS_CTL = 0, CTL_BYTES = 1 * MiB;
constexpr size_t WS_MOD = 1 * MiB;
constexpr size_t WS_S5C = 2 * MiB;
constexpr size_t S5C_STRIDE = 512 * 1024, S5C_ABAR = 0, S5C_ABARL = 16384, S5C_BBAR = 32768, S5C_CMAT = 32768 + 131072;
constexpr size_t WS_LRUW = 3 * MiB;
constexpr size_t LRUW_STRIDE = 512 * 1024, LRUW_X = 147456;
constexpr size_t WS_S5E = 4 * MiB;
constexpr size_t WS_ROUTE = 6 * MiB;
constexpr size_t WS_CNTBLK = 6 * MiB + 512 * 1024;
constexpr size_t WS_GAMMA = 7 * MiB;
constexpr size_t WS_WIN = 8 * MiB;
constexpr size_t WS_WOUT = 44 * MiB;
constexpr size_t WS_WGLU = 60 * MiB;
constexpr size_t WS_F13 = 62 * MiB;
constexpr size_t WS_F2 = 106 * MiB;
constexpr size_t WS_M13 = 128 * MiB;
constexpr size_t WS_M2 = 576 * MiB;
constexpr size_t WS_H = 800 * MiB;
constexpr size_t WS_PROJ = 832 * MiB;
constexpr size_t WS_LRUA = 904 * MiB;
constexpr size_t WS_LRUB = 928 * MiB;
constexpr size_t WS_GLAD = 952 * MiB;
constexpr size_t WS_Z = 988 * MiB;
constexpr size_t WS_S5PRE = 996 * MiB;
constexpr size_t WS_MIX = 1012 * MiB;
constexpr size_t WS_X1 = 1044 * MiB;
constexpr size_t WS_XCUR = 1108 * MiB;
constexpr size_t WS_HID = 1172 * MiB;
constexpr size_t WS_AS = 1424 * MiB;
constexpr size_t WS_Y = 1496 * MiB;
constexpr size_t WS_GLAS = WS_HID;
constexpr size_t WS_GLABC = WS_HID + 32 * MiB;
constexpr size_t WS_END = 1640 * MiB;

constexpr int CW_CNT = 64;
constexpr int CW_BAR = 4096;

constexpr int SCR_BYTES = 143360;
constexpr int LDSCTL_OFF = SCR_BYTES;
constexpr int LDS_BYTES = 147456;

#define LDS_WAIT() asm volatile("s_waitcnt lgkmcnt(0)" ::: "memory")
#define VM_WAIT() asm volatile("s_waitcnt vmcnt(0)" ::: "memory")
DI int lane_id() { unsigned m = ~0u; asm volatile("" : "+s"(m)); return (int)__builtin_amdgcn_mbcnt_hi(m, __builtin_amdgcn_mbcnt_lo(m, 0u)); }
DI unsigned pk_bf16(float lo, float hi) { unsigned r; asm("v_cvt_pk_bf16_f32 %0, %1, %2" : "=v"(r) : "v"(lo), "v"(hi)); return r; }
DI bf16 f2bf(float f) { return (bf16)(pk_bf16(f, 0.f) & 0xffffu); }
DI bf16 f2bf_sw(float f) { unsigned u = __builtin_bit_cast(unsigned, f); return (bf16)((u + 0x7fffu + ((u >> 16) & 1u)) >> 16); }
DI float bf2f(unsigned b) { return __builtin_bit_cast(float, b << 16); }
DI float bflo(unsigned w) { return __builtin_bit_cast(float, w << 16); }
DI float bfhi(unsigned w) { return __builtin_bit_cast(float, w & 0xffff0000u); }
template <int O> DI float xor_add(float v) { return v + __builtin_bit_cast(float, __builtin_amdgcn_ds_swizzle(__builtin_bit_cast(int, v), (O << 10) | 0x1f)); }
DI float half_sum(float v) { v = xor_add<1>(v); v = xor_add<2>(v); v = xor_add<4>(v); v = xor_add<8>(v); v = xor_add<16>(v); return v; }
DI float wave_sum(float v) {
    v = half_sum(v);
    return __builtin_bit_cast(float, __builtin_amdgcn_readlane(__builtin_bit_cast(int, v), 0)) + __builtin_bit_cast(float, __builtin_amdgcn_readlane(__builtin_bit_cast(int, v), 32));
}
DI float sigmoidf_(float x) { return __builtin_amdgcn_rcpf(1.f + __expf(-x)); }
DI float siluf_(float x) { return x * __builtin_amdgcn_rcpf(1.f + __expf(-x)); }
DI float gelu_tanh(float y) { const float u = 1.5957691216057308f * (y + 0.044715f * y * y * y); return y * __builtin_amdgcn_rcpf(1.f + __expf(-u)); }
DI float logsigmoidf_(float x) { return fminf(x, 0.f) - log1pf(__expf(-fabsf(x))); }
DI float logsigmoid_fast(float x) { return fminf(x, 0.f) - __logf(1.f + __expf(-fabsf(x))); }

#define XB_TMO      128
#define XB_XCNT(j)  (256  + 64 * (j))
#define XB_XSUB(j)  (1280 + 64 * (j))
#define XB_XGEN(j)  (2304 + 64 * (j))
#define XB_TOP      3328
#define XB_TOPGEN   3392
#define XCD_BAR_WORDS 3456
#define XB_SPIN_CAP (1u << 18)
__device__ __forceinline__ unsigned xb_ld(unsigned* p)              { return __hip_atomic_load(p, __ATOMIC_RELAXED, __HIP_MEMORY_SCOPE_AGENT); }
__device__ __forceinline__ unsigned xb_add(unsigned* p, unsigned v) { asm volatile("" : "+s"(v)); return __hip_atomic_fetch_add(p, v, __ATOMIC_RELAXED, __HIP_MEMORY_SCOPE_AGENT); }
__device__ __forceinline__ unsigned xb_xcc_id() { return (unsigned)__builtin_amdgcn_s_getreg((3 << 11) | 20) & 0xFu; }
#define XB_SPIN(cond, bar) do { unsigned _sp = 0; while (cond) { __builtin_amdgcn_s_sleep(1); \
    if ((++_sp & 255u) == 0u) { if (xb_ld(&(bar)[XB_TMO])) break; if (_sp > XB_SPIN_CAP) { atomicAdd(&(bar)[XB_TMO], 1u); break; } } } } while (0)
struct XcdBarrier { unsigned* bar; unsigned x; volatile LAS unsigned* st; int wave; };
__device__ __forceinline__ XcdBarrier xcd_barrier_post(unsigned* bar, volatile LAS unsigned* st, int wave) {
    XcdBarrier b; b.bar = bar; b.x = xb_xcc_id(); b.st = st; b.wave = wave;
    if (wave == 0 && lane_id() == 0) (void)xb_add(&bar[XB_XCNT(b.x)], 1u);
    return b;
}
__device__ __forceinline__ void xcd_barrier_complete(unsigned* bar, unsigned x, unsigned& nloc, unsigned& nx) {
    const unsigned G = gridDim.x * gridDim.y * gridDim.z;
    unsigned sum, cnt, mine, sp = 0u;
    for (;;) {
        sum = 0u; cnt = 0u; mine = 0u;
#pragma unroll
        for (unsigned j = 0; j < 16; ++j) { const unsigned c = xb_ld(&bar[XB_XCNT(j)]); sum += c; cnt += (c > 0u) ? 1u : 0u; mine = (j == x) ? c : mine; }
        if (sum == G) break;
        __builtin_amdgcn_s_sleep(1);
        if ((++sp & 255u) == 0u) { if (xb_ld(&bar[XB_TMO])) break; if (sp > XB_SPIN_CAP) { atomicAdd(&bar[XB_TMO], 1u); break; } }
    }
    nloc = mine > 0u ? mine : 1u; nx = cnt > 0u ? cnt : 1u;
}
__device__ __forceinline__ void xcd_barrier(const XcdBarrier& b) {
    asm volatile("s_waitcnt vmcnt(0)" ::: "memory");
    __syncthreads();
    if (b.wave == 0 && lane_id() == 0) {
        unsigned* bar = b.bar;
        __builtin_amdgcn_s_waitcnt(0);
        unsigned nloc = b.st[0], nx = b.st[1];
        if (nloc == 0u) { xcd_barrier_complete(bar, b.x, nloc, nx); b.st[0] = nloc; b.st[1] = nx; }
        const unsigned old = xb_add(&bar[XB_XSUB(b.x)], 1u);
        const unsigned gen = old / nloc;
        if (old + 1u == (gen + 1u) * nloc) {
            __builtin_amdgcn_fence(__ATOMIC_RELEASE, "agent");
            asm volatile("s_waitcnt vmcnt(0)" ::: "memory");
            const unsigned og = xb_add(&bar[XB_TOP], 1u);
            const unsigned tg = og / nx;
            if (og + 1u == (tg + 1u) * nx) xb_add(&bar[XB_TOPGEN], 1u);
            else XB_SPIN(xb_ld(&bar[XB_TOPGEN]) == tg, bar);
            __builtin_amdgcn_fence(__ATOMIC_ACQUIRE, "agent");
            xb_add(&bar[XB_XGEN(b.x)], 1u);
            asm volatile("s_waitcnt vmcnt(0)" ::: "memory");
        } else {
            XB_SPIN(xb_ld(&bar[XB_XGEN(b.x)]) == gen, bar);
            __builtin_amdgcn_fence(__ATOMIC_ACQUIRE, "agent");
            asm volatile("s_waitcnt vmcnt(0)" ::: "memory");
        }
    }
    __syncthreads();
}

namespace pg8 {
constexpr int BM = 256, BK = 64, HALF = 128, HTB = HALF * BK * 2, STAGE_BYTES = 8 * HTB, NXCD = 8, WGM = 4;
__host__ __device__ __forceinline__ int lds_byte(int r, int c) { const int st = (r >> 4) * 2 + (c >> 5), rr = r & 15, cc = c & 31, ob = rr * 64 + cc * 2; return st * 1024 + (ob ^ (((ob >> 9) & 1) << 5)); }
__host__ __device__ __forceinline__ void stage_rc(int b_, int& R, int& C) { const unsigned b = (unsigned)b_, st = b >> 10, sb = b & 1023u, swz = sb ^ (((sb >> 9) & 1u) << 5); R = (int)((st >> 1) * 16u + (swz >> 6)); C = (int)((st & 1u) * 32u + ((swz & 63u) >> 1)); }
__host__ __device__ __forceinline__ int perm32(int rho) { const int n = rho >> 4, i = rho & 15; return 8 * (i >> 2) + 4 * n + (i & 3); }

struct Unit { int pm, pn; long boff; int q; };
struct Gemm { const bf16* A; const bf16* Bt; int K; };

__device__ __forceinline__ int xcd_remap(int wgid, int nwg) { const int q = nwg / NXCD, r = nwg % NXCD, xcd = wgid % NXCD, off = wgid / NXCD; return (xcd < r ? xcd * (q + 1) : r * (q + 1) + (xcd - r) * q) + off; }
struct StaticOrder {
    int nM, nN, nwg, G, c;
    __device__ void init(int M, int N, int G_, int c_) { nM = M / BM; nN = N / BM; nwg = nM * nN; G = G_; c = c_; }
    __device__ bool next(int i, Unit& u) const {
        const long L = (long)i * G + c; if (L >= nwg) return false;
        const int wgid = xcd_remap((int)L, nwg);
        const int nig = WGM * nN, gid = wgid / nig, fm = gid * WGM, gsz = (nM - fm) < WGM ? (nM - fm) : WGM;
        u.pm = fm + ((wgid % nig) % gsz); u.pn = (wgid % nig) / gsz; u.boff = 0; return true;
    }
};
struct GroupedOrder {
    volatile LAS unsigned* ts; int nN, nwg, lim, G, c; long estride;
    __device__ void init(volatile LAS unsigned* ts_, int N, int G_, int c_, long estride_, int lim_ = 1 << 30) { ts = ts_; nN = N / BM; nwg = __builtin_amdgcn_readfirstlane((int)ts_[8] * nN); lim = nwg < lim_ ? nwg : lim_; G = G_; c = c_; estride = estride_; }
    __device__ bool next(int i, Unit& u) const {
        const long L = (long)i * G + c; if (L >= lim) return false;
        const int wgid = xcd_remap((int)L, nwg);
        int e = 0;
#pragma unroll
        for (int k = 1; k < 8; ++k) if (wgid >= (int)ts[k] * nN) e = k;
        const int t0 = (int)ts[e], te = (int)ts[e + 1] - t0, Lp = wgid - t0 * nN;
        u.pn = __builtin_amdgcn_readfirstlane(Lp / te); u.pm = __builtin_amdgcn_readfirstlane(t0 + Lp % te); u.boff = (long)__builtin_amdgcn_readfirstlane(e) * estride; return true;
    }
};

struct TailOrder {
    volatile LAS unsigned* ts; int nN, nwg, first, G, c; long estride, qstride;
    __device__ void init(volatile LAS unsigned* ts_, int N, int first_, int G_, int c_, long estride_, long qstride_) { ts = ts_; nN = N / BM; nwg = __builtin_amdgcn_readfirstlane((int)ts_[8] * nN); first = first_; G = G_; c = c_; estride = estride_; qstride = qstride_; }
    __device__ bool next(int i, Unit& u) const {
        const int s = i * G + c, L = first + (s & 7) + 8 * (s >> 5), q = (s >> 3) & 3;
        if (L >= nwg) return false;
        const int wgid = xcd_remap(L, nwg);
        int e = 0;
#pragma unroll
        for (int k = 1; k < 8; ++k) if (wgid >= (int)ts[k] * nN) e = k;
        const int t0 = (int)ts[e], te = (int)ts[e + 1] - t0, Lp = wgid - t0 * nN;
        u.pn = __builtin_amdgcn_readfirstlane(Lp / te); u.pm = __builtin_amdgcn_readfirstlane(t0 + Lp % te); u.q = q; u.boff = (long)__builtin_amdgcn_readfirstlane(e) * estride + (long)q * qstride; return true;
    }
};

__device__ __forceinline__ void glds16(const char* sbase, unsigned voff, unsigned m0v) {
    unsigned keep;
    asm volatile("s_mov_b32 %0, m0\n\ts_mov_b32 m0, %3\n\ts_nop 0\n\tglobal_load_lds_dwordx4 %1, %2\n\ts_mov_b32 m0, %0" : "=&s"(keep) : "v"(voff), "s"(sbase), "s"(m0v) : "memory");
}
template <class Epi, class Sched>
__device__ __forceinline__ void gemm_phase(LAS unsigned char* lds, const Gemm g, const Sched& S, const Epi& E, const int wid) {
    int lane = lane_id(); asm volatile("" : "+v"(lane));
    const int tid = wid * 64 + lane, wr = wid >> 2, wc = wid & 3, fr = lane & 15, fq = lane >> 4;
    const int K = g.K, nt = K / BK;
    unsigned voffA; { int R, C; stage_rc(tid * 16, R, C); voffA = (unsigned)(R * K + C) * 2u; }
    const size_t rstep = (size_t)64 * K * 2;
    const size_t kstep = (size_t)(BK * 2);
    const size_t hstep = (size_t)HALF * K * 2;
    const size_t tstep = 2 * hstep;
    const unsigned ldsb = (unsigned)(unsigned long)lds + (unsigned)wid * 1024u;
    const int aoff = lds_byte(wr * 64 + fr, fq * 8), boff = lds_byte(wc * 32 + fr, fq * 8);
#define PG8_SA(b, h) (((b) * 2 + (h)) * HTB)
#define PG8_SB(b, h) ((4 + (b) * 2 + (h)) * HTB)
#define PG8_STAGE(bufoff, gbase) do { _Pragma("unroll") for (int _i = 0; _i < 2; ++_i) glds16((const char*)(gbase) + _i * rstep, voffA, ldsb + (unsigned)((bufoff) + _i * 8192)); } while (0)
#define PG8_LDA(dst, b, h) do { _Pragma("unroll") for (int m = 0; m < 4; ++m) _Pragma("unroll") for (int k = 0; k < 2; ++k) dst[m][k] = *(const LAS bf16x8*)(lds + PG8_SA(b, h) + aoff + m * 2048 + k * 1024); } while (0)
#define PG8_LDB(dst, b, h) do { _Pragma("unroll") for (int n = 0; n < 2; ++n) _Pragma("unroll") for (int k = 0; k < 2; ++k) dst[n][k] = *(const LAS bf16x8*)(lds + PG8_SB(b, h) + boff + n * 2048 + k * 1024); } while (0)
#define PG8_MMA(ai, bj, At, Bt) do { __builtin_amdgcn_s_setprio(1); _Pragma("unroll") for (int m = 0; m < 4; ++m) _Pragma("unroll") for (int n = 0; n < 2; ++n) _Pragma("unroll") for (int k = 0; k < 2; ++k) \
        acc[ai][bj][m][n] = __builtin_amdgcn_mfma_f32_16x16x32_bf16(Bt[n][k], At[m][k], acc[ai][bj][m][n], 0, 0, 0); __builtin_amdgcn_s_setprio(0); } while (0)
#define PG8_WAIT_V(n) asm volatile("s_waitcnt vmcnt(" #n ")" ::: "memory")
#define PG8_WAIT_L(n) asm volatile("s_waitcnt lgkmcnt(" #n ")" ::: "memory")
#define PG8_BAR __builtin_amdgcn_s_barrier()
#define PG8_SCHED __builtin_amdgcn_sched_barrier(0)
    Unit cur, nxt; int ui = 0;
    if (!S.next(0, cur)) return;
    f32x4 acc[2][2][4][2];
#pragma unroll
    for (int a = 0; a < 2; ++a)
#pragma unroll
        for (int b = 0; b < 2; ++b)
#pragma unroll
            for (int m = 0; m < 4; ++m)
#pragma unroll
                for (int n = 0; n < 2; ++n) acc[a][b][m][n] = (f32x4){0.f, 0.f, 0.f, 0.f};
    bf16x8 At[4][2], B0[2][2], B1[2][2];
    const char* cA = (const char*)g.A + (size_t)cur.pm * tstep; const char* cB = (const char*)g.Bt + cur.boff + (size_t)cur.pn * tstep;
    PG8_STAGE(PG8_SB(0, 0), cB); PG8_STAGE(PG8_SB(0, 1), cB + hstep); PG8_STAGE(PG8_SA(0, 0), cA); PG8_STAGE(PG8_SA(0, 1), cA + hstep);
    if (wr == 1) PG8_BAR;
    PG8_WAIT_V(2); PG8_BAR;
    PG8_STAGE(PG8_SB(1, 0), cB + kstep); PG8_STAGE(PG8_SA(1, 0), cA + kstep); PG8_STAGE(PG8_SB(1, 1), cB + hstep + kstep);
    PG8_WAIT_V(6); PG8_BAR;
    for (;;) {
        const bool has_next = S.next(ui + 1, nxt);
        const char* nA = has_next ? (const char*)g.A + (size_t)nxt.pm * tstep : cA; const char* nB = has_next ? (const char*)g.Bt + nxt.boff + (size_t)nxt.pn * tstep : cB;
        for (int t = 0; t < nt; t += 2) {
            const bool last = (t == nt - 2);
            const char* a1 = cA + (size_t)(t + 1) * kstep;
            const char* a2 = last ? nA : cA + (size_t)(t + 2) * kstep; const char* b2 = last ? nB : cB + (size_t)(t + 2) * kstep;
            const char* a3 = a2 + kstep; const char* b3 = b2 + kstep;
            PG8_LDB(B0, 0, 0); PG8_LDB(B1, 0, 1); PG8_SCHED; PG8_LDA(At, 0, 0); PG8_STAGE(PG8_SA(1, 1), a1 + hstep);
            PG8_WAIT_V(8); PG8_WAIT_L(0); PG8_BAR; PG8_MMA(0, 0, At, B0); PG8_MMA(0, 1, At, B1); PG8_BAR; PG8_SCHED;
            PG8_LDA(At, 0, 1); PG8_STAGE(PG8_SB(0, 0), b2); PG8_STAGE(PG8_SB(0, 1), b2 + hstep); PG8_STAGE(PG8_SA(0, 0), a2);
            PG8_WAIT_V(8); PG8_WAIT_L(0); PG8_BAR; PG8_MMA(1, 0, At, B0); PG8_MMA(1, 1, At, B1); PG8_BAR; PG8_SCHED;
            PG8_LDB(B0, 1, 0); PG8_LDB(B1, 1, 1); PG8_SCHED; PG8_LDA(At, 1, 0); PG8_STAGE(PG8_SA(0, 1), a2 + hstep);
            PG8_WAIT_V(8); PG8_WAIT_L(0); PG8_BAR; PG8_MMA(0, 0, At, B0); PG8_MMA(0, 1, At, B1); PG8_BAR; PG8_SCHED;
            PG8_LDA(At, 1, 1); PG8_STAGE(PG8_SB(1, 0), b3); PG8_STAGE(PG8_SB(1, 1), b3 + hstep); PG8_STAGE(PG8_SA(1, 0), a3);
            PG8_WAIT_V(8); PG8_WAIT_L(0); PG8_BAR; PG8_MMA(1, 0, At, B0); PG8_MMA(1, 1, At, B1); PG8_BAR; PG8_SCHED;
        }
        if (wr == 0) PG8_BAR;
        { int lz = lane_id(); asm volatile("" : "+v"(lz)); E(acc, cur, wid >> 2, wid & 3, lz & 15, lz >> 4); }
        if (!has_next) break;
        { float z0 = 0.f; asm volatile("" : "+v"(z0));
#pragma unroll
        for (int a = 0; a < 2; ++a)
#pragma unroll
            for (int b = 0; b < 2; ++b)
#pragma unroll
                for (int m = 0; m < 4; ++m)
#pragma unroll
                    for (int n = 0; n < 2; ++n) acc[a][b][m][n] = (f32x4){z0, z0, z0, z0}; }
        cur = nxt; cA = nA; cB = nB; ++ui;
        if (wr == 1) PG8_BAR;
    }
    PG8_WAIT_V(0);
    PG8_BAR;
#undef PG8_SA
#undef PG8_SB
#undef PG8_STAGE
#undef PG8_LDA
#undef PG8_LDB
#undef PG8_MMA
#undef PG8_WAIT_V
#undef PG8_WAIT_L
#undef PG8_BAR
#undef PG8_SCHED
}

typedef int i32x8 __attribute__((ext_vector_type(8)));
typedef int i32x4 __attribute__((ext_vector_type(4)));
__device__ __forceinline__ i32x8 ld32(const LAS unsigned char* p) { const i32x4 a = *(const LAS i32x4*)p, b = *(const LAS i32x4*)(p + 1024); return __builtin_shufflevector(a, b, 0, 1, 2, 3, 4, 5, 6, 7); }
template <bool NARROW = false, class Epi, class Sched>
__device__ __forceinline__ void gemm_phase8(LAS unsigned char* lds, const Gemm g, const Sched& S, const Epi& E, const int wid) {
    int lane = lane_id(); asm volatile("" : "+v"(lane));
    const int tid = wid * 64 + lane, wr = wid >> 2, wc = wid & 3, fr = lane & 15, fq = lane >> 4;
    const int K = g.K, nt = K / BK;
    unsigned voffA; { int R, C; stage_rc(tid * 16, R, C); voffA = (unsigned)(R * K + C) * 2u; }
    const size_t rstep = (size_t)64 * K * 2;
    const size_t kstep = (size_t)(BK * 2);
    const size_t hstep = (size_t)HALF * K * 2;
    const size_t tstep = 2 * hstep;
    const size_t bh = NARROW ? 0 : hstep;
    const unsigned ldsb = (unsigned)(unsigned long)lds + (unsigned)wid * 1024u;
    const int aoff = lds_byte(wr * 64 + fr, fq * 8), boff = NARROW ? lds_byte(wc * 16 + fr, fq * 8) : lds_byte(wc * 32 + fr, fq * 8);
#define PG8_SA(b, h) (((b) * 2 + (h)) * HTB)
#define PG8_SB(b, h) ((4 + (b) * 2 + (h)) * HTB)
#define PG8_STAGE(bufoff, gbase) do { _Pragma("unroll") for (int _i = 0; _i < 2; ++_i) glds16((const char*)(gbase) + _i * rstep, voffA, ldsb + (unsigned)((bufoff) + _i * 8192)); } while (0)
#define PG8_LDA(dst, b, h) do { _Pragma("unroll") for (int m = 0; m < 4; ++m) dst[m] = ld32(lds + PG8_SA(b, h) + aoff + m * 2048); } while (0)
#define PG8_LDB(dst, b, h) do { _Pragma("unroll") for (int n = 0; n < (NARROW ? 1 : 2); ++n) dst[n] = ld32(lds + PG8_SB(b, h) + boff + n * 2048); } while (0)
#define PG8_MMA(ai, bj, At, Bt) do { __builtin_amdgcn_s_setprio(1); _Pragma("unroll") for (int m = 0; m < 4; ++m) _Pragma("unroll") for (int n = 0; n < (NARROW ? 1 : 2); ++n) \
        asm volatile("v_mfma_scale_f32_16x16x128_f8f6f4 %0, %1, %2, %0, %3, %3 op_sel_hi:[0,0,0]" : "+v"(acc[ai][bj][m][n]) : "v"(Bt[n]), "v"(At[m]), "v"(mxscale)); __builtin_amdgcn_s_setprio(0); } while (0)
#define PG8_WAIT_V(n) asm volatile("s_waitcnt vmcnt(" #n ")" ::: "memory")
#define PG8_WAIT_L(n) asm volatile("s_waitcnt lgkmcnt(" #n ")" ::: "memory")
#define PG8_BAR __builtin_amdgcn_s_barrier()
#define PG8_SCHED __builtin_amdgcn_sched_barrier(0)
    const int mxscale = 0x7F7F7F7F;
    Unit cur, nxt; int ui = 0;
    if (!S.next(0, cur)) return;
    f32x4 acc[2][2][4][2];
#pragma unroll
    for (int a = 0; a < 2; ++a)
#pragma unroll
        for (int b = 0; b < 2; ++b)
#pragma unroll
            for (int m = 0; m < 4; ++m)
#pragma unroll
                for (int n = 0; n < 2; ++n) acc[a][b][m][n] = (f32x4){0.f, 0.f, 0.f, 0.f};
    i32x8 At[4], B0[2], B1[2];
    const char* cA = (const char*)g.A + (size_t)cur.pm * tstep; const char* cB = (const char*)g.Bt + cur.boff + (size_t)cur.pn * tstep;
    PG8_STAGE(PG8_SB(0, 0), cB); PG8_STAGE(PG8_SB(0, 1), cB + bh); PG8_STAGE(PG8_SA(0, 0), cA); PG8_STAGE(PG8_SA(0, 1), cA + hstep);
    if (wr == 1) PG8_BAR;
    PG8_WAIT_V(2); PG8_BAR;
    PG8_STAGE(PG8_SB(1, 0), cB + kstep); PG8_STAGE(PG8_SA(1, 0), cA + kstep); PG8_STAGE(PG8_SB(1, 1), cB + bh + kstep);
    PG8_WAIT_V(6); PG8_BAR;
    for (;;) {
        const bool has_next = S.next(ui + 1, nxt);
        const char* nA = has_next ? (const char*)g.A + (size_t)nxt.pm * tstep : cA; const char* nB = has_next ? (const char*)g.Bt + nxt.boff + (size_t)nxt.pn * tstep : cB;
        for (int t = 0; t < nt; t += 2) {
            const bool last = (t == nt - 2);
            const char* a1 = cA + (size_t)(t + 1) * kstep;
            const char* a2 = last ? nA : cA + (size_t)(t + 2) * kstep; const char* b2 = last ? nB : cB + (size_t)(t + 2) * kstep;
            const char* a3 = a2 + kstep; const char* b3 = b2 + kstep;
            PG8_LDB(B0, 0, 0); if constexpr (!NARROW) PG8_LDB(B1, 0, 1); PG8_SCHED; PG8_LDA(At, 0, 0); PG8_STAGE(PG8_SA(1, 1), a1 + hstep);
            PG8_WAIT_V(8); PG8_WAIT_L(0); PG8_BAR; PG8_MMA(0, 0, At, B0); if constexpr (!NARROW) PG8_MMA(0, 1, At, B1); PG8_BAR; PG8_SCHED;
            PG8_LDA(At, 0, 1); PG8_STAGE(PG8_SB(0, 0), b2); PG8_STAGE(PG8_SB(0, 1), b2 + bh); PG8_STAGE(PG8_SA(0, 0), a2);
            PG8_WAIT_V(8); PG8_WAIT_L(0); PG8_BAR; PG8_MMA(1, 0, At, B0); if constexpr (!NARROW) PG8_MMA(1, 1, At, B1); PG8_BAR; PG8_SCHED;
            PG8_LDB(B0, 1, 0); if constexpr (!NARROW) PG8_LDB(B1, 1, 1); PG8_SCHED; PG8_LDA(At, 1, 0); PG8_STAGE(PG8_SA(0, 1), a2 + hstep);
            PG8_WAIT_V(8); PG8_WAIT_L(0); PG8_BAR; PG8_MMA(0, 0, At, B0); if constexpr (!NARROW) PG8_MMA(0, 1, At, B1); PG8_BAR; PG8_SCHED;
            PG8_LDA(At, 1, 1); PG8_STAGE(PG8_SB(1, 0), b3); PG8_STAGE(PG8_SB(1, 1), b3 + bh); PG8_STAGE(PG8_SA(1, 0), a3);
            PG8_WAIT_V(8); PG8_WAIT_L(0); PG8_BAR; PG8_MMA(1, 0, At, B0); if constexpr (!NARROW) PG8_MMA(1, 1, At, B1); PG8_BAR; PG8_SCHED;
        }
        if (wr == 0) PG8_BAR;
        asm volatile("s_nop 15\n\ts_nop 15" ::: "memory");
        { int lz = lane_id(); asm volatile("" : "+v"(lz)); E(acc, cur, wid >> 2, wid & 3, lz & 15, lz >> 4); }
        if (!has_next) break;
        { float z0 = 0.f; asm volatile("" : "+v"(z0));
#pragma unroll
        for (int a = 0; a < 2; ++a)
#pragma unroll
            for (int b = 0; b < 2; ++b)
#pragma unroll
                for (int m = 0; m < 4; ++m)
#pragma unroll
                    for (int n = 0; n < 2; ++n) acc[a][b][m][n] = (f32x4){z0, z0, z0, z0}; }
        cur = nxt; cA = nA; cB = nB; ++ui;
        if (wr == 1) PG8_BAR;
    }
    PG8_WAIT_V(0);
    PG8_BAR;
#undef PG8_SA
#undef PG8_SB
#undef PG8_STAGE
#undef PG8_LDA
#undef PG8_LDB
#undef PG8_MMA
#undef PG8_WAIT_V
#undef PG8_WAIT_L
#undef PG8_BAR
#undef PG8_SCHED
}

struct EpiBf16Perm {
    bf16* O; int ldc;
    __device__ __forceinline__ void operator()(const f32x4 (&acc)[2][2][4][2], const Unit& u, int wr, int wc, int fr, int fq) const {
        const int row0 = u.pm * BM + wr * 64 + fr, col0 = u.pn * BM + wc * 32 + 8 * fq;
#pragma unroll
        for (int ai = 0; ai < 2; ++ai)
#pragma unroll
            for (int m = 0; m < 4; ++m) { bf16* rowp = O + (size_t)(row0 + ai * HALF + m * 16) * ldc + col0;
#pragma unroll
                for (int bj = 0; bj < 2; ++bj) { const f32x4 v0 = acc[ai][bj][m][0], v1 = acc[ai][bj][m][1];
                    u32x4 w; w.x = pk_bf16(v0[0], v0[1]); w.y = pk_bf16(v0[2], v0[3]); w.z = pk_bf16(v1[0], v1[1]); w.w = pk_bf16(v1[2], v1[3]);
                    *(u32x4*)(rowp + bj * HALF) = w; } }
    }
};
struct EpiSwiglu {
    bf16* O; int ldo;
    __device__ __forceinline__ void operator()(const f32x4 (&acc)[2][2][4][2], const Unit& u, int wr, int wc, int fr, int fq) const {
        const int row0 = u.pm * BM + wr * 64 + fr, col0 = u.pn * HALF + wc * 16 + 4 * fq;
#pragma unroll
        for (int ai = 0; ai < 2; ++ai)
#pragma unroll
            for (int m = 0; m < 4; ++m) { bf16* rowp = O + (size_t)(row0 + ai * HALF + m * 16) * ldo + col0;
#pragma unroll
                for (int bj = 0; bj < 2; ++bj) { const f32x4 a = acc[ai][bj][m][0], b = acc[ai][bj][m][1];
                    u32x2 w; w.x = pk_bf16(siluf_(a[0]) * b[0], siluf_(a[1]) * b[1]); w.y = pk_bf16(siluf_(a[2]) * b[2], siluf_(a[3]) * b[3]);
                    *(u32x2*)(rowp + bj * 64) = w; } }
    }
};
DI unsigned pk4_fp8(float a, float b, float c, float d) {
    float cm = 448.f; asm volatile("" : "+s"(cm));
    a = __builtin_amdgcn_fmed3f(a, -cm, cm); b = __builtin_amdgcn_fmed3f(b, -cm, cm); c = __builtin_amdgcn_fmed3f(c, -cm, cm); d = __builtin_amdgcn_fmed3f(d, -cm, cm);
    int w = __builtin_amdgcn_cvt_pk_fp8_f32(a, b, 0, false); w = __builtin_amdgcn_cvt_pk_fp8_f32(c, d, w, true); return (unsigned)w; }
struct EpiSwiglu8 {
    unsigned char* O; int ldo; float inv, oscale;
    __device__ __forceinline__ void operator()(const f32x4 (&acc)[2][2][4][2], const Unit& u, int wr, int wc, int fr, int fq) const {
        const int row0 = u.pm * BM + wr * 64 + fr, col0 = u.pn * HALF + wc * 16 + 4 * fq;
#pragma unroll
        for (int ai = 0; ai < 2; ++ai)
#pragma unroll
            for (int m = 0; m < 4; ++m) { unsigned char* rowp = O + (size_t)(row0 + ai * HALF + m * 16) * ldo + col0;
#pragma unroll
                for (int bj = 0; bj < 2; ++bj) { const f32x4 a = acc[ai][bj][m][0] * inv, b = acc[ai][bj][m][1] * (inv * oscale);
                    *(unsigned*)(rowp + bj * 64) = pk4_fp8(siluf_(a[0]) * b[0], siluf_(a[1]) * b[1], siluf_(a[2]) * b[2], siluf_(a[3]) * b[3]); } }
    }
};
struct EpiGlu {
    float* O; const float* bias;
    __device__ __forceinline__ void operator()(const f32x4 (&acc)[2][2][4][2], const Unit& u, int wr, int wc, int fr, int fq) const {
        const int row0 = u.pm * BM + wr * 64 + fr, col0 = u.pn * HALF + wc * 16 + 4 * fq;
        f32x4 bv[2], bg[2];
#pragma unroll
        for (int bj = 0; bj < 2; ++bj) { bv[bj] = *(const f32x4*)(bias + col0 + bj * 64); bg[bj] = *(const f32x4*)(bias + 512 + col0 + bj * 64); }
#pragma unroll
        for (int ai = 0; ai < 2; ++ai)
#pragma unroll
            for (int m = 0; m < 4; ++m) { float* rowp = O + (size_t)(row0 + ai * HALF + m * 16) * 512 + col0;
#pragma unroll
                for (int bj = 0; bj < 2; ++bj) { const f32x4 a = acc[ai][bj][m][0] + bv[bj], b = acc[ai][bj][m][1] + bg[bj];
                    f32x4 o; o[0] = a[0] * sigmoidf_(b[0]); o[1] = a[1] * sigmoidf_(b[1]); o[2] = a[2] * sigmoidf_(b[2]); o[3] = a[3] * sigmoidf_(b[3]);
                    *(f32x4*)(rowp + bj * 64) = o; } }
    }
};
struct EpiResid {
    float* O; const float* X; const float* gate; float scale;
    __device__ __forceinline__ void operator()(const f32x4 (&acc)[2][2][4][2], const Unit& u, int wr, int wc, int fr, int fq) const {
        const int row0 = u.pm * BM + wr * 64 + fr, col0 = u.pn * BM + wc * 32 + 4 * fq;
        const float* gp = gate + (size_t)(u.pm >> 3) * (NADA * DM) + col0;
        f32x4 gv[2][2];
#pragma unroll
        for (int bj = 0; bj < 2; ++bj)
#pragma unroll
            for (int n = 0; n < 2; ++n) gv[bj][n] = *(const f32x4*)(gp + bj * HALF + n * 16) * scale;
#pragma unroll
        for (int ai = 0; ai < 2; ++ai)
#pragma unroll
            for (int m = 0; m < 4; ++m) { const size_t off = (size_t)(row0 + ai * HALF + m * 16) * DM + col0;
#pragma unroll
                for (int bj = 0; bj < 2; ++bj)
#pragma unroll
                    for (int n = 0; n < 2; ++n) { const f32x4 xv = *(const f32x4*)(X + off + bj * HALF + n * 16);
                        *(f32x4*)(O + off + bj * HALF + n * 16) = xv + gv[bj][n] * acc[ai][bj][m][n]; } }
    }
};
struct EpiOut {
    float* O; const float* X; const float* gate; float scale;
    __device__ __forceinline__ void operator()(const f32x4 (&acc)[2][2][4][2], const Unit& u, int wr, int wc, int fr, int fq) const {
        const int row0 = u.pm * BM + wr * 64 + fr, col0 = u.pn * BM + wc * 32 + 4 * fq;
        f32x4 gv[2][2];
        if (X) { const float* gp = gate + (size_t)(u.pm >> 3) * (NADA * DM) + col0;
#pragma unroll
            for (int bj = 0; bj < 2; ++bj)
#pragma unroll
                for (int n = 0; n < 2; ++n) gv[bj][n] = *(const f32x4*)(gp + bj * HALF + n * 16) * scale; }
        else {
#pragma unroll
            for (int bj = 0; bj < 2; ++bj)
#pragma unroll
                for (int n = 0; n < 2; ++n) gv[bj][n] = (f32x4){scale, scale, scale, scale}; }
#pragma unroll
        for (int ai = 0; ai < 2; ++ai)
#pragma unroll
            for (int m = 0; m < 4; ++m) { const size_t off = (size_t)(row0 + ai * HALF + m * 16) * DM + col0;
#pragma unroll
                for (int bj = 0; bj < 2; ++bj)
#pragma unroll
                    for (int n = 0; n < 2; ++n) { f32x4 o = gv[bj][n] * acc[ai][bj][m][n]; if (X) o += *(const f32x4*)(X + off + bj * HALF + n * 16);
                        *(f32x4*)(O + off + bj * HALF + n * 16) = o; } }
    }
};
struct EpiF32 {
    float* O; int ldc; float scale;
    __device__ __forceinline__ void operator()(const f32x4 (&acc)[2][2][4][2], const Unit& u, int wr, int wc, int fr, int fq) const {
        const int row0 = u.pm * BM + wr * 64 + fr, col0 = u.pn * BM + wc * 32 + 4 * fq;
#pragma unroll
        for (int ai = 0; ai < 2; ++ai)
#pragma unroll
            for (int m = 0; m < 4; ++m) { float* rowp = O + (size_t)(row0 + ai * HALF + m * 16) * ldc + col0;
#pragma unroll
                for (int bj = 0; bj < 2; ++bj)
#pragma unroll
                    for (int n = 0; n < 2; ++n) *(f32x4*)(rowp + bj * HALF + n * 16) = acc[ai][bj][m][n] * scale; }
    }
};
struct EpiF32Narrow {
    float* O; int ldc; float scale;
    __device__ __forceinline__ void operator()(const f32x4 (&acc)[2][2][4][2], const Unit& u, int wr, int wc, int fr, int fq) const {
        const int row0 = u.pm * BM + wr * 64 + fr, col0 = u.pn * BM + 64 * u.q + wc * 16 + 4 * fq;
#pragma unroll
        for (int ai = 0; ai < 2; ++ai)
#pragma unroll
            for (int m = 0; m < 4; ++m) *(f32x4*)(O + (size_t)(row0 + ai * HALF + m * 16) * ldc + col0) = acc[ai][0][m][0] * scale;
    }
};
}

struct Args { const float* in[38]; float* out; unsigned char* ws; unsigned long long hoff, hbytes; int ph_lo, ph_hi, li, pad; };
enum { I_X = 0, I_C, I_ADAW, I_ADAB, I_NMIXG, I_NFFNG, I_WIN, I_S5ARE, I_S5AIM, I_S5LOGDT, I_S5BRE, I_S5BIM, I_S5CRE, I_S5CIM, I_S5D, I_S5WGLU, I_S5BGLU, I_S5NG,
       I_LCONVW, I_LCONVB, I_LWA, I_LBA, I_LWX, I_LBX, I_LLAM, I_LNG, I_GWG2, I_GBG2, I_GHG, I_WOUT, I_F1, I_F3, I_F2, I_ROUTER, I_M1, I_M3, I_M2, I_FNG };

#define GAS __attribute__((address_space(1)))
template <class T> DI T* as_global(T* p) { return (T*)(GAS T*)p; }
DI const float* INP(const Args& a, int i) { asm volatile("" : "+s"(i)); return as_global(a.in[i]); }
struct Frame {
    LAS unsigned char* lds;
    volatile LAS unsigned* MISC;
    unsigned* ctl;
    GAS unsigned char* ws;
    int tid, lane, wave, G, bid;
};

DI void conv_item(const float* src0, const float* src1, int ldsrc, int K, bf16* dst, int kb, int pb, int mode, LAS float* scr, int lane) {
    const int p = pb * 64 + lane, g = p >> 5, rho = p & 31, n = rho >> 4, i = rho & 15;
    const float* sp = src0; bool valid = true;
    if (mode == 0) sp = src0 + p;
    else if (mode == 1) { const int lc = (g << 5) + pg8::perm32(rho); const int sc = lc < 3584 ? lc : (lc < 4352 ? lc + 16 : (lc < 4368 ? lc - 4352 + 3584 : -1)); valid = sc >= 0; sp = src0 + (valid ? sc : 0); }
    else if (mode == 2) sp = (n ? src1 : src0) + 16 * g + i;
    else sp = src0 + n * 512 + 16 * g + i;
    const int k0 = kb * 64;
    sp += (size_t)k0 * ldsrc;
#pragma unroll 16
    for (int kk = 0; kk < 64; ++kk) { const float v = valid ? sp[(size_t)kk * ldsrc] : 0.f; scr[kk * 65 + lane] = v; }
    LDS_WAIT();
    const int c = lane & 7;
#pragma unroll
    for (int j = 0; j < 8; ++j) { const int rr = (lane >> 3) + 8 * j; const LAS float* s = scr + (8 * c) * 65 + rr;
        u32x4 o; o.x = pk_bf16(s[0 * 65], s[1 * 65]); o.y = pk_bf16(s[2 * 65], s[3 * 65]); o.z = pk_bf16(s[4 * 65], s[5 * 65]); o.w = pk_bf16(s[6 * 65], s[7 * 65]);
        *(u32x4*)(dst + (size_t)(pb * 64 + rr) * K + k0 + 8 * c) = o; }
    LDS_WAIT();
}

template <bool GATED>
DI void conv_item8(const float* src0, const float* src1, int ldsrc, int K8, unsigned char* dst, int kb, int cb, float scale, LAS unsigned* scr, int lane) {
    constexpr int NC = GATED ? 128 : 64, ST = NC + 1;
    const int k0 = kb * 128;
    const float* p0 = src0 + (size_t)k0 * ldsrc + 64 * cb + lane;
    const float* p1 = GATED ? src1 + (size_t)k0 * ldsrc + 64 * cb + lane : src0;
#pragma unroll 4
    for (int kq = 0; kq < 32; ++kq) {
        const float* r0 = p0 + (size_t)(4 * kq) * ldsrc;
        scr[kq * ST + lane] = pg8::pk4_fp8(r0[0] * scale, r0[ldsrc] * scale, r0[2 * (size_t)ldsrc] * scale, r0[3 * (size_t)ldsrc] * scale);
        if (GATED) { const float* r1 = p1 + (size_t)(4 * kq) * ldsrc;
            scr[kq * ST + 64 + lane] = pg8::pk4_fp8(r1[0] * scale, r1[ldsrc] * scale, r1[2 * (size_t)ldsrc] * scale, r1[3 * (size_t)ldsrc] * scale); }
    }
    LDS_WAIT();
    const int c = lane & 7;
#pragma unroll
    for (int j = 0; j < NC / 8; ++j) { const int rr = (lane >> 3) + 8 * j;
        const int col = GATED ? (((rr >> 4) & 1) * 64 + (rr >> 5) * 16 + (rr & 15)) : rr;
        const LAS unsigned* q = scr + (4 * c) * ST + col;
        u32x4 o; o.x = q[0]; o.y = q[ST]; o.z = q[2 * ST]; o.w = q[3 * ST];
        *(u32x4*)(dst + (size_t)(NC * cb + rr) * K8 + k0 + 16 * c) = o; }
    LDS_WAIT();
}

DI void sincos_d(double x, double& s, double& c) {
    const double k = rint(x * 0.63661977236758134308);
    const double r = fma(-k, 6.123233995736766e-17, fma(-k, 1.5707963267948966, x));
    const double r2 = r * r;
    double sp = -1.0 / 1307674368000.0;
    sp = fma(sp, r2, 1.0 / 6227020800.0); sp = fma(sp, r2, -1.0 / 39916800.0); sp = fma(sp, r2, 1.0 / 362880.0); sp = fma(sp, r2, -1.0 / 5040.0); sp = fma(sp, r2, 1.0 / 120.0); sp = fma(sp, r2, -1.0 / 6.0); sp = fma(sp, r2, 1.0);
    const double sr = sp * r;
    double cp = 1.0 / 20922789888000.0;
    cp = fma(cp, r2, -1.0 / 87178291200.0); cp = fma(cp, r2, 1.0 / 479001600.0); cp = fma(cp, r2, -1.0 / 3628800.0); cp = fma(cp, r2, 1.0 / 40320.0); cp = fma(cp, r2, -1.0 / 720.0); cp = fma(cp, r2, 1.0 / 24.0); cp = fma(cp, r2, -0.5); cp = fma(cp, r2, 1.0);
    const int q = ((int)k) & 3;
    s = (q == 0) ? sr : (q == 1) ? cp : (q == 2) ? -sr : -cp;
    c = (q == 0) ? cp : (q == 1) ? -sr : (q == 2) ? -cp : sr;
}

DI void p0_s5_consts(const Frame& F, const Args& a) {
    const int gt = F.bid * NTHREADS + F.tid;
    if (gt >= DEPTH * 32 * 64) return;
    const int l = gt >> 11, g = (gt >> 6) & 31, p = gt & 63;
    unsigned char* base = (unsigned char*)(F.ws + WS_S5C + (size_t)l * S5C_STRIDE);
    const double ar = INP(a, I_S5ARE)[(l * 32 + g) * 64 + p], ai = INP(a, I_S5AIM)[(l * 32 + g) * 64 + p];
    const double dt = exp((double)INP(a, I_S5LOGDT)[l * 32 + g]);
    const double mag = exp(ar * dt); double sn, cs; sincos_d(ai * dt, sn, cs);
    const double abr = mag * cs, abi = mag * sn;
    const double nr = abr - 1.0, ni = abi, den = ar * ar + ai * ai;
    const double fre = (nr * ar + ni * ai) / den, fim = (ni * ar - nr * ai) / den;
    float* abar = (float*)(base + S5C_ABAR); abar[(g * 64 + p) * 2] = (float)abr; abar[(g * 64 + p) * 2 + 1] = (float)abi;
    double pr = abr, pi = abi;
#pragma unroll
    for (int s = 0; s < 6; ++s) { const double tr = pr * pr - pi * pi, ti = 2.0 * pr * pi; pr = tr; pi = ti; }
    float* abarL = (float*)(base + S5C_ABARL); abarL[(g * 64 + p) * 2] = (float)pr; abarL[(g * 64 + p) * 2 + 1] = (float)pi;
    bf16* bbar = (bf16*)(base + S5C_BBAR);
    const float* bre = INP(a, I_S5BRE) + ((size_t)(l * 32 + g) * 64 + p) * 16; const float* bim = INP(a, I_S5BIM) + ((size_t)(l * 32 + g) * 64 + p) * 16;
#pragma unroll
    for (int c = 0; c < 16; ++c) { const double br = bre[c], bi = bim[c];
        bbar[((size_t)g * 128 + p) * 16 + c] = f2bf((float)(fre * br - fim * bi));
        bbar[((size_t)g * 128 + 64 + p) * 16 + c] = f2bf((float)(fre * bi + fim * br)); }
    bf16* cmat = (bf16*)(base + S5C_CMAT);
    const float* cre = INP(a, I_S5CRE) + (size_t)(l * 32 + g) * 16 * 64; const float* cim = INP(a, I_S5CIM) + (size_t)(l * 32 + g) * 16 * 64;
#pragma unroll
    for (int c = 0; c < 16; ++c) { cmat[((size_t)g * 16 + c) * 128 + p] = f2bf(cre[c * 64 + p]); cmat[((size_t)g * 16 + c) * 128 + 64 + p] = f2bf(-cim[c * 64 + p]); }
}
DI void p0_lru_w(const Frame& F, const Args& a) {
    const int total = DEPTH * 2 * 8 * 96 * 96;
    const float* pwa = INP(a, I_LWA); const float* pwx = INP(a, I_LWX);
    for (int idx = F.bid * NTHREADS + F.tid; idx < total; idx += F.G * NTHREADS) {
        int r = idx; const int i = r % 96; r /= 96; const int j = r % 96; r /= 96; const int h = r % 8; r /= 8; const int which = r & 1, l = r >> 1;
        const float* src = (which ? pwx : pwa) + (((size_t)l * 8 + h) * 96 + i) * 96 + j;
        bf16* dst = (bf16*)(F.ws + WS_LRUW + (size_t)l * LRUW_STRIDE + (which ? LRUW_X : 0));
        dst[((size_t)h * 96 + j) * 96 + i] = f2bf(*src);
    }
}
DI void p0_ada(const Frame& F, const Args& a) {
    LAS float* red = (LAS float*)F.lds;
    const int cq = F.lane & 15, kr = F.lane >> 4;
    for (int task = F.bid; task < DEPTH * 192; task += F.G) {
        const int l = task / 192, cg = task % 192;
        const float* W = INP(a, I_ADAW) + (size_t)l * DM * (NADA * DM) + 64 * cg + 4 * cq;
        const float* cin = INP(a, I_C);
        f32x4 acc[4];
#pragma unroll
        for (int b = 0; b < 4; ++b) acc[b] = (f32x4){0.f, 0.f, 0.f, 0.f};
#pragma unroll 4
        for (int it = 0; it < 64; ++it) { const int k = 256 * F.wave + 4 * it + kr;
            const f32x4 wv = *(const f32x4*)(W + (size_t)k * (NADA * DM));
#pragma unroll
            for (int b = 0; b < 4; ++b) { const float cs = siluf_(cin[b * DM + k]); acc[b] += cs * wv; } }
#pragma unroll
        for (int b = 0; b < 4; ++b)
#pragma unroll
            for (int e = 0; e < 4; ++e) acc[b][e] = xor_add<16>(acc[b][e]);
        if ((kr & 1) == 0) {
#pragma unroll
            for (int b = 0; b < 4; ++b) *(LAS f32x4*)(red + ((F.wave * 2 + (kr >> 1)) * 4 + b) * 64 + 4 * cq) = acc[b]; }
        __syncthreads();
        if (F.tid < 256) { const int b = F.tid >> 6, col = F.tid & 63; float s = INP(a, I_ADAB)[(size_t)l * (NADA * DM) + 64 * cg + col];
#pragma unroll
            for (int w = 0; w < 16; ++w) s += red[(w * 4 + b) * 64 + col];
            ((float*)(F.ws + WS_MOD))[((size_t)l * 4 + b) * (NADA * DM) + 64 * cg + col] = s; }
        __syncthreads();
    }
}
DI void p0_convert(const Frame& F, const Args& a) {
    LAS float* scr = (LAS float*)(F.lds + F.wave * 16896);
    const int gw = F.bid * NWAVES + F.wave, NGW = F.G * NWAVES;
    constexpr int I_WIN_ = 32 * 72, I_WOUT_ = 32 * 32, I_GLU_ = 8 * 16, I_F13_ = 32 * 176, I_F2_ = 44 * 32, I_M13_ = 16 * 112, I_M2_ = 56 * 32;
    constexpr int TOTAL = 2 * I_WIN_ + 2 * I_WOUT_ + 2 * I_GLU_ + I_F13_ + I_F2_ + 8 * I_M13_ + 8 * I_M2_;
    for (int it = gw; it < TOTAL; it += NGW) {
        int r = it;
        if (r < 2 * I_WIN_) { const int l = r / I_WIN_; r %= I_WIN_; conv_item(INP(a, I_WIN) + (size_t)l * DM * DIN_SRC, nullptr, DIN_SRC, DM, (bf16*)(F.ws + WS_WIN) + (size_t)l * PROJ_LD * DM, r / 72, r % 72, 1, scr, F.lane); continue; } r -= 2 * I_WIN_;
        if (r < 2 * I_WOUT_) { const int l = r / I_WOUT_; r %= I_WOUT_; conv_item(INP(a, I_WOUT) + (size_t)l * DM * DM, nullptr, DM, DM, (bf16*)(F.ws + WS_WOUT) + (size_t)l * DM * DM, r / 32, r % 32, 0, scr, F.lane); continue; } r -= 2 * I_WOUT_;
        if (r < 2 * I_GLU_) { const int l = r / I_GLU_; r %= I_GLU_; conv_item(INP(a, I_S5WGLU) + (size_t)l * 512 * 1024, nullptr, 1024, 512, (bf16*)(F.ws + WS_WGLU) + (size_t)l * 1024 * 512, r / 16, r % 16, 3, scr, F.lane); continue; } r -= 2 * I_GLU_;
        if (r < I_F13_) { conv_item(INP(a, I_F1), INP(a, I_F3), DFF, DM, (bf16*)(F.ws + WS_F13), r / 176, r % 176, 2, scr, F.lane); continue; } r -= I_F13_;
        if (r < I_F2_) { conv_item8<false>(INP(a, I_F2), nullptr, DM, DFF, (unsigned char*)(F.ws + WS_F2), r / 32, r % 32, SC_W2, (LAS unsigned*)scr, F.lane); continue; } r -= I_F2_;
        if (r < 8 * I_M13_) { const int e = r / I_M13_; r %= I_M13_; conv_item8<true>(INP(a, I_M1) + (size_t)e * DM * DFFE, INP(a, I_M3) + (size_t)e * DM * DFFE, DFFE, DM, (unsigned char*)(F.ws + WS_M13 + (size_t)e * 2 * DFFE * DM), 8 * ((r >> 3) / 112) + (r & 7), (r >> 3) % 112, SC_W13, (LAS unsigned*)scr, F.lane);     continue; } r -= 8 * I_M13_;
        { const int e = r / I_M2_; r %= I_M2_; conv_item8<false>(INP(a, I_M2) + (size_t)e * DFFE * DM, nullptr, DM, DFFE, (unsigned char*)(F.ws + WS_M2 + (size_t)e * DM * DFFE), 8 * ((r >> 3) / 32) + (r & 7), (r >> 3) % 32, SC_W2, (LAS unsigned*)scr, F.lane); }
    }
}

template <bool ROUTER, bool OUT8>
DI void norm_phase(const Frame& F, const Args& a, const float* xin, const float* g, const float* mod  , int shift_idx, int scale_idx, const float* wrouter) {
    bf16* H = (bf16*)(F.ws + WS_H);
    LAS float* wr = (LAS float*)F.lds;
    volatile LAS unsigned* bcnt = F.MISC + 32;
    LAS unsigned* rows = (LAS unsigned*)(F.lds + 65536);
    if (ROUTER) {
        for (int i0 = F.tid; i0 < DM * NE; i0 += 8 * NTHREADS) { float w8[8];
#pragma unroll
            for (int q = 0; q < 8; ++q) w8[q] = wrouter[i0 + NTHREADS * q];
#pragma unroll
            for (int q = 0; q < 8; ++q) { const int i = i0 + NTHREADS * q, d = i >> 3, e = i & 7; wr[e * DM + d] = w8[q]; } }
        if (F.tid < 8) bcnt[F.tid] = 0u;
        __syncthreads();
    }
    const int gw = F.bid * NWAVES + F.wave;
    int rslot = 0;
    f32x4 vnx[8];
    if (gw < T) {
#pragma unroll
        for (int j = 0; j < 8; ++j) vnx[j] = ((const f32x4*)(xin + (size_t)gw * DM) + F.lane)[64 * j]; }
    for (int row = gw; row < T; row += F.G * NWAVES, ++rslot) {
        const int b = row >> 11;
        f32x4 v[8]; float ss = 0.f;
#pragma unroll
        for (int j = 0; j < 8; ++j) v[j] = vnx[j];
        { const int rown = row + F.G * NWAVES < T ? row + F.G * NWAVES : row;
          const f32x4* xn = (const f32x4*)(xin + (size_t)rown * DM) + F.lane;
#pragma unroll
          for (int j = 0; j < 8; ++j) vnx[j] = xn[64 * j]; }
#pragma unroll
        for (int j = 0; j < 8; ++j) ss += (v[j][0] * v[j][0] + v[j][1] * v[j][1]) + (v[j][2] * v[j][2] + v[j][3] * v[j][3]);
        const float rstd = rsqrtf(wave_sum(ss) * (1.f / DM) + EPS);
        const f32x4* gp = (const f32x4*)g + F.lane; const f32x4* sc = (const f32x4*)(mod + (size_t)b * (NADA * DM) + scale_idx * DM) + F.lane; const f32x4* sh = (const f32x4*)(mod + (size_t)b * (NADA * DM) + shift_idx * DM) + F.lane;
        u32x2* o8 = (u32x2*)(H + (size_t)row * DM) + F.lane;
#pragma unroll
        for (int j = 0; j < 8; ++j) { const f32x4 gg = gp[64 * j], s1 = sc[64 * j], s0 = sh[64 * j];
            v[j] = v[j] * rstd * gg * (1.f + s1) + s0;
            if (OUT8) ((unsigned*)((unsigned char*)H + (size_t)row * DM))[F.lane + 64 * j] = pg8::pk4_fp8(v[j][0] * SC_X, v[j][1] * SC_X, v[j][2] * SC_X, v[j][3] * SC_X);
            else { u32x2 w; w.x = pk_bf16(v[j][0], v[j][1]); w.y = pk_bf16(v[j][2], v[j][3]); o8[64 * j] = w; } }
        if (ROUTER) {
            float lg[8];
#pragma unroll
            for (int e = 0; e < 8; ++e) { float s = 0.f;
#pragma unroll
                for (int j = 0; j < 8; ++j) { const f32x4 w4 = *(const LAS f32x4*)(wr + e * DM + 256 * j + 4 * F.lane); s += (v[j][0] * w4[0] + v[j][1] * w4[1]) + (v[j][2] * w4[2] + v[j][3] * w4[3]); }
                lg[e] = wave_sum(s); }
            if (F.lane == 0) {
                int e0 = 0; float v0 = lg[0];
#pragma unroll
                for (int e = 1; e < 8; ++e) if (lg[e] > v0) { v0 = lg[e]; e0 = e; }
                int e1 = -1; float v1 = -3.4e38f;
#pragma unroll
                for (int e = 0; e < 8; ++e) if (e != e0 && lg[e] > v1) { v1 = lg[e]; e1 = e; }
                const float ex = __expf(v1 - v0), g0 = 1.f / (1.f + ex), g1 = ex / (1.f + ex);
                const unsigned p0 = 0u, p1 = 0u;
                LAS unsigned* rec = rows + (F.wave * 4 + rslot) * 8;
                rec[0] = (unsigned)e0; rec[1] = (unsigned)e1; rec[2] = p0; rec[3] = p1; rec[4] = __builtin_bit_cast(unsigned, g0); rec[5] = __builtin_bit_cast(unsigned, g1);
            }
        }
    }
    if (ROUTER) {
        __syncthreads();
        if (F.tid == 0) {
            for (int r = 0; r < 32; ++r) { LAS unsigned* rec = rows + r * 8; const unsigned e0 = rec[0], e1 = rec[1];
                const unsigned q0 = bcnt[e0]; bcnt[e0] = q0 + 1u; const unsigned q1 = bcnt[e1]; bcnt[e1] = q1 + 1u; rec[2] = q0; rec[3] = q1; }
            unsigned* cb = (unsigned*)(F.ws + WS_CNTBLK) + (size_t)F.bid * 32;
            for (int e = 0; e < 8; ++e) cb[e] = bcnt[e];
        }
        __syncthreads();
        if (F.tid < 32) { LAS unsigned* rec = rows + F.tid * 8; const int w = F.tid >> 2, rs = F.tid & 3; const int row = F.bid * NWAVES + w + rs * F.G * NWAVES;
            if (row < T) { unsigned* out = (unsigned*)(F.ws + WS_ROUTE) + (size_t)row * 8;
                out[0] = rec[0]; out[1] = rec[1]; out[2] = rec[2]; out[3] = rec[3]; out[4] = rec[4]; out[5] = rec[5]; } }
        __syncthreads();
    }
}
DI void s5norm_phase(const Frame& F, const float* g) {
    const float* P = (const float*)(F.ws + WS_S5PRE); bf16* MIX = (bf16*)(F.ws + WS_MIX);
    for (int row = F.bid * NWAVES + F.wave; row < T; row += F.G * NWAVES) {
        const f32x4* xr = (const f32x4*)(P + (size_t)row * 512) + F.lane;
        f32x4 v[2]; float ss = 0.f;
#pragma unroll
        for (int j = 0; j < 2; ++j) { v[j] = xr[64 * j]; ss += (v[j][0] * v[j][0] + v[j][1] * v[j][1]) + (v[j][2] * v[j][2] + v[j][3] * v[j][3]); }
        const float rstd = rsqrtf(wave_sum(ss) * (1.f / 512.f) + EPS);
        u32x2* o8 = (u32x2*)(MIX + (size_t)row * DM) + F.lane;
#pragma unroll
        for (int j = 0; j < 2; ++j) { const f32x4 gg = ((const f32x4*)g)[F.lane + 64 * j]; v[j] = v[j] * rstd * gg;
            u32x2 w; w.x = pk_bf16(v[j][0], v[j][1]); w.y = pk_bf16(v[j][2], v[j][3]); o8[64 * j] = w; }
    }
}
DI void moe_tiles(const Frame& F) {
    LAS unsigned* tbl = (LAS unsigned*)F.lds;
    const unsigned* cb = (const unsigned*)(F.ws + WS_CNTBLK);
    __syncthreads();
    for (int i = F.tid; i < F.G * 8; i += NTHREADS) tbl[i] = cb[(i >> 3) * 32 + (i & 7)];
    __syncthreads();
    if (F.tid < 8) { unsigned tot = 0, base = 0;
        for (int b = 0; b < F.G; ++b) { if (b == F.bid) base = tot; tot += tbl[b * 8 + F.tid]; }
        F.MISC[32 + F.tid] = tot; F.MISC[40 + F.tid] = base; }
    __syncthreads();
    if (F.tid == 0) { unsigned s = 0;
        for (int e = 0; e < 8; ++e) { F.MISC[16 + e] = s; s += (F.MISC[32 + e] + 255u) >> 8; }
        F.MISC[24] = s; }
    __syncthreads();
}
DI void dense_tiles(const Frame& F) {
    __syncthreads();
    if (F.tid == 0) { F.MISC[16] = 0u; for (int e = 1; e <= 8; ++e) F.MISC[16 + e] = (unsigned)(T / 256); }
    __syncthreads();
}
DI void moe_sort_phase(const Frame& F) {
    moe_tiles(F);
    const bf16* H = (const bf16*)(F.ws + WS_H); bf16* AS = (bf16*)(F.ws + WS_AS);
    for (int row = F.bid * NWAVES + F.wave; row < T; row += F.G * NWAVES) {
        unsigned* rt = (unsigned*)(F.ws + WS_ROUTE) + (size_t)row * 8;
        const unsigned e0 = rt[0], e1 = rt[1], q0 = rt[2], q1 = rt[3];
        const unsigned p0 = F.MISC[16 + e0] * 256u + F.MISC[40 + e0] + q0, p1 = F.MISC[16 + e1] * 256u + F.MISC[40 + e1] + q1;
        const u32x4* src = (const u32x4*)((const unsigned char*)H + (size_t)row * DM) + F.lane;
        u32x4* d0 = (u32x4*)((unsigned char*)AS + (size_t)p0 * DM) + F.lane; u32x4* d1 = (u32x4*)((unsigned char*)AS + (size_t)p1 * DM) + F.lane;
#pragma unroll
        for (int j = 0; j < 2; ++j) { const u32x4 v = src[64 * j]; d0[64 * j] = v; d1[64 * j] = v; }
        if (F.lane == 0) { rt[6] = p0; rt[7] = p1; }
    }
}
DI void final_phase(const Frame& F, const Args& a, const float* mod) {
    const float* X1 = (const float*)(F.ws + WS_X1); const float* Y = (const float*)(F.ws + WS_Y);
    const f32x4* fng = (const f32x4*)INP(a, I_FNG);
    for (int row = F.bid * NWAVES + F.wave; row < T; row += F.G * NWAVES) {
        const int b = row >> 11;
        const unsigned* rt = (const unsigned*)(F.ws + WS_ROUTE) + (size_t)row * 8;
        const float g0 = __builtin_bit_cast(float, rt[4]), g1 = __builtin_bit_cast(float, rt[5]); const unsigned p0 = rt[6], p1 = rt[7];
        const f32x4* xr = (const f32x4*)(X1 + (size_t)row * DM) + F.lane; const f32x4* y0 = (const f32x4*)(Y + (size_t)p0 * DM) + F.lane; const f32x4* y1 = (const f32x4*)(Y + (size_t)p1 * DM) + F.lane;
        const f32x4* gt = (const f32x4*)(mod + (size_t)b * (NADA * DM) + 5 * DM) + F.lane;
        f32x4 v[8]; float ss = 0.f;
#pragma unroll
        for (int j = 0; j < 8; ++j) {
#if defined(DBG_ROUTE_ONLY)
            v[j] = xr[64 * j] + gt[64 * j] * (g0 * (float)(p0 % 97u) * 0.01f + g1 * (float)(p1 % 89u) * 0.01f + (float)rt[0] * 0.1f - (float)rt[1] * 0.05f);
#elif defined(DBG_SKIP_MOE)
            v[j] = xr[64 * j];
#else
            v[j] = xr[64 * j] + gt[64 * j] * (g0 * y0[64 * j] + g1 * y1[64 * j]);
#endif
            ss += (v[j][0] * v[j][0] + v[j][1] * v[j][1]) + (v[j][2] * v[j][2] + v[j][3] * v[j][3]); }
        const float rstd = rsqrtf(wave_sum(ss) * (1.f / DM) + EPS);
        f32x4* o = (f32x4*)(as_global(a.out) + (size_t)row * DM) + F.lane;
#pragma unroll
        for (int j = 0; j < 8; ++j) o[64 * j] = DBG_OUTSCALE * v[j] * rstd * fng[F.lane + 64 * j];
    }
}

template <bool FULL>
DI void s5_task(const Frame& F, const Args& a, int l, int task, LAS unsigned char* wl) {
    const int lane = F.lane, fr = lane & 15, fq = lane >> 4;
    const int b = task >> 10, g = (task >> 5) & 31, j = task & 31;
    const unsigned char* cb = (const unsigned char*)(F.ws + WS_S5C + (size_t)l * S5C_STRIDE);
    const f32x2 ab = ((const f32x2*)(cb + S5C_ABAR))[g * 64 + lane];
    const bf16* bbar = (const bf16*)(cb + S5C_BBAR) + (size_t)g * 128 * 16;
    const bf16* PJ = (const bf16*)(F.ws + WS_PROJ);
    volatile LAS float* BU = (volatile LAS float*)wl;
    bf16x8 Bf[8];
    const bf16x8 zero8 = (bf16x8){0, 0, 0, 0, 0, 0, 0, 0};
#pragma unroll
    for (int nb = 0; nb < 8; ++nb) Bf[nb] = (fq < 2) ? *(const bf16x8*)(bbar + (16 * nb + fr) * 16 + 8 * fq) : zero8;
    bf16x8 Cf[4]; float dv = 0.f;
    float hr = 0.f, hi = 0.f;
    float* E = (float*)(F.ws + WS_S5E) + (size_t)((b * 32 + g) * 32) * 128;
    if (FULL) {
        const bf16* cmat = (const bf16*)(cb + S5C_CMAT) + (size_t)g * 16 * 128;
#pragma unroll
        for (int ks = 0; ks < 4; ++ks) Cf[ks] = *(const bf16x8*)(cmat + fr * 128 + 32 * ks + 8 * fq);
        dv = INP(a, I_S5D)[l * 512 + g * 16 + fr];
        const f32x2 aL = ((const f32x2*)(cb + S5C_ABARL))[g * 64 + lane];
        int i = 0;
        for (; i + 8 <= j; i += 8) { float er[8], ei[8];
#pragma unroll
            for (int q = 0; q < 8; ++q) { er[q] = E[(i + q) * 128 + lane]; ei[q] = E[(i + q) * 128 + 64 + lane]; }
#pragma unroll
            for (int q = 0; q < 8; ++q) { const float nr = fmaf(aL[0], hr, fmaf(-aL[1], hi, er[q])), ni = fmaf(aL[0], hi, fmaf(aL[1], hr, ei[q])); hr = nr; hi = ni; } }
        for (; i < j; ++i) { const float er = E[i * 128 + lane], ei = E[i * 128 + 64 + lane];
            const float nr = fmaf(aL[0], hr, fmaf(-aL[1], hi, er)), ni = fmaf(aL[0], hi, fmaf(aL[1], hr, ei)); hr = nr; hi = ni; }
    }
    const size_t row0 = (size_t)b * SEQ + 64 * j;
    bf16x8 Afs[4];
#pragma unroll
    for (int sub = 0; sub < 4; ++sub) Afs[sub] = (fq < 2) ? *(const bf16x8*)(PJ + (row0 + 16 * sub + fr) * PROJ_LD + C_U + g * 16 + 8 * fq) : zero8;
#pragma unroll
    for (int sub = 0; sub < 4; ++sub) {
        const size_t r0 = row0 + 16 * sub;
        const bf16x8 Af = Afs[sub];
        f32x4 dd[8];
#pragma unroll
        for (int nb = 0; nb < 8; ++nb) dd[nb] = __builtin_amdgcn_mfma_f32_16x16x32_bf16(Af, Bf[nb], (f32x4){0.f, 0.f, 0.f, 0.f}, 0, 0, 0);
        asm volatile("s_nop 15\n\ts_nop 15" : "+v"(dd[0]), "+v"(dd[1]), "+v"(dd[2]), "+v"(dd[3]), "+v"(dd[4]), "+v"(dd[5]), "+v"(dd[6]), "+v"(dd[7]));
#pragma unroll
        for (int nb = 0; nb < 8; ++nb) {
#pragma unroll
            for (int jj = 0; jj < 4; ++jj) BU[(4 * fq + jj) * 132 + 16 * nb + fr] = dd[nb][jj]; }
        LDS_WAIT();
        volatile LAS bf16* HT = (volatile LAS bf16*)(wl + 8448);
        bf16 uu[4];
        if (FULL) {
#pragma unroll
            for (int jj = 0; jj < 4; ++jj) uu[jj] = PJ[(r0 + 4 * fq + jj) * PROJ_LD + C_U + g * 16 + fr]; }
#pragma unroll
        for (int t = 0; t < 16; ++t) { const float br = BU[t * 132 + lane], bi = BU[t * 132 + 64 + lane];
            const float nr = fmaf(ab[0], hr, fmaf(-ab[1], hi, br)), ni = fmaf(ab[0], hi, fmaf(ab[1], hr, bi)); hr = nr; hi = ni;
            if (FULL) { HT[t * 136 + lane] = f2bf_sw(nr); HT[t * 136 + 64 + lane] = f2bf_sw(ni); } }
        LDS_WAIT();
        if (FULL) {
            bf16x8 hf[4];
#pragma unroll
            for (int ks = 0; ks < 4; ++ks) hf[ks] = *(const LAS bf16x8*)((const LAS bf16*)(wl + 8448) + fr * 136 + 32 * ks + 8 * fq);
            asm volatile("s_waitcnt vmcnt(0) lgkmcnt(0)\n\ts_nop 7" : "+v"(hf[0]), "+v"(hf[1]), "+v"(hf[2]), "+v"(hf[3]));
            f32x4 y = (f32x4){0.f, 0.f, 0.f, 0.f};
#pragma unroll
            for (int ks = 0; ks < 4; ++ks) y = __builtin_amdgcn_mfma_f32_16x16x32_bf16(hf[ks], Cf[ks], y, 0, 0, 0);
            asm volatile("s_nop 15\n\ts_nop 15" : "+v"(y));
            bf16* Z = (bf16*)(F.ws + WS_Z);
#pragma unroll
            for (int jj = 0; jj < 4; ++jj) { const size_t r = r0 + 4 * fq + jj; Z[r * 512 + g * 16 + fr] = f2bf(gelu_tanh(y[jj] + dv * bf2f(uu[jj]))); }
        }
    }
    if (!FULL) { E[j * 128 + lane] = hr; E[j * 128 + 64 + lane] = hi; }
}

DI void lru_gate_task(const Frame& F, const Args& a, int l, int task) {
    const int lane = F.lane, fr = lane & 15, fq = lane >> 4;
    const int b = task >> 9, j = (task >> 3) & 63, hd = task & 7;
    const bf16* PJ = (const bf16*)(F.ws + WS_PROJ);
    const float* cw = INP(a, I_LCONVW) + (size_t)l * 4 * 768; const float* cbias = INP(a, I_LCONVB) + (size_t)l * 768;
    const bf16* waT = (const bf16*)(F.ws + WS_LRUW + (size_t)l * LRUW_STRIDE) + (size_t)hd * 96 * 96; const bf16* wxT = (const bf16*)(F.ws + WS_LRUW + (size_t)l * LRUW_STRIDE + LRUW_X) + (size_t)hd * 96 * 96;
    const size_t rbase = (size_t)b * SEQ + 32 * j;
    bf16x8 X[2][3];
#pragma unroll
    for (int ks = 0; ks < 3; ++ks) {
        const int ch = hd * 96 + 32 * ks + 8 * fq;
        f32x4 w0[4], w1[4];
#pragma unroll
        for (int k = 0; k < 4; ++k) { w0[k] = *(const f32x4*)(cw + k * 768 + ch); w1[k] = *(const f32x4*)(cw + k * 768 + ch + 4); }
        const f32x4 c0 = *(const f32x4*)(cbias + ch), c1 = *(const f32x4*)(cbias + ch + 4);
#pragma unroll
        for (int m = 0; m < 2; ++m) {
            const int ts = 32 * j + 16 * m + fr;
            float xc[8];
#pragma unroll
            for (int e = 0; e < 4; ++e) { xc[e] = c0[e]; xc[4 + e] = c1[e]; }
            u32x4 xt[4];
#pragma unroll
            for (int k = 0; k < 4; ++k) { const int tt = ts - 3 + k; xt[k] = *(const u32x4*)(PJ + ((size_t)b * SEQ + (tt < 0 ? 0 : tt)) * PROJ_LD + C_XL + ch); }
#pragma unroll
            for (int k = 0; k < 4; ++k) { const int tt = ts - 3 + k; const u32x4 z4 = {0u, 0u, 0u, 0u}; const u32x4 xv = tt < 0 ? z4 : xt[k];
                    xc[0] += w0[k][0] * bflo(xv.x); xc[1] += w0[k][1] * bfhi(xv.x); xc[2] += w0[k][2] * bflo(xv.y); xc[3] += w0[k][3] * bfhi(xv.y);
                    xc[4] += w1[k][0] * bflo(xv.z); xc[5] += w1[k][1] * bfhi(xv.z); xc[6] += w1[k][2] * bflo(xv.w); xc[7] += w1[k][3] * bfhi(xv.w); }
            u32x4 pk; pk.x = pk_bf16(xc[0], xc[1]); pk.y = pk_bf16(xc[2], xc[3]); pk.z = pk_bf16(xc[4], xc[5]); pk.w = pk_bf16(xc[6], xc[7]);
            X[m][ks] = __builtin_bit_cast(bf16x8, pk);
        }
        asm volatile("" ::: "memory");
    }
    float* LA = (float*)(F.ws + WS_LRUA); float* LB = (float*)(F.ws + WS_LRUB);
    const float* pba = INP(a, I_LBA) + l * 768; const float* pbx = INP(a, I_LBX) + l * 768; const float* plam = INP(a, I_LLAM) + l * 768;
    for (int nb = 0; nb < 6; ++nb) {
        bf16x8 WA[3], WX[3];
#pragma unroll
        for (int ks = 0; ks < 3; ++ks) { WA[ks] = *(const bf16x8*)(waT + (16 * nb + fr) * 96 + 32 * ks + 8 * fq); WX[ks] = *(const bf16x8*)(wxT + (16 * nb + fr) * 96 + 32 * ks + 8 * fq); }
        const int ch0 = hd * 96 + 16 * nb + 4 * fq;
        const f32x4 ba = *(const f32x4*)(pba + ch0), bx = *(const f32x4*)(pbx + ch0), lam = *(const f32x4*)(plam + ch0);
        const f32x4 cb4 = *(const f32x4*)(cbias + ch0);
        f32x4 cwk[4]; u32x2 xtap[2][4];
#pragma unroll
        for (int k = 0; k < 4; ++k) { cwk[k] = *(const f32x4*)(cw + k * 768 + ch0);
#pragma unroll
            for (int m = 0; m < 2; ++m) { const int tt = 32 * j + 16 * m + fr - 3 + k; xtap[m][k] = *(const u32x2*)(PJ + ((size_t)b * SEQ + (tt < 0 ? 0 : tt)) * PROJ_LD + C_XL + ch0); } }
        asm volatile("" : "+v"(cwk[0]), "+v"(cwk[1]), "+v"(cwk[2]), "+v"(cwk[3]));
        asm volatile("" : "+v"(xtap[0][0]), "+v"(xtap[0][1]), "+v"(xtap[0][2]), "+v"(xtap[0][3]), "+v"(xtap[1][0]), "+v"(xtap[1][1]), "+v"(xtap[1][2]), "+v"(xtap[1][3]));
        f32x4 ls;
#pragma unroll
        for (int e = 0; e < 4; ++e) ls[e] = 8.f * logsigmoid_fast(lam[e]);
#pragma unroll
        for (int m = 0; m < 2; ++m) {
            f32x4 da = (f32x4){0.f, 0.f, 0.f, 0.f}, dx = (f32x4){0.f, 0.f, 0.f, 0.f};
#pragma unroll
            for (int ks = 0; ks < 3; ++ks) { da = __builtin_amdgcn_mfma_f32_16x16x32_bf16(WA[ks], X[m][ks], da, 0, 0, 0); dx = __builtin_amdgcn_mfma_f32_16x16x32_bf16(WX[ks], X[m][ks], dx, 0, 0, 0); }
            asm volatile("s_nop 15\n\ts_nop 15" : "+v"(da), "+v"(dx));
            const int ts = 32 * j + 16 * m + fr;
            f32x4 xc = cb4;
#pragma unroll
            for (int k = 0; k < 4; ++k) { const int tt = ts - 3 + k;
                u32x2 xv = xtap[m][k]; const f32x4 w = cwk[k];
                if (tt < 0) { xv.x = 0u; xv.y = 0u; }
                    xc[0] += w[0] * bflo(xv.x); xc[1] += w[1] * bfhi(xv.x); xc[2] += w[2] * bflo(xv.y); xc[3] += w[3] * bfhi(xv.y); }
            f32x4 av, bv;
#pragma unroll
            for (int e = 0; e < 4; ++e) { const float r = sigmoidf_(da[e] + ba[e]), ig = sigmoidf_(dx[e] + bx[e]); const float la = r * ls[e];
                av[e] = __expf(la); bv[e] = sqrtf(fmaxf(1.f - av[e] * av[e], 0.f)) * ig * xc[e]; }
            const size_t o = (rbase + 16 * m + fr) * 768 + ch0;
            *(f32x4*)(LA + o) = av; *(f32x4*)(LB + o) = bv;
        }
    }
}
DI void lru_scan_task(const Frame& F, int task) {
    const int b = task / 384, rem = task % 384, j = rem / 12, cg = rem % 12;
    float* LA = (float*)(F.ws + WS_LRUA) + ((size_t)b * SEQ + 64 * j) * 768 + 64 * cg + F.lane; float* LB = (float*)(F.ws + WS_LRUB) + ((size_t)b * SEQ + 64 * j) * 768 + 64 * cg + F.lane;
    float h = 0.f, cum = 1.f;
    for (int t0 = 0; t0 < 64; t0 += 32) { float av[32], bv[32];
#pragma unroll
        for (int t = 0; t < 32; ++t) { av[t] = LA[(size_t)(t0 + t) * 768]; bv[t] = LB[(size_t)(t0 + t) * 768]; }
#pragma unroll
        for (int t = 0; t < 32; ++t) { h = fmaf(av[t], h, bv[t]); cum *= av[t]; LB[(size_t)(t0 + t) * 768] = h; LA[(size_t)(t0 + t) * 768] = cum; } }
}
DI void lru_out_task(const Frame& F, const Args& a, int l, int task) {
    const int b = task >> 5, j = task & 31;
    const float* LA = (const float*)(F.ws + WS_LRUA) + (size_t)b * SEQ * 768; const float* LB = (const float*)(F.ws + WS_LRUB) + (size_t)b * SEQ * 768;
    LAS float* HS = (LAS float*)F.lds;
    for (int ch = F.tid; ch < 768; ch += NTHREADS) { float H = 0.f;
        int i = 0;
        for (; i + 8 <= j; i += 8) { float ap[8], e[8];
#pragma unroll
            for (int q = 0; q < 8; ++q) { ap[q] = LA[(size_t)(64 * (i + q) + 63) * 768 + ch]; e[q] = LB[(size_t)(64 * (i + q) + 63) * 768 + ch]; }
#pragma unroll
            for (int q = 0; q < 8; ++q) H = fmaf(ap[q], H, e[q]); }
        for (; i < j; ++i) { const float ap = LA[(size_t)(64 * i + 63) * 768 + ch], e = LB[(size_t)(64 * i + 63) * 768 + ch]; H = fmaf(ap, H, e); }
        HS[ch] = H; }
    __syncthreads();
    const bf16* PJ = (const bf16*)(F.ws + WS_PROJ); bf16* MIX = (bf16*)(F.ws + WS_MIX);
    const float* ng = INP(a, I_LNG) + l * 768;
    const f32x4 g4r[3] = {*(const f32x4*)(ng + 4 * F.lane), *(const f32x4*)(ng + 4 * F.lane + 256), *(const f32x4*)(ng + 4 * F.lane + 512)};
    for (int rr0 = F.wave; rr0 < 64; rr0 += 2 * NWAVES) {
      f32x4 hl2[2][3], ca2[2][3]; u32x2 gv2[2][3];
#pragma unroll
      for (int u = 0; u < 2; ++u) { const size_t t = 64 * j + rr0 + NWAVES * u, row = (size_t)b * SEQ + t;
#pragma unroll
          for (int q = 0; q < 3; ++q) { const int ch = 4 * F.lane + 256 * q; hl2[u][q] = *(const f32x4*)(LB + t * 768 + ch); ca2[u][q] = *(const f32x4*)(LA + t * 768 + ch); gv2[u][q] = *(const u32x2*)(PJ + row * PROJ_LD + C_GL + ch); } }
#pragma unroll
      for (int u = 0; u < 2; ++u) {
        const size_t t = 64 * j + rr0 + NWAVES * u, row = (size_t)b * SEQ + t;
        f32x4 v[3]; float ss = 0.f;
#pragma unroll
        for (int q = 0; q < 3; ++q) { const int ch = 4 * F.lane + 256 * q;
            const f32x4 hl = hl2[u][q], ca = ca2[u][q], hs = *(const LAS f32x4*)(HS + ch);
            const u32x2 gv = gv2[u][q];
            const float gg[4] = {bflo(gv.x), bfhi(gv.x), bflo(gv.y), bfhi(gv.y)};
#pragma unroll
            for (int e = 0; e < 4; ++e) { const float h = fmaf(ca[e], hs[e], hl[e]); v[q][e] = h * gelu_tanh(gg[e]); ss += v[q][e] * v[q][e]; } }
        const float rstd = rsqrtf(wave_sum(ss) * (1.f / 768.f) + EPS);
#pragma unroll
        for (int q = 0; q < 3; ++q) { const int ch = 4 * F.lane + 256 * q; const f32x4 o = v[q] * rstd * g4r[q];
            u32x2 w; w.x = pk_bf16(o[0], o[1]); w.y = pk_bf16(o[2], o[3]); *(u32x2*)(MIX + row * DM + 512 + ch) = w; }
      }
    }
    __syncthreads();
}

constexpr int GL_BC = 0, GL_WG = 24832, GL_K = 31488, GL_V = 57600;
constexpr int GB_Q = 31488, GB_K = 57600, GB_V = 83712;
DI void gla_bcum(const Frame& F, const Args& a, int l, int hd, size_t r0, LAS float* bc, LAS float* wg) {
    const bf16* PJ = (const bf16*)(F.ws + WS_PROJ);
    { const float* pg = INP(a, I_GWG2) + (size_t)l * 16 * 384 + hd * 96; float w3[3];
#pragma unroll
      for (int q = 0; q < 3; ++q) { const int i = F.tid + NTHREADS * q; w3[q] = pg[(i / 96) * 384 + i % 96]; }
#pragma unroll
      for (int q = 0; q < 3; ++q) wg[F.tid + NTHREADS * q] = w3[q]; }
    if (F.tid < 96) wg[1536 + F.tid] = INP(a, I_GBG2)[l * 384 + hd * 96 + F.tid];
    __syncthreads();
    { const int t = F.tid >> 3, dg = F.tid & 7;
      const u32x4 g0 = *(const u32x4*)(PJ + (r0 + t) * PROJ_LD + C_GLOW), g1 = *(const u32x4*)(PJ + (r0 + t) * PROJ_LD + C_GLOW + 8);
      const float gl[16] = {bflo(g0.x), bfhi(g0.x), bflo(g0.y), bfhi(g0.y), bflo(g0.z), bfhi(g0.z), bflo(g0.w), bfhi(g0.w), bflo(g1.x), bfhi(g1.x), bflo(g1.y), bfhi(g1.y), bflo(g1.z), bfhi(g1.z), bflo(g1.w), bfhi(g1.w)};
#pragma unroll
      for (int q = 0; q < 12; ++q) { const int d = dg + 8 * q; float acc = wg[1536 + d];
#pragma unroll
          for (int r = 0; r < 16; ++r) acc = fmaf(gl[r], wg[r * 96 + d], acc);
          bc[t * 97 + d] = logsigmoid_fast(acc) * (1.f / 16.f); } }
    __syncthreads();
    { const int d = F.tid % 96, seg = F.tid / 96; float v[16]; float s_ = 0.f;
      if (F.tid < 384) {
#pragma unroll
          for (int t = 0; t < 16; ++t) { s_ += bc[(16 * seg + t) * 97 + d]; v[t] = s_; }
          wg[1632 + seg * 96 + d] = s_; }
      __syncthreads();
      if (F.tid < 384) { float pre = 0.f;
#pragma unroll
          for (int q = 0; q < 3; ++q) pre += (q < seg) ? wg[1632 + q * 96 + d] : 0.f;
#pragma unroll
          for (int t = 0; t < 16; ++t) bc[(16 * seg + t) * 97 + d] = v[t] + pre; } }
    __syncthreads();
}
constexpr int G2_QD = 31488, G2_KI = 44800, G2_VT = 58112, G2_KO = 85760, G2_AT = 85760, G2_RED = 99584;
DI bf16x8 ldfrag(const LAS bf16* tile, int ST, int r0, int k0, int fr, int fq) { return *(const LAS bf16x8*)(tile + (r0 + fr) * ST + k0 + 8 * fq); }
#define MFMA_GUARD_IN4(a, b, c, d)  asm volatile("s_waitcnt vmcnt(0) lgkmcnt(0)\n\ts_nop 7" : "+v"(a), "+v"(b), "+v"(c), "+v"(d))
#define MFMA_GUARD_OUT(x)           asm volatile("s_nop 15\n\ts_nop 15" : "+v"(x))
DI void gla_stage_vt(const Frame& F, size_t r0, int hd, LAS bf16* VT) {
    const bf16* PJ = (const bf16*)(F.ws + WS_PROJ);
    u32x4 v3[3];
#pragma unroll
    for (int q = 0; q < 3; ++q) { const int it = F.tid + NTHREADS * q, t = it & 63, vc = it >> 6; v3[q] = *(const u32x4*)(PJ + (r0 + t) * PROJ_LD + C_V + hd * 192 + 8 * vc); }
#pragma unroll
    for (int q = 0; q < 3; ++q) { const int it = F.tid + NTHREADS * q, t = it & 63, vc = it >> 6;
        const u32x4 vv = v3[q];
        LAS bf16* p = VT + (8 * vc) * 72 + t;
        p[0 * 72] = (bf16)(vv.x & 0xffffu); p[1 * 72] = (bf16)(vv.x >> 16); p[2 * 72] = (bf16)(vv.y & 0xffffu); p[3 * 72] = (bf16)(vv.y >> 16);
        p[4 * 72] = (bf16)(vv.z & 0xffffu); p[5 * 72] = (bf16)(vv.z >> 16); p[6 * 72] = (bf16)(vv.w & 0xffffu); p[7 * 72] = (bf16)(vv.w >> 16);
        LDS_WAIT(); }
}
DI void gla_a_task(const Frame& F, const Args& a, int l, int unit) {
    const int bh = unit >> 5, n = unit & 31, b = bh >> 2, hd = bh & 3;
    const size_t r0 = (size_t)b * SEQ + 64 * n;
    LAS float* bc = (LAS float*)(F.lds + GL_BC); LAS float* wg = (LAS float*)(F.lds + GL_WG);
    LAS bf16* VT = (LAS bf16*)(F.lds + G2_VT); LAS bf16* KO = (LAS bf16*)(F.lds + G2_KO);
    const bf16* PJ = (const bf16*)(F.ws + WS_PROJ);
    gla_bcum(F, a, l, hd, r0, bc, wg);
    { float* G = (float*)(F.ws + WS_GLABC) + (size_t)unit * 6144;
      for (int i = F.tid; i < 6144; i += NTHREADS) G[i] = bc[(i / 96) * 97 + i % 96]; }
    u32x4 k2[2];
#pragma unroll
    for (int q = 0; q < 2; ++q) { const int it = F.tid + NTHREADS * q, t = it & 63, dc = (it >> 6) % 12; k2[q] = *(const u32x4*)(PJ + (r0 + t) * PROJ_LD + C_K + hd * 96 + 8 * dc); }
#pragma unroll
    for (int q = 0; q < 2; ++q) { const int it = F.tid + NTHREADS * q, t = it & 63, dc = it >> 6;
        if (it < 64 * 12) { const u32x4 kv = k2[q];
        const float kk[8] = {bflo(kv.x), bfhi(kv.x), bflo(kv.y), bfhi(kv.y), bflo(kv.z), bfhi(kv.z), bflo(kv.w), bfhi(kv.w)};
#pragma unroll
        for (int e = 0; e < 8; ++e) { const int d = 8 * dc + e; KO[d * 72 + t] = f2bf_sw(kk[e] * __expf(bc[63 * 97 + d] - bc[t * 97 + d])); } } }
    gla_stage_vt(F, r0, hd, VT);
    __syncthreads();
    const int fr = F.lane & 15, fq = F.lane >> 4;
    float* DT = (float*)(F.ws + WS_GLAD) + (size_t)unit * 96 * 192;
    for (int q = 0; q < 9; ++q) { const int idx = F.wave * 9 + q, mb = idx / 6, nb = idx - 6 * mb;
        bf16x8 a0 = ldfrag(VT, 72, 16 * mb, 0, fr, fq), a1 = ldfrag(VT, 72, 16 * mb, 32, fr, fq), b0 = ldfrag(KO, 72, 16 * nb, 0, fr, fq), b1 = ldfrag(KO, 72, 16 * nb, 32, fr, fq);
        MFMA_GUARD_IN4(a0, a1, b0, b1);
        f32x4 d = __builtin_amdgcn_mfma_f32_16x16x32_bf16(a0, b0, (f32x4){0.f, 0.f, 0.f, 0.f}, 0, 0, 0);
        d = __builtin_amdgcn_mfma_f32_16x16x32_bf16(a1, b1, d, 0, 0, 0);
        MFMA_GUARD_OUT(d);
#pragma unroll
        for (int jj = 0; jj < 4; ++jj) DT[(16 * mb + 4 * fq + jj) * 96 + 16 * nb + fr] = d[jj]; }
    if (F.tid < 96) ((float*)(F.ws + WS_GAMMA))[(size_t)unit * 96 + F.tid] = __expf(bc[63 * 97 + F.tid]);
    __syncthreads();
}
DI void gla_scan_phase(const Frame& F) {
    const float* DL = (const float*)(F.ws + WS_GLAD); const float* GM = (const float*)(F.ws + WS_GAMMA); bf16* ST = (bf16*)(F.ws + WS_GLAS);
    for (int idx = F.bid * NTHREADS + F.tid; idx < 16 * 18432; idx += F.G * NTHREADS) {
        const int bh = idx / 18432, e = idx - bh * 18432, d = e % 96;
        const float* p = DL + (size_t)bh * 32 * 18432 + e; const float* gp = GM + (size_t)bh * 32 * 96 + d; bf16* sp = ST + (size_t)bh * 32 * 18432 + e;
        float S = 0.f; float dl[32], gm[32];
#pragma unroll
        for (int n = 0; n < 32; ++n) { dl[n] = p[(size_t)n * 18432]; gm[n] = gp[n * 96]; }
#pragma unroll
        for (int n = 0; n < 32; ++n) { sp[(size_t)n * 18432] = f2bf_sw(S); S = fmaf(gm[n], S, dl[n]); }
    }
}
DI void gla_b_task(const Frame& F, const Args& a, int l, int unit) {
    const int bh = unit >> 5, n = unit & 31, b = bh >> 2, hd = bh & 3;
    const size_t r0 = (size_t)b * SEQ + 64 * n;
    LAS float* bc = (LAS float*)(F.lds + GL_BC); LAS float* wg = (LAS float*)(F.lds + GL_WG);
    LAS bf16* QD = (LAS bf16*)(F.lds + G2_QD); LAS bf16* KI = (LAS bf16*)(F.lds + G2_KI); LAS bf16* VT = (LAS bf16*)(F.lds + G2_VT); LAS bf16* AT = (LAS bf16*)(F.lds + G2_AT);
    LAS float* red = (LAS float*)(F.lds + G2_RED);
    const bf16* PJ = (const bf16*)(F.ws + WS_PROJ);
    { const float* G = (const float*)(F.ws + WS_GLABC) + (size_t)unit * 6144;
      float g12[12];
#pragma unroll
      for (int q = 0; q < 12; ++q) g12[q] = G[F.tid + NTHREADS * q];
      asm volatile("" : "+v"(g12[0]), "+v"(g12[1]), "+v"(g12[2]), "+v"(g12[3]), "+v"(g12[4]), "+v"(g12[5]), "+v"(g12[6]), "+v"(g12[7]), "+v"(g12[8]), "+v"(g12[9]), "+v"(g12[10]), "+v"(g12[11]));
#pragma unroll
      for (int q = 0; q < 12; ++q) { const int i = F.tid + NTHREADS * q; bc[(i / 96) * 97 + i % 96] = g12[q]; } }
    __syncthreads();
    const float qscale = 0.10206207261596575f;
    u32x4 q2[2], k2[2];
#pragma unroll
    for (int q = 0; q < 2; ++q) { const int it = F.tid + NTHREADS * q, t = it & 63, dc = (it >> 6) % 12;
        q2[q] = *(const u32x4*)(PJ + (r0 + t) * PROJ_LD + C_Q + hd * 96 + 8 * dc); k2[q] = *(const u32x4*)(PJ + (r0 + t) * PROJ_LD + C_K + hd * 96 + 8 * dc); }
    asm volatile("" : "+v"(q2[0]), "+v"(q2[1]), "+v"(k2[0]), "+v"(k2[1]));
#pragma unroll
    for (int q = 0; q < 2; ++q) { const int it = F.tid + NTHREADS * q, t = it & 63, dc = it >> 6;
        if (it < 64 * 12) {
        const u32x4 qv = q2[q], kv = k2[q];
        const float qq[8] = {bflo(qv.x), bfhi(qv.x), bflo(qv.y), bfhi(qv.y), bflo(qv.z), bfhi(qv.z), bflo(qv.w), bfhi(qv.w)};
        const float kk[8] = {bflo(kv.x), bfhi(kv.x), bflo(kv.y), bfhi(kv.y), bflo(kv.z), bfhi(kv.z), bflo(kv.w), bfhi(kv.w)};
        float qo[8], ko[8];
#pragma unroll
        for (int e = 0; e < 8; ++e) { const float bcv = bc[t * 97 + 8 * dc + e]; qo[e] = qq[e] * qscale * __expf(bcv); ko[e] = kk[e] * __expf(-bcv); }
        u32x4 qp, kp; qp.x = pk_bf16(qo[0], qo[1]); qp.y = pk_bf16(qo[2], qo[3]); qp.z = pk_bf16(qo[4], qo[5]); qp.w = pk_bf16(qo[6], qo[7]);
        kp.x = pk_bf16(ko[0], ko[1]); kp.y = pk_bf16(ko[2], ko[3]); kp.z = pk_bf16(ko[4], ko[5]); kp.w = pk_bf16(ko[6], ko[7]);
        *(LAS u32x4*)(QD + t * 104 + 8 * dc) = qp; *(LAS u32x4*)(KI + t * 104 + 8 * dc) = kp; } }
    gla_stage_vt(F, r0, hd, VT);
    __syncthreads();
    const int fr = F.lane & 15, fq = F.lane >> 4;
    { const int mb = F.wave >> 1;
      bf16x8 qa0 = ldfrag(QD, 104, 16 * mb, 0, fr, fq), qa1 = ldfrag(QD, 104, 16 * mb, 32, fr, fq), qa2 = ldfrag(QD, 104, 16 * mb, 64, fr, fq);
#pragma unroll
      for (int h = 0; h < 2; ++h) { const int nb = 2 * (F.wave & 1) + h;
          bf16x8 k0 = ldfrag(KI, 104, 16 * nb, 0, fr, fq), k1 = ldfrag(KI, 104, 16 * nb, 32, fr, fq), k2 = ldfrag(KI, 104, 16 * nb, 64, fr, fq);
          MFMA_GUARD_IN4(k0, k1, k2, qa0); asm volatile("" : "+v"(qa1), "+v"(qa2));
          f32x4 d = __builtin_amdgcn_mfma_f32_16x16x32_bf16(qa0, k0, (f32x4){0.f, 0.f, 0.f, 0.f}, 0, 0, 0);
          d = __builtin_amdgcn_mfma_f32_16x16x32_bf16(qa1, k1, d, 0, 0, 0);
          d = __builtin_amdgcn_mfma_f32_16x16x32_bf16(qa2, k2, d, 0, 0, 0);
          MFMA_GUARD_OUT(d);
#pragma unroll
          for (int jj = 0; jj < 4; ++jj) { const int i = 16 * mb + 4 * fq + jj, jc = 16 * nb + fr; AT[i * 72 + jc] = f2bf_sw(jc <= i ? d[jj] : 0.f); } } }
    __syncthreads();
    const int mb = F.wave & 3, nb0 = 6 * (F.wave >> 2);
    const bf16* SG = (const bf16*)(F.ws + WS_GLAS) + (size_t)unit * 18432;
    bf16x8 at0 = ldfrag(AT, 72, 16 * mb, 0, fr, fq), at1 = ldfrag(AT, 72, 16 * mb, 32, fr, fq);
    bf16x8 qa0 = ldfrag(QD, 104, 16 * mb, 0, fr, fq), qa1 = ldfrag(QD, 104, 16 * mb, 32, fr, fq), qa2 = ldfrag(QD, 104, 16 * mb, 64, fr, fq);
    f32x4 o[6];
    bf16x8 vf[6][2], sf[6][3];
#pragma unroll
    for (int q = 0; q < 6; ++q) { const int nb = nb0 + q; const bf16* sp = SG + (16 * nb + fr) * 96 + 8 * fq;
        sf[q][0] = *(const bf16x8*)(sp); sf[q][1] = *(const bf16x8*)(sp + 32); sf[q][2] = *(const bf16x8*)(sp + 64);
        vf[q][0] = ldfrag(VT, 72, 16 * nb, 0, fr, fq); vf[q][1] = ldfrag(VT, 72, 16 * nb, 32, fr, fq); }
    asm volatile("s_waitcnt vmcnt(0) lgkmcnt(0)\n\ts_nop 7" : "+v"(at0), "+v"(at1), "+v"(qa0), "+v"(qa1), "+v"(qa2));
#pragma unroll
    for (int q = 0; q < 6; ++q) {
        asm volatile("" : "+v"(vf[q][0]), "+v"(vf[q][1]), "+v"(sf[q][0]), "+v"(sf[q][1]), "+v"(sf[q][2]));
        f32x4 d = __builtin_amdgcn_mfma_f32_16x16x32_bf16(at0, vf[q][0], (f32x4){0.f, 0.f, 0.f, 0.f}, 0, 0, 0);
        d = __builtin_amdgcn_mfma_f32_16x16x32_bf16(at1, vf[q][1], d, 0, 0, 0);
        d = __builtin_amdgcn_mfma_f32_16x16x32_bf16(qa0, sf[q][0], d, 0, 0, 0);
        d = __builtin_amdgcn_mfma_f32_16x16x32_bf16(qa1, sf[q][1], d, 0, 0, 0);
        d = __builtin_amdgcn_mfma_f32_16x16x32_bf16(qa2, sf[q][2], d, 0, 0, 0);
        o[q] = d; }
    asm volatile("s_nop 15\n\ts_nop 15" : "+v"(o[0]), "+v"(o[1]), "+v"(o[2]), "+v"(o[3]), "+v"(o[4]), "+v"(o[5]));
    float ss[4];
#pragma unroll
    for (int jj = 0; jj < 4; ++jj) { float s_ = 0.f;
#pragma unroll
        for (int q = 0; q < 6; ++q) s_ += o[q][jj] * o[q][jj];
        s_ = xor_add<1>(s_); s_ = xor_add<2>(s_); s_ = xor_add<4>(s_); s_ = xor_add<8>(s_); ss[jj] = s_; }
    if (fr == 0) {
#pragma unroll
        for (int jj = 0; jj < 4; ++jj) red[(F.wave >> 2) * 64 + 16 * mb + 4 * fq + jj] = ss[jj]; }
    __syncthreads();
    bf16* MIX = (bf16*)(F.ws + WS_MIX);
    const float* hg = INP(a, I_GHG) + l * 192;
#pragma unroll
    for (int jj = 0; jj < 4; ++jj) { const int i = 16 * mb + 4 * fq + jj; const float rstd = rsqrtf((red[i] + red[64 + i]) * (1.f / 192.f) + EPS);
        const size_t row = r0 + i;
#pragma unroll
        for (int q = 0; q < 6; ++q) { const int v = 16 * (nb0 + q) + fr; const float og = bf2f(PJ[row * PROJ_LD + C_OG + hd * 192 + v]);
            MIX[row * DM + 1280 + hd * 192 + v] = f2bf(o[q][jj] * rstd * hg[v] * siluf_(og)); } }
    __syncthreads();
}

#ifdef DBG_HASH
constexpr int CW_HASH = 1024;
struct HashJob { int after_ph; size_t off; size_t bytes; };
__device__ __forceinline__ void hash_phase(const Frame& F, size_t off, size_t bytes, int slot) {
    const unsigned* w = (const unsigned*)(F.ws + off); const size_t n = bytes / 4;
    unsigned acc = 0u;
    for (size_t i = (size_t)F.bid * NTHREADS + F.tid; i < n; i += (size_t)F.G * NTHREADS) acc += w[i] * (unsigned)(2u * (unsigned)i + 1u);
#pragma unroll
    for (int o = 1; o < 64; o <<= 1) acc += __shfl_xor(acc, o);
    if (F.lane == 0) __hip_atomic_fetch_add(F.ctl + CW_HASH + slot * 64, acc, __ATOMIC_RELAXED, __HIP_MEMORY_SCOPE_AGENT);
}
__device__ __forceinline__ void emit_phase(const Frame& F, float* out) {
    const size_t total = (size_t)T * DM, seg = total / 16;
    for (size_t i = (size_t)F.bid * NTHREADS + F.tid; i < total; i += (size_t)F.G * NTHREADS) {
        const int k = (int)(i / seg); const unsigned h = __hip_atomic_load(F.ctl + CW_HASH + k * 64, __ATOMIC_RELAXED, __HIP_MEMORY_SCOPE_AGENT);
        const float amp = __builtin_ldexpf(1.f, -k);
        out[i] = amp * (float)((h >> (unsigned)(i & 31)) & 1u);
    }
}
#endif
#ifndef LB_W
#define LB_W 2
#endif
__global__ void __launch_bounds__(NTHREADS, LB_W) mega_fwd(Args args) {
    extern __shared__ __attribute__((aligned(16))) unsigned char lds_raw[];
    Frame F;
    F.lds = (LAS unsigned char*)lds_raw;
    F.MISC = (volatile LAS unsigned*)(F.lds + LDSCTL_OFF);
    F.wave = __builtin_amdgcn_readfirstlane((int)threadIdx.x >> 6); F.lane = lane_id(); F.tid = F.wave * 64 + F.lane;
    F.G = gridDim.x; F.bid = blockIdx.x;
    F.ws = (GAS unsigned char*)args.ws; F.ctl = (unsigned*)(F.ws + WS_CTL);
#ifdef DBG_POISON
    for (int u = F.tid; u < SCR_BYTES / 4; u += NTHREADS) ((LAS unsigned*)F.lds)[u] = 0xFFFFFFFFu;
#endif
    for (int u = F.tid; u < (LDS_BYTES - LDSCTL_OFF) / 4; u += NTHREADS) ((LAS unsigned*)(F.lds + LDSCTL_OFF))[u] = 0u;
    __syncthreads();
    XcdBarrier bar = xcd_barrier_post(F.ctl + CW_BAR + args.li * XCD_BAR_WORDS, F.MISC + 8, F.wave);
    const int lo = args.ph_lo, hi = args.ph_hi;
#ifdef DBG_HASH
    if (lo >= 200) { emit_phase(F, args.out); return; }
    if (lo >= 100) { hash_phase(F, (size_t)args.hoff, (size_t)args.hbytes, lo - 100); return; }
#endif
#ifndef PHMASK
#define PHMASK 0xFFFF
#endif
#define PH(k, id) if (((PHMASK >> (k)) & 1) && (id) >= lo && (id) < hi)
#define REFRESH() do { int lz_ = lane_id(); asm volatile("" : "+v"(lz_)); F.lane = lz_; F.tid = F.wave * 64 + lz_; asm volatile("" : "+s"(F.ws)); } while (0)
#define SEAM(id) do { if ((id) > lo) xcd_barrier(bar); REFRESH(); } while (0)
    const float* MOD = (const float*)(F.ws + WS_MOD);

    PH(0, 0) { p0_s5_consts(F, args); p0_lru_w(F, args); p0_ada(F, args); p0_convert(F, args); }

    for (int l = 0; l < DEPTH; ++l) {
        const int pb = 1 + 12 * l;
        const float* mod = MOD + (size_t)l * 4 * (NADA * DM);
        const float* xin = (l == 0) ? INP(args, I_X) : (const float*)(F.ws + WS_XCUR);
        PH(1, pb + 0) { SEAM(pb + 0); norm_phase<false, false>(F, args, xin, INP(args, I_NMIXG) + l * DM, mod, 0, 1, nullptr); }
        PH(2, pb + 1) { SEAM(pb + 1);
            pg8::Gemm g{(const bf16*)(F.ws + WS_H), (const bf16*)(F.ws + WS_WIN) + (size_t)l * PROJ_LD * DM, DM}; pg8::StaticOrder S; S.init(T, PROJ_LD, F.G, F.bid);
            pg8::EpiBf16Perm E{(bf16*)(F.ws + WS_PROJ), PROJ_LD};
            pg8::gemm_phase(F.lds, g, S, E, F.wave); }
        PH(3, pb + 2) { SEAM(pb + 2);
#ifndef M1_NO_GLA
            for (int u = F.bid; u < 512; u += F.G) gla_a_task(F, args, l, u);
#endif
            __syncthreads();
#ifndef M1_NO_S5
            for (int bt = F.bid; bt < 512; bt += F.G) s5_task<false>(F, args, l, ((bt >> 7) << 10) | ((8 * (bt & 3) + F.wave) << 5) | ((bt >> 2) & 31), F.lds + F.wave * 16384);
#endif
#ifndef M1_NO_LRU
            for (int t = F.bid * NWAVES + F.wave; t < 2048; t += F.G * NWAVES) lru_gate_task(F, args, l, t);
#endif
 }
        PH(4, pb + 3) { SEAM(pb + 3);
            for (int bt = F.bid; bt < 512; bt += F.G) s5_task<true>(F, args, l, ((bt >> 7) << 10) | ((8 * (bt & 3) + F.wave) << 5) | ((bt >> 2) & 31), F.lds + F.wave * 16384);
            for (int t = F.bid * NWAVES + F.wave; t < 1536; t += F.G * NWAVES) lru_scan_task(F, t);
            gla_scan_phase(F); }
        PH(5, pb + 4) { SEAM(pb + 4);
            { pg8::Gemm g{(const bf16*)(F.ws + WS_Z), (const bf16*)(F.ws + WS_WGLU) + (size_t)l * 1024 * 512, 512}; pg8::StaticOrder S; S.init(T, 1024, F.G, F.bid);
              pg8::EpiGlu E{(float*)(F.ws + WS_S5PRE), INP(args, I_S5BGLU) + l * 1024};
              pg8::gemm_phase(F.lds, g, S, E, F.wave); }
            REFRESH();
            __syncthreads();
#ifndef T_NO_A
            for (int u = (F.bid + 128 >= F.G) ? F.bid + 128 - F.G : F.bid + 128; u < 128; u += F.G) lru_out_task(F, args, l, u);
#endif
#ifndef T_NO_B
            for (int u = F.bid; u < 512; u += F.G) gla_b_task(F, args, l, u);
#endif
 }
        PH(6, pb + 5) { SEAM(pb + 5); s5norm_phase(F, INP(args, I_S5NG) + l * 512); }
        PH(7, pb + 6) { SEAM(pb + 6);
            pg8::Gemm g{(const bf16*)(F.ws + WS_MIX), (const bf16*)(F.ws + WS_WOUT) + (size_t)l * DM * DM, DM}; pg8::StaticOrder S; S.init(T, DM, F.G, F.bid);
            pg8::EpiResid E{(float*)(F.ws + WS_X1), xin, mod + 2 * DM, 1.f};
            pg8::gemm_phase(F.lds, g, S, E, F.wave); }
        PH(8, pb + 7) { SEAM(pb + 7);
            if (l & 1) norm_phase<true, true>(F, args, (const float*)(F.ws + WS_X1), INP(args, I_NFFNG) + l * DM, mod, 3, 4, INP(args, I_ROUTER) + (size_t)(l >> 1) * DM * NE);
            else norm_phase<false, false>(F, args, (const float*)(F.ws + WS_X1), INP(args, I_NFFNG) + l * DM, mod, 3, 4, nullptr); }
        const bool moe = (l & 1) != 0;
        if (moe) { PH(9, pb + 8) { SEAM(pb + 8); moe_sort_phase(F); } }
        if (moe) {
            PH(10, pb + 9) { SEAM(pb + 9); moe_tiles(F);
                pg8::Gemm g{(const bf16*)(F.ws + WS_AS), (const bf16*)(F.ws + WS_M13), DM / 2}; pg8::GroupedOrder S; S.init(F.MISC + 16, 2 * DFFE, F.G, F.bid, (long)2 * DFFE * DM);
                pg8::EpiSwiglu8 E{(unsigned char*)(F.ws + WS_HID), DFFE, 1.f / (SC_X * SC_W13), SC_H};
                pg8::gemm_phase8(F.lds, g, S, E, F.wave); }
            PH(11, pb + 10) { SEAM(pb + 10); moe_tiles(F);
                pg8::Gemm g{(const bf16*)(F.ws + WS_HID), (const bf16*)(F.ws + WS_M2), DFFE / 2}; pg8::GroupedOrder S; S.init(F.MISC + 16, DM, F.G, F.bid, (long)DM * DFFE, 2 * F.G);
                pg8::EpiF32 E{(float*)(F.ws + WS_Y), DM, 1.f / (SC_H * SC_W2)};
                pg8::gemm_phase8(F.lds, g, S, E, F.wave);
                pg8::TailOrder ST; ST.init(F.MISC + 16, DM, 2 * F.G, F.G, F.bid, (long)DM * DFFE, (long)64 * DFFE);
                pg8::EpiF32Narrow EN{(float*)(F.ws + WS_Y), DM, 1.f / (SC_H * SC_W2)};
                pg8::gemm_phase8<true>(F.lds, g, ST, EN, F.wave); }
        } else {
            PH(10, pb + 9) { SEAM(pb + 9);
                pg8::Gemm g{(const bf16*)(F.ws + WS_H), (const bf16*)(F.ws + WS_F13), DM}; pg8::StaticOrder S; S.init(T, 2 * DFF, F.G, F.bid);
                pg8::EpiSwiglu8 E{(unsigned char*)(F.ws + WS_HID), DFF, 1.f, SC_H};
                pg8::gemm_phase(F.lds, g, S, E, F.wave); }
            PH(11, pb + 10) { SEAM(pb + 10);
                pg8::Gemm g{(const bf16*)(F.ws + WS_HID), (const bf16*)(F.ws + WS_F2), DFF / 2}; pg8::StaticOrder S; S.init(T, DM, F.G, F.bid);
                pg8::EpiResid E{(float*)(F.ws + WS_XCUR), (const float*)(F.ws + WS_X1), mod + 5 * DM, 1.f / (SC_H * SC_W2)};
                pg8::gemm_phase8(F.lds, g, S, E, F.wave); }
        }
        if (moe) { PH(12, pb + 11) { SEAM(pb + 11); final_phase(F, args, mod); } }
    }
#undef PH
#undef SEAM
}

extern "C" void kernel_launch(void* const* d_in, const int* in_sizes, int n_in, void* d_out, int out_size, void* d_ws, size_t ws_size, hipStream_t stream) {
    static int grid = 0;
    if (grid == 0) {
        if (n_in != 38 || out_size != T * DM || ws_size < WS_END) { fprintf(stderr, "kernel_launch: unexpected shapes (n_in %d out %d ws %zu)\n", n_in, out_size, ws_size); grid = -1; return; }
        int dev = 0, cus = 0, per_cu = 0;
        if (hipGetDevice(&dev) != hipSuccess || hipDeviceGetAttribute(&cus, hipDeviceAttributeMultiprocessorCount, dev) != hipSuccess) { grid = -1; return; }
        if (hipFuncSetAttribute((const void*)mega_fwd, hipFuncAttributeMaxDynamicSharedMemorySize, LDS_BYTES) != hipSuccess) { fprintf(stderr, "kernel_launch: hipFuncSetAttribute failed\n"); grid = -1; return; }
        if (hipOccupancyMaxActiveBlocksPerMultiprocessor(&per_cu, (const void*)mega_fwd, NTHREADS, LDS_BYTES) != hipSuccess || per_cu < 1) { fprintf(stderr, "kernel_launch: occupancy query says %d\n", per_cu); }
        (void)hipGetLastError();
        grid = cus;
    }
    if (grid < 0) return;
    (void)hipMemsetAsync((char*)d_ws + WS_CTL, 0, CTL_BYTES, stream);
#ifdef DBG_POISON
    (void)hipMemsetAsync((char*)d_ws + CTL_BYTES, 0xFF, WS_END - CTL_BYTES, stream);
#endif
    Args a{};
    for (int i = 0; i < 38; ++i) a.in[i] = (const float*)d_in[i];
    a.out = (float*)d_out; a.ws = (unsigned char*)d_ws; a.pad = 0; a.hoff = 0; a.hbytes = 0;
    constexpr int NPH = 1 + 12 * DEPTH;
#if N_LAUNCH_MODE == 0
    a.ph_lo = 0; a.ph_hi = NPH; a.li = 0;
    hipLaunchKernelGGL(mega_fwd, dim3(grid), dim3(NTHREADS), LDS_BYTES, stream, a);
#else
    int li = 0;
    for (int ph = 0; ph < NPH; ++ph) {
        const int l = (ph - 1) / 12, k = (ph - 1) % 12;
        if (ph > 0) { if ((l & 1) == 0 && (k == 8 || k == 11)) continue; }
        a.ph_lo = ph; a.ph_hi = ph + 1; a.li = li++;
        hipLaunchKernelGGL(mega_fwd, dim3(grid), dim3(NTHREADS), LDS_BYTES, stream, a);
#ifdef DBG_HASH
        {
            static const HashJob jobs[16] = {
                {0, 1 * MiB, 3 * MiB}, {0, WS_WIN, WS_H - WS_WIN},
                {1, WS_H, 32 * MiB}, {2, WS_PROJ, 72 * MiB}, {3, WS_S5E, 2 * MiB}, {3, WS_LRUA, 84 * MiB},
                {4, WS_Z, 8 * MiB}, {4, WS_LRUA, 48 * MiB}, {4, WS_GLAD, 36 * MiB},
                {5, WS_S5PRE, 16 * MiB}, {5, WS_MIX, 32 * MiB}, {6, WS_MIX, 32 * MiB}, {7, WS_X1, 64 * MiB}, {8, WS_H, 32 * MiB}, {10, WS_HID, (size_t)T * DFF * 2}, {11, WS_XCUR, 64 * MiB} };
            for (int k = 0; k < 16; ++k) if (jobs[k].after_ph == ph) { Args h = a; h.ph_lo = 100 + k; h.ph_hi = 101 + k; h.hoff = jobs[k].off; h.hbytes = jobs[k].bytes; hipLaunchKernelGGL(mega_fwd, dim3(grid), dim3(NTHREADS), LDS_BYTES, stream, h); }
        }
#endif
    }
#ifdef DBG_HASH
    { Args h = a; h.ph_lo = 200; h.ph_hi = 201; hipLaunchKernelGGL(mega_fwd, dim3(grid), dim3(NTHREADS), LDS_BYTES, stream, h); }
#endif
#endif
}
```

```cpp
#include <hip/hip_runtime.h>
#include <cstdio>
#include <cstdint>

#ifndef N_LAUNCH_MODE
#define N_LAUNCH_MODE 0
#endif
#ifndef DBG_OUTSCALE
#define DBG_OUTSCALE 1.0f
#endif

#define DI __device__ __forceinline__
#define GAS __attribute__((address_space(1)))
#define LAS __attribute__((address_space(3)))
typedef unsigned short bf16;
typedef float f32x4 __attribute__((ext_vector_type(4)));
typedef float f32x2 __attribute__((ext_vector_type(2)));
typedef short bf16x8 __attribute__((ext_vector_type(8)));
typedef unsigned u32x4 __attribute__((ext_vector_type(4)));
typedef unsigned u32x2 __attribute__((ext_vector_type(2)));

constexpr int DM = 2048, NBATCH = 4, SEQ = 2048, T = NBATCH * SEQ, DEPTH = 2;
constexpr int DIN_SRC = 4368;
constexpr int PROJ_LD = 4608;
constexpr int C_U = 0, C_XL = 512, C_GL = 1280, C_Q = 2048, C_K = 2432, C_V = 2816, C_OG = 3584, C_GLOW = 4352;
constexpr int DFF = 5632, DFFE = 7168, NE = 8;
constexpr int NADA = 6;
constexpr float EPS = 1e-6f;
constexpr int MOE_ROWS = 18432;
constexpr int NWAVES = 8, NTHREADS = 512;
constexpr float SC_X = 16.f, SC_W13 = 256.f, SC_H = 16.f, SC_W2 = 512.f;

constexpr size_t MiB = 1u << 20;
constexpr size_t WS_CTL = 0, CTL_BYTES = 1 * MiB;
constexpr size_t WS_MOD = 1 * MiB;
constexpr size_t WS_S5C = 2 * MiB;
constexpr size_t S5C_STRIDE = 512 * 1024, S5C_ABAR = 0, S5C_ABARL = 16384, S5C_BBAR = 32768, S5C_CMAT = 32768 + 131072;
constexpr size_t WS_LRUW = 3 * MiB;
constexpr size_t LRUW_STRIDE = 512 * 1024, LRUW_X = 147456;
constexpr size_t WS_S5E = 4 * MiB;
constexpr size_t WS_ROUTE = 6 * MiB;
constexpr size_t WS_CNTBLK = 6 * MiB + 512 * 1024;
constexpr size_t WS_GAMMA = 7 * MiB;
constexpr size_t WS_WIN = 8 * MiB;
constexpr size_t WS_WOUT = 44 * MiB;
constexpr size_t WS_WGLU = 60 * MiB;
constexpr size_t WS_F13 = 62 * MiB;
constexpr size_t WS_F2 = 106 * MiB;
constexpr size_t WS_M13 = 128 * MiB;
constexpr size_t WS_M2 = 576 * MiB;
constexpr size_t WS_H = 800 * MiB;
constexpr size_t WS_PROJ = 832 * MiB;
constexpr size_t WS_LRUA = 904 * MiB;
constexpr size_t WS_LRUB = 928 * MiB;
constexpr size_t WS_GLAD = 952 * MiB;
constexpr size_t WS_Z = 988 * MiB;
constexpr size_t WS_S5PRE = 996 * MiB;
constexpr size_t WS_MIX = 1012 * MiB;
constexpr size_t WS_X1 = 1044 * MiB;
constexpr size_t WS_XCUR = 1108 * MiB;
constexpr size_t WS_HID = 1172 * MiB;
constexpr size_t WS_AS = 1424 * MiB;
constexpr size_t WS_Y = 1496 * MiB;
constexpr size_t WS_GLAS = WS_HID;
constexpr size_t WS_GLABC = WS_HID + 32 * MiB;
constexpr size_t WS_END = 1640 * MiB;

constexpr int CW_CNT = 64;
constexpr int CW_BAR = 4096;

constexpr int SCR_BYTES = 143360;
constexpr int LDSCTL_OFF = SCR_BYTES;
constexpr int LDS_BYTES = 147456;

#define LDS_WAIT() asm volatile("s_waitcnt lgkmcnt(0)" ::: "memory")
#define VM_WAIT() asm volatile("s_waitcnt vmcnt(0)" ::: "memory")
DI int lane_id() { unsigned m = ~0u; asm volatile("" : "+s"(m)); return (int)__builtin_amdgcn_mbcnt_hi(m, __builtin_amdgcn_mbcnt_lo(m, 0u)); }
DI unsigned pk_bf16(float lo, float hi) { unsigned r; asm("v_cvt_pk_bf16_f32 %0, %1, %2" : "=v"(r) : "v"(lo), "v"(hi)); return r; }
DI bf16 f2bf(float f) { return (bf16)(pk_bf16(f, 0.f) & 0xffffu); }
DI bf16 f2bf_sw(float f) { unsigned u = __builtin_bit_cast(unsigned, f); return (bf16)((u + 0x7fffu + ((u >> 16) & 1u)) >> 16); }
DI float bf2f(unsigned b) { return __builtin_bit_cast(float, b << 16); }
DI float bflo(unsigned w) { return __builtin_bit_cast(float, w << 16); }
DI float bfhi(unsigned w) { return __builtin_bit_cast(float, w & 0xffff0000u); }
template <int O> DI float xor_add(float v) { return v + __builtin_bit_cast(float, __builtin_amdgcn_ds_swizzle(__builtin_bit_cast(int, v), (O << 10) | 0x1f)); }
DI float half_sum(float v) { v = xor_add<1>(v); v = xor_add<2>(v); v = xor_add<4>(v); v = xor_add<8>(v); v = xor_add<16>(v); return v; }
DI float wave_sum(float v) {
    v = half_sum(v);
    return __builtin_bit_cast(float, __builtin_amdgcn_readlane(__builtin_bit_cast(int, v), 0)) + __builtin_bit_cast(float, __builtin_amdgcn_readlane(__builtin_bit_cast(int, v), 32));
}
DI float sigmoidf_(float x) { return __builtin_amdgcn_rcpf(1.f + __expf(-x)); }
DI float siluf_(float x) { return x * __builtin_amdgcn_rcpf(1.f + __expf(-x)); }
DI float gelu_tanh(float y) { const float u = 1.5957691216057308f * (y + 0.044715f * y * y * y); return y * __builtin_amdgcn_rcpf(1.f + __expf(-u)); }
DI float logsigmoidf_(float x) { return fminf(x, 0.f) - log1pf(__expf(-fabsf(x))); }
DI float logsigmoid_fast(float x) { return fminf(x, 0.f) - __logf(1.f + __expf(-fabsf(x))); }

#define XB_TMO      128
#define XB_XCNT(j)  (256  + 64 * (j))
#define XB_XSUB(j)  (1280 + 64 * (j))
#define XB_XGEN(j)  (2304 + 64 * (j))
#define XB_TOP      3328
#define XB_TOPGEN   3392
#define XCD_BAR_WORDS 3456
#define XB_SPIN_CAP (1u << 18)
__device__ __forceinline__ unsigned xb_ld(unsigned* p)              { return __hip_atomic_load(p, __ATOMIC_RELAXED, __HIP_MEMORY_SCOPE_AGENT); }
__device__ __forceinline__ unsigned xb_add(unsigned* p, unsigned v) { asm volatile("" : "+s"(v)); return __hip_atomic_fetch_add(p, v, __ATOMIC_RELAXED, __HIP_MEMORY_SCOPE_AGENT); }
__device__ __forceinline__ unsigned xb_xcc_id() { return (unsigned)__builtin_amdgcn_s_getreg((3 << 11) | 20) & 0xFu; }
#define XB_SPIN(cond, bar) do { unsigned _sp = 0; while (cond) { __builtin_amdgcn_s_sleep(1); \
    if ((++_sp & 255u) == 0u) { if (xb_ld(&(bar)[XB_TMO])) break; if (_sp > XB_SPIN_CAP) { atomicAdd(&(bar)[XB_TMO], 1u); break; } } } } while (0)
struct XcdBarrier { unsigned* bar; unsigned x; volatile LAS unsigned* st; int wave; };
__device__ __forceinline__ XcdBarrier xcd_barrier_post(unsigned* bar, volatile LAS unsigned* st, int wave) {
    XcdBarrier b; b.bar = bar; b.x = xb_xcc_id(); b.st = st; b.wave = wave;
    if (wave == 0 && lane_id() == 0) (void)xb_add(&bar[XB_XCNT(b.x)], 1u);
    return b;
}
__device__ __forceinline__ void xcd_barrier_complete(unsigned* bar, unsigned x, unsigned& nloc, unsigned& nx) {
    const unsigned G = gridDim.x * gridDim.y * gridDim.z;
    unsigned sum, cnt, mine, sp = 0u;
    for (;;) {
        sum = 0u; cnt = 0u; mine = 0u;
#pragma unroll
        for (unsigned j = 0; j < 16; ++j) { const unsigned c = xb_ld(&bar[XB_XCNT(j)]); sum += c; cnt += (c > 0u) ? 1u : 0u; mine = (j == x) ? c : mine; }
        if (sum == G) break;
        __builtin_amdgcn_s_sleep(1);
        if ((++sp & 255u) == 0u) { if (xb_ld(&bar[XB_TMO])) break; if (sp > XB_SPIN_CAP) { atomicAdd(&bar[XB_TMO], 1u); break; } }
    }
    nloc = mine > 0u ? mine : 1u; nx = cnt > 0u ? cnt : 1u;
}
__device__ __forceinline__ void xcd_barrier(const XcdBarrier& b) {
    asm volatile("s_waitcnt vmcnt(0)" ::: "memory");
    __syncthreads();
    if (b.wave == 0 && lane_id() == 0) {
        unsigned* bar = b.bar;
        __builtin_amdgcn_s_waitcnt(0);
        unsigned nloc = b.st[0], nx = b.st[1];
        if (nloc == 0u) { xcd_barrier_complete(bar, b.x, nloc, nx); b.st[0] = nloc; b.st[1] = nx; }
        const unsigned old = xb_add(&bar[XB_XSUB(b.x)], 1u);
        const unsigned gen = old / nloc;
        if (old + 1u == (gen + 1u) * nloc) {
            __builtin_amdgcn_fence(__ATOMIC_RELEASE, "agent");
            asm volatile("s_waitcnt vmcnt(0)" ::: "memory");
            const unsigned og = xb_add(&bar[XB_TOP], 1u);
            const unsigned tg = og / nx;
            if (og + 1u == (tg + 1u) * nx) xb_add(&bar[XB_TOPGEN], 1u);
            else XB_SPIN(xb_ld(&bar[XB_TOPGEN]) == tg, bar);
            __builtin_amdgcn_fence(__ATOMIC_ACQUIRE, "agent");
            xb_add(&bar[XB_XGEN(b.x)], 1u);
            asm volatile("s_waitcnt vmcnt(0)" ::: "memory");
        } else {
            XB_SPIN(xb_ld(&bar[XB_XGEN(b.x)]) == gen, bar);
            __builtin_amdgcn_fence(__ATOMIC_ACQUIRE, "agent");
            asm volatile("s_waitcnt vmcnt(0)" ::: "memory");
        }
    }
    __syncthreads();
}

namespace pg8 {
constexpr int BM = 256, BK = 64, HALF = 128, HTB = HALF * BK * 2, STAGE_BYTES = 8 * HTB, NXCD = 8, WGM = 6;
__host__ __device__ __forceinline__ int lds_byte(int r, int c) { const int st = (r >> 4) * 2 + (c >> 5), rr = r & 15, cc = c & 31, ob = rr * 64 + cc * 2; return st * 1024 + (ob ^ (((ob >> 9) & 1) << 5)); }
__host__ __device__ __forceinline__ void stage_rc(int b_, int& R, int& C) { const unsigned b = (unsigned)b_, st = b >> 10, sb = b & 1023u, swz = sb ^ (((sb >> 9) & 1u) << 5); R = (int)((st >> 1) * 16u + (swz >> 6)); C = (int)((st & 1u) * 32u + ((swz & 63u) >> 1)); }
__host__ __device__ __forceinline__ int perm32(int rho) { const int n = rho >> 4, i = rho & 15; return 8 * (i >> 2) + 4 * n + (i & 3); }

struct Unit { int pm, pn; long boff; int q; };
struct Gemm { const bf16* A; const bf16* Bt; int K; };

__device__ __forceinline__ int xcd_remap(int wgid, int nwg) { const int q = nwg / NXCD, r = nwg % NXCD, xcd = wgid % NXCD, off = wgid / NXCD; return (xcd < r ? xcd * (q + 1) : r * (q + 1) + (xcd - r) * q) + off; }
struct StaticOrder {
    int nM, nN, nwg, G, c;
    __device__ void init(int M, int N, int G_, int c_) { nM = M / BM; nN = N / BM; nwg = nM * nN; G = G_; c = c_; }
    __device__ bool next(int i, Unit& u) const {
        const long L = (long)i * G + c; if (L >= nwg) return false;
        const int wgid = xcd_remap((int)L, nwg);
        const int nig = WGM * nN, gid = wgid / nig, fm = gid * WGM, gsz = (nM - fm) < WGM ? (nM - fm) : WGM;
        u.pm = fm + ((wgid % nig) % gsz); u.pn = (wgid % nig) / gsz; u.boff = 0; return true;
    }
};
struct GroupedOrder {
    volatile LAS unsigned* ts; int nN, nwg, lim, G, c; long estride;
    __device__ void init(volatile LAS unsigned* ts_, int N, int G_, int c_, long estride_, int lim_ = 1 << 30) { ts = ts_; nN = N / BM; nwg = __builtin_amdgcn_readfirstlane((int)ts_[8] * nN); lim = nwg < lim_ ? nwg : lim_; G = G_; c = c_; estride = estride_; }
    __device__ bool next(int i, Unit& u) const {
        const long L = (long)i * G + c; if (L >= lim) return false;
        const int wgid = xcd_remap((int)L, nwg);
        int e = 0;
#pragma unroll
        for (int k = 1; k < 8; ++k) if (wgid >= (int)ts[k] * nN) e = k;
        const int t0 = (int)ts[e], te = (int)ts[e + 1] - t0, Lp = wgid - t0 * nN;
        u.pn = __builtin_amdgcn_readfirstlane(Lp / te); u.pm = __builtin_amdgcn_readfirstlane(t0 + Lp % te); u.boff = (long)__builtin_amdgcn_readfirstlane(e) * estride; return true;
    }
};

struct TailOrder {
    volatile LAS unsigned* ts; int nN, nwg, first, G, c; long estride, qstride;
    __device__ void init(volatile LAS unsigned* ts_, int N, int first_, int G_, int c_, long estride_, long qstride_) { ts = ts_; nN = N / BM; nwg = __builtin_amdgcn_readfirstlane((int)ts_[8] * nN); first = first_; G = G_; c = c_; estride = estride_; qstride = qstride_; }
    __device__ bool next(int i, Unit& u) const {
        const int s = i * G + c, L = first + (s & 7) + 8 * (s >> 5), q = (s >> 3) & 3;
        if (L >= nwg) return false;
        const int wgid = xcd_remap(L, nwg);
        int e = 0;
#pragma unroll
        for (int k = 1; k < 8; ++k) if (wgid >= (int)ts[k] * nN) e = k;
        const int t0 = (int)ts[e], te = (int)ts[e + 1] - t0, Lp = wgid - t0 * nN;
        u.pn = __builtin_amdgcn_readfirstlane(Lp / te); u.pm = __builtin_amdgcn_readfirstlane(t0 + Lp % te); u.q = q; u.boff = (long)__builtin_amdgcn_readfirstlane(e) * estride + (long)q * qstride; return true;
    }
};

__device__ __forceinline__ void glds16(const char* sbase, unsigned voff, unsigned m0v) {
    unsigned keep;
    asm volatile("s_mov_b32 %0, m0\n\ts_mov_b32 m0, %3\n\ts_nop 0\n\tglobal_load_lds_dwordx4 %1, %2\n\ts_mov_b32 m0, %0" : "=&s"(keep) : "v"(voff), "s"(sbase), "s"(m0v) : "memory");
}
template <class Epi, class Sched>
__device__ __forceinline__ void gemm_phase(LAS unsigned char* lds, const Gemm g, const Sched& S, const Epi& E, const int wid) {
    int lane = lane_id(); asm volatile("" : "+v"(lane));
    const int tid = wid * 64 + lane, wr = wid >> 2, wc = wid & 3, fr = lane & 15, fq = lane >> 4;
    const int K = g.K, nt = K / BK;
    unsigned voffA; { int R, C; stage_rc(tid * 16, R, C); voffA = (unsigned)(R * K + C) * 2u; }
    const size_t rstep = (size_t)64 * K * 2;
    const size_t kstep = (size_t)(BK * 2);
    const size_t hstep = (size_t)HALF * K * 2;
    const size_t tstep = 2 * hstep;
    const unsigned ldsb = (unsigned)(unsigned long)lds + (unsigned)wid * 1024u;
    const int aoff = lds_byte(wr * 64 + fr, fq * 8), boff = lds_byte(wc * 32 + fr, fq * 8);
#define PG8_SA(b, h) (((b) * 2 + (h)) * HTB)
#define PG8_SB(b, h) ((4 + (b) * 2 + (h)) * HTB)
#define PG8_STAGE(bufoff, gbase) do { _Pragma("unroll") for (int _i = 0; _i < 2; ++_i) glds16((const char*)(gbase) + _i * rstep, voffA, ldsb + (unsigned)((bufoff) + _i * 8192)); } while (0)
#define PG8_LDA(dst, b, h) do { _Pragma("unroll") for (int m = 0; m < 4; ++m) _Pragma("unroll") for (int k = 0; k < 2; ++k) dst[m][k] = *(const LAS bf16x8*)(lds + PG8_SA(b, h) + aoff + m * 2048 + k * 1024); } while (0)
#define PG8_LDB(dst, b, h) do { _Pragma("unroll") for (int n = 0; n < 2; ++n) _Pragma("unroll") for (int k = 0; k < 2; ++k) dst[n][k] = *(const LAS bf16x8*)(lds + PG8_SB(b, h) + boff + n * 2048 + k * 1024); } while (0)
#define PG8_MMA(ai, bj, At, Bt) do { __builtin_amdgcn_s_setprio(1); _Pragma("unroll") for (int m = 0; m < 4; ++m) _Pragma("unroll") for (int n = 0; n < 2; ++n) _Pragma("unroll") for (int k = 0; k < 2; ++k) \
        acc[ai][bj][m][n] = __builtin_amdgcn_mfma_f32_16x16x32_bf16(Bt[n][k], At[m][k], acc[ai][bj][m][n], 0, 0, 0); __builtin_amdgcn_s_setprio(0); } while (0)
#define PG8_WAIT_V(n) asm volatile("s_waitcnt vmcnt(" #n ")" ::: "memory")
#define PG8_WAIT_L(n) asm volatile("s_waitcnt lgkmcnt(" #n ")" ::: "memory")
#define PG8_BAR __builtin_amdgcn_s_barrier()
#define PG8_SCHED __builtin_amdgcn_sched_barrier(0)
    Unit cur, nxt; int ui = 0;
    if (!S.next(0, cur)) return;
    f32x4 acc[2][2][4][2];
#pragma unroll
    for (int a = 0; a < 2; ++a)
#pragma unroll
        for (int b = 0; b < 2; ++b)
#pragma unroll
            for (int m = 0; m < 4; ++m)
#pragma unroll
                for (int n = 0; n < 2; ++n) acc[a][b][m][n] = (f32x4){0.f, 0.f, 0.f, 0.f};
    bf16x8 At[4][2], B0[2][2], B1[2][2];
    const char* cA = (const char*)g.A + (size_t)cur.pm * tstep; const char* cB = (const char*)g.Bt + cur.boff + (size_t)cur.pn * tstep;
    PG8_STAGE(PG8_SB(0, 0), cB); PG8_STAGE(PG8_SB(0, 1), cB + hstep); PG8_STAGE(PG8_SA(0, 0), cA); PG8_STAGE(PG8_SA(0, 1), cA + hstep);
    if (wr == 1) PG8_BAR;
    PG8_WAIT_V(2); PG8_BAR;
    PG8_STAGE(PG8_SB(1, 0), cB + kstep); PG8_STAGE(PG8_SA(1, 0), cA + kstep); PG8_STAGE(PG8_SB(1, 1), cB + hstep + kstep);
    PG8_WAIT_V(6); PG8_BAR;
    for (;;) {
        const bool has_next = S.next(ui + 1, nxt);
        const char* nA = has_next ? (const char*)g.A + (size_t)nxt.pm * tstep : cA; const char* nB = has_next ? (const char*)g.Bt + nxt.boff + (size_t)nxt.pn * tstep : cB;
        for (int t = 0; t < nt; t += 2) {
            const bool last = (t == nt - 2);
            const char* a1 = cA + (size_t)(t + 1) * kstep;
            const char* a2 = last ? nA : cA + (size_t)(t + 2) * kstep; const char* b2 = last ? nB : cB + (size_t)(t + 2) * kstep;
            const char* a3 = a2 + kstep; const char* b3 = b2 + kstep;
            PG8_LDB(B0, 0, 0); PG8_LDB(B1, 0, 1); PG8_SCHED; PG8_LDA(At, 0, 0); PG8_STAGE(PG8_SA(1, 1), a1 + hstep);
            PG8_WAIT_V(8); PG8_WAIT_L(0); PG8_BAR; PG8_MMA(0, 0, At, B0); PG8_MMA(0, 1, At, B1); PG8_BAR; PG8_SCHED;
            PG8_LDA(At, 0, 1); PG8_STAGE(PG8_SB(0, 0), b2); PG8_STAGE(PG8_SB(0, 1), b2 + hstep); PG8_STAGE(PG8_SA(0, 0), a2);
            PG8_WAIT_V(8); PG8_WAIT_L(0); PG8_BAR; PG8_MMA(1, 0, At, B0); PG8_MMA(1, 1, At, B1); PG8_BAR; PG8_SCHED;
            PG8_LDB(B0, 1, 0); PG8_LDB(B1, 1, 1); PG8_SCHED; PG8_LDA(At, 1, 0); PG8_STAGE(PG8_SA(0, 1), a2 + hstep);
            PG8_WAIT_V(8); PG8_WAIT_L(0); PG8_BAR; PG8_MMA(0, 0, At, B0); PG8_MMA(0, 1, At, B1); PG8_BAR; PG8_SCHED;
            PG8_LDA(At, 1, 1); PG8_STAGE(PG8_SB(1, 0), b3); PG8_STAGE(PG8_SB(1, 1), b3 + hstep); PG8_STAGE(PG8_SA(1, 0), a3);
            PG8_WAIT_V(8); PG8_WAIT_L(0); PG8_BAR; PG8_MMA(1, 0, At, B0); PG8_MMA(1, 1, At, B1); PG8_BAR; PG8_SCHED;
        }
        if (wr == 0) PG8_BAR;
        { int lz = lane_id(); asm volatile("" : "+v"(lz)); E(acc, cur, wid >> 2, wid & 3, lz & 15, lz >> 4); }
        if (!has_next) break;
        { float z0 = 0.f; asm volatile("" : "+v"(z0));
#pragma unroll
        for (int a = 0; a < 2; ++a)
#pragma unroll
            for (int b = 0; b < 2; ++b)
#pragma unroll
                for (int m = 0; m < 4; ++m)
#pragma unroll
                    for (int n = 0; n < 2; ++n) acc[a][b][m][n] = (f32x4){z0, z0, z0, z0}; }
        cur = nxt; cA = nA; cB = nB; ++ui;
        if (wr == 1) PG8_BAR;
    }
    PG8_WAIT_V(0);
    PG8_BAR;
#undef PG8_SA
#undef PG8_SB
#undef PG8_STAGE
#undef PG8_LDA
#undef PG8_LDB
#undef PG8_MMA
#undef PG8_WAIT_V
#undef PG8_WAIT_L
#undef PG8_BAR
#undef PG8_SCHED
}

typedef int i32x8 __attribute__((ext_vector_type(8)));
typedef int i32x4 __attribute__((ext_vector_type(4)));
__device__ __forceinline__ i32x8 ld32(const LAS unsigned char* p) { const i32x4 a = *(const LAS i32x4*)p, b = *(const LAS i32x4*)(p + 1024); return __builtin_shufflevector(a, b, 0, 1, 2, 3, 4, 5, 6, 7); }
template <bool NARROW = false, class Epi, class Sched>
__device__ __forceinline__ void gemm_phase8(LAS unsigned char* lds, const Gemm g, const Sched& S, const Epi& E, const int wid) {
    int lane = lane_id(); asm volatile("" : "+v"(lane));
    const int tid = wid * 64 + lane, wr = wid >> 2, wc = wid & 3, fr = lane & 15, fq = lane >> 4;
    const int K = g.K, nt = K / BK;
    unsigned voffA; { int R, C; stage_rc(tid * 16, R, C); voffA = (unsigned)(R * K + C) * 2u; }
    const size_t rstep = (size_t)64 * K * 2;
    const size_t kstep = (size_t)(BK * 2);
    const size_t hstep = (size_t)HALF * K * 2;
    const size_t tstep = 2 * hstep;
    const size_t bh = NARROW ? 0 : hstep;
    const unsigned ldsb = (unsigned)(unsigned long)lds + (unsigned)wid * 1024u;
    const int aoff = lds_byte(wr * 64 + fr, fq * 8), boff = NARROW ? lds_byte(wc * 16 + fr, fq * 8) : lds_byte(wc * 32 + fr, fq * 8);
#define PG8_SA(b, h) (((b) * 2 + (h)) * HTB)
#define PG8_SB(b, h) ((4 + (b) * 2 + (h)) * HTB)
#define PG8_STAGE(bufoff, gbase) do { _Pragma("unroll") for (int _i = 0; _i < 2; ++_i) glds16((const char*)(gbase) + _i * rstep, voffA, ldsb + (unsigned)((bufoff) + _i * 8192)); } while (0)
#define PG8_LDA(dst, b, h) do { _Pragma("unroll") for (int m = 0; m < 4; ++m) dst[m] = ld32(lds + PG8_SA(b, h) + aoff + m * 2048); } while (0)
#define PG8_LDB(dst, b, h) do { _Pragma("unroll") for (int n = 0; n < (NARROW ? 1 : 2); ++n) dst[n] = ld32(lds + PG8_SB(b, h) + boff + n * 2048); } while (0)
#define PG8_MMA(ai, bj, At, Bt) do { __builtin_amdgcn_s_setprio(1); _Pragma("unroll") for (int m = 0; m < 4; ++m) _Pragma("unroll") for (int n = 0; n < (NARROW ? 1 : 2); ++n) \
        asm volatile("v_mfma_scale_f32_16x16x128_f8f6f4 %0, %1, %2, %0, %3, %3 op_sel_hi:[0,0,0]" : "+v"(acc[ai][bj][m][n]) : "v"(Bt[n]), "v"(At[m]), "v"(mxscale)); __builtin_amdgcn_s_setprio(0); } while (0)
#define PG8_WAIT_V(n) asm volatile("s_waitcnt vmcnt(" #n ")" ::: "memory")
#define PG8_WAIT_L(n) asm volatile("s_waitcnt lgkmcnt(" #n ")" ::: "memory")
#define PG8_BAR __builtin_amdgcn_s_barrier()
#define PG8_SCHED __builtin_amdgcn_sched_barrier(0)
    const int mxscale = 0x7F7F7F7F;
    Unit cur, nxt; int ui = 0;
    if (!S.next(0, cur)) return;
    f32x4 acc[2][2][4][2];
#pragma unroll
    for (int a = 0; a < 2; ++a)
#pragma unroll
        for (int b = 0; b < 2; ++b)
#pragma unroll
            for (int m = 0; m < 4; ++m)
#pragma unroll
                for (int n = 0; n < 2; ++n) acc[a][b][m][n] = (f32x4){0.f, 0.f, 0.f, 0.f};
    i32x8 At[4], B0[2], B1[2];
    const char* cA = (const char*)g.A + (size_t)cur.pm * tstep; const char* cB = (const char*)g.Bt + cur.boff + (size_t)cur.pn * tstep;
    PG8_STAGE(PG8_SB(0, 0), cB); PG8_STAGE(PG8_SB(0, 1), cB + bh); PG8_STAGE(PG8_SA(0, 0), cA); PG8_STAGE(PG8_SA(0, 1), cA + hstep);
    if (wr == 1) PG8_BAR;
    PG8_WAIT_V(2); PG8_BAR;
    PG8_STAGE(PG8_SB(1, 0), cB + kstep); PG8_STAGE(PG8_SA(1, 0), cA + kstep); PG8_STAGE(PG8_SB(1, 1), cB + bh + kstep);
    PG8_WAIT_V(6); PG8_BAR;
    for (;;) {
        const bool has_next = S.next(ui + 1, nxt);
        const char* nA = has_next ? (const char*)g.A + (size_t)nxt.pm * tstep : cA; const char* nB = has_next ? (const char*)g.Bt + nxt.boff + (size_t)nxt.pn * tstep : cB;
        for (int t = 0; t < nt; t += 2) {
            const bool last = (t == nt - 2);
            const char* a1 = cA + (size_t)(t + 1) * kstep;
            const char* a2 = last ? nA : cA + (size_t)(t + 2) * kstep; const char* b2 = last ? nB : cB + (size_t)(t + 2) * kstep;
            const char* a3 = a2 + kstep; const char* b3 = b2 + kstep;
            PG8_LDB(B0, 0, 0); if constexpr (!NARROW) PG8_LDB(B1, 0, 1); PG8_SCHED; PG8_LDA(At, 0, 0); PG8_STAGE(PG8_SA(1, 1), a1 + hstep);
            PG8_WAIT_V(8); PG8_WAIT_L(0); PG8_BAR; PG8_MMA(0, 0, At, B0); if constexpr (!NARROW) PG8_MMA(0, 1, At, B1); PG8_BAR; PG8_SCHED;
            PG8_LDA(At, 0, 1); PG8_STAGE(PG8_SB(0, 0), b2); PG8_STAGE(PG8_SB(0, 1), b2 + bh); PG8_STAGE(PG8_SA(0, 0), a2);
            PG8_WAIT_V(8); PG8_WAIT_L(0); PG8_BAR; PG8_MMA(1, 0, At, B0); if constexpr (!NARROW) PG8_MMA(1, 1, At, B1); PG8_BAR; PG8_SCHED;
            PG8_LDB(B0, 1, 0); if constexpr (!NARROW) PG8_LDB(B1, 1, 1); PG8_SCHED; PG8_LDA(At, 1, 0); PG8_STAGE(PG8_SA(0, 1), a2 + hstep);
            PG8_WAIT_V(8); PG8_WAIT_L(0); PG8_BAR; PG8_MMA(0, 0, At, B0); if constexpr (!NARROW) PG8_MMA(0, 1, At, B1); PG8_BAR; PG8_SCHED;
            PG8_LDA(At, 1, 1); PG8_STAGE(PG8_SB(1, 0), b3); PG8_STAGE(PG8_SB(1, 1), b3 + bh); PG8_STAGE(PG8_SA(1, 0), a3);
            PG8_WAIT_V(8); PG8_WAIT_L(0); PG8_BAR; PG8_MMA(1, 0, At, B0); if constexpr (!NARROW) PG8_MMA(1, 1, At, B1); PG8_BAR; PG8_SCHED;
        }
        if (wr == 0) PG8_BAR;
        asm volatile("s_nop 15\n\ts_nop 15" ::: "memory");
        { int lz = lane_id(); asm volatile("" : "+v"(lz)); E(acc, cur, wid >> 2, wid & 3, lz & 15, lz >> 4); }
        if (!has_next) break;
        { float z0 = 0.f; asm volatile("" : "+v"(z0));
#pragma unroll
        for (int a = 0; a < 2; ++a)
#pragma unroll
            for (int b = 0; b < 2; ++b)
#pragma unroll
                for (int m = 0; m < 4; ++m)
#pragma unroll
                    for (int n = 0; n < 2; ++n) acc[a][b][m][n] = (f32x4){z0, z0, z0, z0}; }
        cur = nxt; cA = nA; cB = nB; ++ui;
        if (wr == 1) PG8_BAR;
    }
    PG8_WAIT_V(0);
    PG8_BAR;
#undef PG8_SA
#undef PG8_SB
#undef PG8_STAGE
#undef PG8_LDA
#undef PG8_LDB
#undef PG8_MMA
#undef PG8_WAIT_V
#undef PG8_WAIT_L
#undef PG8_BAR
#undef PG8_SCHED
}

struct EpiBf16Perm {
    bf16* O; int ldc;
    __device__ __forceinline__ void operator()(const f32x4 (&acc)[2][2][4][2], const Unit& u, int wr, int wc, int fr, int fq) const {
        const int row0 = u.pm * BM + wr * 64 + fr, col0 = u.pn * BM + wc * 32 + 8 * fq;
#pragma unroll
        for (int ai = 0; ai < 2; ++ai)
#pragma unroll
            for (int m = 0; m < 4; ++m) { bf16* rowp = O + (size_t)(row0 + ai * HALF + m * 16) * ldc + col0;
#pragma unroll
                for (int bj = 0; bj < 2; ++bj) { const f32x4 v0 = acc[ai][bj][m][0], v1 = acc[ai][bj][m][1];
                    u32x4 w; w.x = pk_bf16(v0[0], v0[1]); w.y = pk_bf16(v0[2], v0[3]); w.z = pk_bf16(v1[0], v1[1]); w.w = pk_bf16(v1[2], v1[3]);
                    *(u32x4*)(rowp + bj * HALF) = w; } }
    }
};
struct EpiSwiglu {
    bf16* O; int ldo;
    __device__ __forceinline__ void operator()(const f32x4 (&acc)[2][2][4][2], const Unit& u, int wr, int wc, int fr, int fq) const {
        const int row0 = u.pm * BM + wr * 64 + fr, col0 = u.pn * HALF + wc * 16 + 4 * fq;
#pragma unroll
        for (int ai = 0; ai < 2; ++ai)
#pragma unroll
            for (int m = 0; m < 4; ++m) { bf16* rowp = O + (size_t)(row0 + ai * HALF + m * 16) * ldo + col0;
#pragma unroll
                for (int bj = 0; bj < 2; ++bj) { const f32x4 a = acc[ai][bj][m][0], b = acc[ai][bj][m][1];
                    u32x2 w; w.x = pk_bf16(siluf_(a[0]) * b[0], siluf_(a[1]) * b[1]); w.y = pk_bf16(siluf_(a[2]) * b[2], siluf_(a[3]) * b[3]);
                    *(u32x2*)(rowp + bj * 64) = w; } }
    }
};
DI unsigned pk4_fp8(float a, float b, float c, float d) {
    float cm = 448.f; asm volatile("" : "+s"(cm));
    a = __builtin_amdgcn_fmed3f(a, -cm, cm); b = __builtin_amdgcn_fmed3f(b, -cm, cm); c = __builtin_amdgcn_fmed3f(c, -cm, cm); d = __builtin_amdgcn_fmed3f(d, -cm, cm);
    int w = __builtin_amdgcn_cvt_pk_fp8_f32(a, b, 0, false); w = __builtin_amdgcn_cvt_pk_fp8_f32(c, d, w, true); return (unsigned)w; }
struct EpiSwiglu8 {
    unsigned char* O; int ldo; float inv, oscale;
    __device__ __forceinline__ void operator()(const f32x4 (&acc)[2][2][4][2], const Unit& u, int wr, int wc, int fr, int fq) const {
        const int row0 = u.pm * BM + wr * 64 + fr, col0 = u.pn * HALF + wc * 16 + 4 * fq;
#pragma unroll
        for (int ai = 0; ai < 2; ++ai)
#pragma unroll
            for (int m = 0; m < 4; ++m) { unsigned char* rowp = O + (size_t)(row0 + ai * HALF + m * 16) * ldo + col0;
#pragma unroll
                for (int bj = 0; bj < 2; ++bj) { const f32x4 a = acc[ai][bj][m][0] * inv, b = acc[ai][bj][m][1] * (inv * oscale);
                    *(unsigned*)(rowp + bj * 64) = pk4_fp8(siluf_(a[0]) * b[0], siluf_(a[1]) * b[1], siluf_(a[2]) * b[2], siluf_(a[3]) * b[3]); } }
    }
};
struct EpiGlu {
    float* O; const float* bias;
    __device__ __forceinline__ void operator()(const f32x4 (&acc)[2][2][4][2], const Unit& u, int wr, int wc, int fr, int fq) const {
        const int row0 = u.pm * BM + wr * 64 + fr, col0 = u.pn * HALF + wc * 16 + 4 * fq;
        f32x4 bv[2], bg[2];
#pragma unroll
        for (int bj = 0; bj < 2; ++bj) { bv[bj] = *(const f32x4*)(bias + col0 + bj * 64); bg[bj] = *(const f32x4*)(bias + 512 + col0 + bj * 64); }
#pragma unroll
        for (int ai = 0; ai < 2; ++ai)
#pragma unroll
            for (int m = 0; m < 4; ++m) { float* rowp = O + (size_t)(row0 + ai * HALF + m * 16) * 512 + col0;
#pragma unroll
                for (int bj = 0; bj < 2; ++bj) { const f32x4 a = acc[ai][bj][m][0] + bv[bj], b = acc[ai][bj][m][1] + bg[bj];
                    f32x4 o; o[0] = a[0] * sigmoidf_(b[0]); o[1] = a[1] * sigmoidf_(b[1]); o[2] = a[2] * sigmoidf_(b[2]); o[3] = a[3] * sigmoidf_(b[3]);
                    *(f32x4*)(rowp + bj * 64) = o; } }
    }
};
struct EpiResid {
    float* O; const float* X; const float* gate; float scale;
    __device__ __forceinline__ void operator()(const f32x4 (&acc)[2][2][4][2], const Unit& u, int wr, int wc, int fr, int fq) const {
        const int row0 = u.pm * BM + wr * 64 + fr, col0 = u.pn * BM + wc * 32 + 4 * fq;
        const float* gp = gate + (size_t)(u.pm >> 3) * (NADA * DM) + col0;
        f32x4 gv[2][2];
#pragma unroll
        for (int bj = 0; bj < 2; ++bj)
#pragma unroll
            for (int n = 0; n < 2; ++n) gv[bj][n] = *(const f32x4*)(gp + bj * HALF + n * 16) * scale;
#pragma unroll
        for (int ai = 0; ai < 2; ++ai)
#pragma unroll
            for (int m = 0; m < 4; ++m) { const size_t off = (size_t)(row0 + ai * HALF + m * 16) * DM + col0;
#pragma unroll
                for (int bj = 0; bj < 2; ++bj)
#pragma unroll
                    for (int n = 0; n < 2; ++n) { const f32x4 xv = *(const f32x4*)(X + off + bj * HALF + n * 16);
                        *(f32x4*)(O + off + bj * HALF + n * 16) = xv + gv[bj][n] * acc[ai][bj][m][n]; } }
    }
};
struct EpiOut {
    float* O; const float* X; const float* gate; float scale;
    __device__ __forceinline__ void operator()(const f32x4 (&acc)[2][2][4][2], const Unit& u, int wr, int wc, int fr, int fq) const {
        const int row0 = u.pm * BM + wr * 64 + fr, col0 = u.pn * BM + wc * 32 + 4 * fq;
        f32x4 gv[2][2];
        if (X) { const float* gp = gate + (size_t)(u.pm >> 3) * (NADA * DM) + col0;
#pragma unroll
            for (int bj = 0; bj < 2; ++bj)
#pragma unroll
                for (int n = 0; n < 2; ++n) gv[bj][n] = *(const f32x4*)(gp + bj * HALF + n * 16) * scale; }
        else {
#pragma unroll
            for (int bj = 0; bj < 2; ++bj)
#pragma unroll
                for (int n = 0; n < 2; ++n) gv[bj][n] = (f32x4){scale, scale, scale, scale}; }
#pragma unroll
        for (int ai = 0; ai < 2; ++ai)
#pragma unroll
            for (int m = 0; m < 4; ++m) { const size_t off = (size_t)(row0 + ai * HALF + m * 16) * DM + col0;
#pragma unroll
                for (int bj = 0; bj < 2; ++bj)
#pragma unroll
                    for (int n = 0; n < 2; ++n) { f32x4 o = gv[bj][n] * acc[ai][bj][m][n]; if (X) o += *(const f32x4*)(X + off + bj * HALF + n * 16);
                        *(f32x4*)(O + off + bj * HALF + n * 16) = o; } }
    }
};
struct EpiF32 {
    float* O; int ldc; float scale;
    __device__ __forceinline__ void operator()(const f32x4 (&acc)[2][2][4][2], const Unit& u, int wr, int wc, int fr, int fq) const {
        const int row0 = u.pm * BM + wr * 64 + fr, col0 = u.pn * BM + wc * 32 + 4 * fq;
#pragma unroll
        for (int ai = 0; ai < 2; ++ai)
#pragma unroll
            for (int m = 0; m < 4; ++m) { float* rowp = O + (size_t)(row0 + ai * HALF + m * 16) * ldc + col0;
#pragma unroll
                for (int bj = 0; bj < 2; ++bj)
#pragma unroll
                    for (int n = 0; n < 2; ++n) *(f32x4*)(rowp + bj * HALF + n * 16) = acc[ai][bj][m][n] * scale; }
    }
};
struct EpiF32Narrow {
    float* O; int ldc; float scale;
    __device__ __forceinline__ void operator()(const f32x4 (&acc)[2][2][4][2], const Unit& u, int wr, int wc, int fr, int fq) const {
        const int row0 = u.pm * BM + wr * 64 + fr, col0 = u.pn * BM + 64 * u.q + wc * 16 + 4 * fq;
#pragma unroll
        for (int ai = 0; ai < 2; ++ai)
#pragma unroll
            for (int m = 0; m < 4; ++m) *(f32x4*)(O + (size_t)(row0 + ai * HALF + m * 16) * ldc + col0) = acc[ai][0][m][0] * scale;
    }
};
}

struct Args { const float* in[38]; float* out; unsigned char* ws; unsigned long long hoff, hbytes; int ph_lo, ph_hi, li, pad; };
enum { I_X = 0, I_C, I_ADAW, I_ADAB, I_NMIXG, I_NFFNG, I_WIN, I_S5ARE, I_S5AIM, I_S5LOGDT, I_S5BRE, I_S5BIM, I_S5CRE, I_S5CIM, I_S5D, I_S5WGLU, I_S5BGLU, I_S5NG,
       I_LCONVW, I_LCONVB, I_LWA, I_LBA, I_LWX, I_LBX, I_LLAM, I_LNG, I_GWG2, I_GBG2, I_GHG, I_WOUT, I_F1, I_F3, I_F2, I_ROUTER, I_M1, I_M3, I_M2, I_FNG };

#define GAS __attribute__((address_space(1)))
template <class T> DI T* as_global(T* p) { return (T*)(GAS T*)p; }
DI const float* INP(const Args& a, int i) { asm volatile("" : "+s"(i)); return as_global(a.in[i]); }
struct Frame {
    LAS unsigned char* lds;
    volatile LAS unsigned* MISC;
    unsigned* ctl;
    GAS unsigned char* ws;
    int tid, lane, wave, G, bid;
};

DI void conv_item(const float* src0, const float* src1, int ldsrc, int K, bf16* dst, int kb, int pb, int mode, LAS float* scr, int lane) {
    const int p = pb * 64 + lane, g = p >> 5, rho = p & 31, n = rho >> 4, i = rho & 15;
    const float* sp = src0; bool valid = true;
    if (mode == 0) sp = src0 + p;
    else if (mode == 1) { const int lc = (g << 5) + pg8::perm32(rho); const int sc = lc < 3584 ? lc : (lc < 4352 ? lc + 16 : (lc < 4368 ? lc - 4352 + 3584 : -1)); valid = sc >= 0; sp = src0 + (valid ? sc : 0); }
    else if (mode == 2) sp = (n ? src1 : src0) + 16 * g + i;
    else sp = src0 + n * 512 + 16 * g + i;
    const int k0 = kb * 64;
    sp += (size_t)k0 * ldsrc;
#pragma unroll 16
    for (int kk = 0; kk < 64; ++kk) { const float v = valid ? sp[(size_t)kk * ldsrc] : 0.f; scr[kk * 65 + lane] = v; }
    LDS_WAIT();
    const int c = lane & 7;
#pragma unroll
    for (int j = 0; j < 8; ++j) { const int rr = (lane >> 3) + 8 * j; const LAS float* s = scr + (8 * c) * 65 + rr;
        u32x4 o; o.x = pk_bf16(s[0 * 65], s[1 * 65]); o.y = pk_bf16(s[2 * 65], s[3 * 65]); o.z = pk_bf16(s[4 * 65], s[5 * 65]); o.w = pk_bf16(s[6 * 65], s[7 * 65]);
        *(u32x4*)(dst + (size_t)(pb * 64 + rr) * K + k0 + 8 * c) = o; }
    LDS_WAIT();
}

template <bool GATED>
DI void conv_item8(const float* src0, const float* src1, int ldsrc, int K8, unsigned char* dst, int kb, int cb, float scale, LAS unsigned* scr, int lane) {
    constexpr int NC = GATED ? 128 : 64, ST = NC + 1;
    const int k0 = kb * 128;
    const float* p0 = src0 + (size_t)k0 * ldsrc + 64 * cb + lane;
    const float* p1 = GATED ? src1 + (size_t)k0 * ldsrc + 64 * cb + lane : src0;
#pragma unroll 4
    for (int kq = 0; kq < 32; ++kq) {
        const float* r0 = p0 + (size_t)(4 * kq) * ldsrc;
        scr[kq * ST + lane] = pg8::pk4_fp8(r0[0] * scale, r0[ldsrc] * scale, r0[2 * (size_t)ldsrc] * scale, r0[3 * (size_t)ldsrc] * scale);
        if (GATED) { const float* r1 = p1 + (size_t)(4 * kq) * ldsrc;
            scr[kq * ST + 64 + lane] = pg8::pk4_fp8(r1[0] * scale, r1[ldsrc] * scale, r1[2 * (size_t)ldsrc] * scale, r1[3 * (size_t)ldsrc] * scale); }
    }
    LDS_WAIT();
    const int c = lane & 7;
#pragma unroll
    for (int j = 0; j < NC / 8; ++j) { const int rr = (lane >> 3) + 8 * j;
        const int col = GATED ? (((rr >> 4) & 1) * 64 + (rr >> 5) * 16 + (rr & 15)) : rr;
        const LAS unsigned* q = scr + (4 * c) * ST + col;
        u32x4 o; o.x = q[0]; o.y = q[ST]; o.z = q[2 * ST]; o.w = q[3 * ST];
        *(u32x4*)(dst + (size_t)(NC * cb + rr) * K8 + k0 + 16 * c) = o; }
    LDS_WAIT();
}

DI void sincos_d(double x, double& s, double& c) {
    const double k = rint(x * 0.63661977236758134308);
    const double r = fma(-k, 6.123233995736766e-17, fma(-k, 1.5707963267948966, x));
    const double r2 = r * r;
    double sp = -1.0 / 1307674368000.0;
    sp = fma(sp, r2, 1.0 / 6227020800.0); sp = fma(sp, r2, -1.0 / 39916800.0); sp = fma(sp, r2, 1.0 / 362880.0); sp = fma(sp, r2, -1.0 / 5040.0); sp = fma(sp, r2, 1.0 / 120.0); sp = fma(sp, r2, -1.0 / 6.0); sp = fma(sp, r2, 1.0);
    const double sr = sp * r;
    double cp = 1.0 / 20922789888000.0;
    cp = fma(cp, r2, -1.0 / 87178291200.0); cp = fma(cp, r2, 1.0 / 479001600.0); cp = fma(cp, r2, -1.0 / 3628800.0); cp = fma(cp, r2, 1.0 / 40320.0); cp = fma(cp, r2, -1.0 / 720.0); cp = fma(cp, r2, 1.0 / 24.0); cp = fma(cp, r2, -0.5); cp = fma(cp, r2, 1.0);
    const int q = ((int)k) & 3;
    s = (q == 0) ? sr : (q == 1) ? cp : (q == 2) ? -sr : -cp;
    c = (q == 0) ? cp : (q == 1) ? -sr : (q == 2) ? -cp : sr;
}

DI void p0_s5_consts(const Frame& F, const Args& a) {
    const int gt = F.bid * NTHREADS + F.tid;
    if (gt >= DEPTH * 32 * 64) return;
    const int l = gt >> 11, g = (gt >> 6) & 31, p = gt & 63;
    unsigned char* base = (unsigned char*)(F.ws + WS_S5C + (size_t)l * S5C_STRIDE);
    const double ar = INP(a, I_S5ARE)[(l * 32 + g) * 64 + p], ai = INP(a, I_S5AIM)[(l * 32 + g) * 64 + p];
    const double dt = exp((double)INP(a, I_S5LOGDT)[l * 32 + g]);
    const double mag = exp(ar * dt); double sn, cs; sincos_d(ai * dt, sn, cs);
    const double abr = mag * cs, abi = mag * sn;
    const double nr = abr - 1.0, ni = abi, den = ar * ar + ai * ai;
    const double fre = (nr * ar + ni * ai) / den, fim = (ni * ar - nr * ai) / den;
    float* abar = (float*)(base + S5C_ABAR); abar[(g * 64 + p) * 2] = (float)abr; abar[(g * 64 + p) * 2 + 1] = (float)abi;
    double pr = abr, pi = abi;
#pragma unroll
    for (int s = 0; s < 6; ++s) { const double tr = pr * pr - pi * pi, ti = 2.0 * pr * pi; pr = tr; pi = ti; }
    float* abarL = (float*)(base + S5C_ABARL); abarL[(g * 64 + p) * 2] = (float)pr; abarL[(g * 64 + p) * 2 + 1] = (float)pi;
    bf16* bbar = (bf16*)(base + S5C_BBAR);
    const float* bre = INP(a, I_S5BRE) + ((size_t)(l * 32 + g) * 64 + p) * 16; const float* bim = INP(a, I_S5BIM) + ((size_t)(l * 32 + g) * 64 + p) * 16;
#pragma unroll
    for (int c = 0; c < 16; ++c) { const double br = bre[c], bi = bim[c];
        bbar[((size_t)g * 128 + p) * 16 + c] = f2bf((float)(fre * br - fim * bi));
        bbar[((size_t)g * 128 + 64 + p) * 16 + c] = f2bf((float)(fre * bi + fim * br)); }
    bf16* cmat = (bf16*)(base + S5C_CMAT);
    const float* cre = INP(a, I_S5CRE) + (size_t)(l * 32 + g) * 16 * 64; const float* cim = INP(a, I_S5CIM) + (size_t)(l * 32 + g) * 16 * 64;
#pragma unroll
    for (int c = 0; c < 16; ++c) { cmat[((size_t)g * 16 + c) * 128 + p] = f2bf(cre[c * 64 + p]); cmat[((size_t)g * 16 + c) * 128 + 64 + p] = f2bf(-cim[c * 64 + p]); }
}
DI void p0_lru_w(const Frame& F, const Args& a) {
    const int total = DEPTH * 2 * 8 * 96 * 96;
    const float* pwa = INP(a, I_LWA); const float* pwx = INP(a, I_LWX);
    for (int idx = F.bid * NTHREADS + F.tid; idx < total; idx += F.G * NTHREADS) {
        int r = idx; const int i = r % 96; r /= 96; const int j = r % 96; r /= 96; const int h = r % 8; r /= 8; const int which = r & 1, l = r >> 1;
        const float* src = (which ? pwx : pwa) + (((size_t)l * 8 + h) * 96 + i) * 96 + j;
        bf16* dst = (bf16*)(F.ws + WS_LRUW + (size_t)l * LRUW_STRIDE + (which ? LRUW_X : 0));
        dst[((size_t)h * 96 + j) * 96 + i] = f2bf(*src);
    }
}
DI void p0_ada(const Frame& F, const Args& a) {
    LAS float* red = (LAS float*)F.lds;
    const int cq = F.lane & 15, kr = F.lane >> 4;
    for (int task = F.bid; task < DEPTH * 192; task += F.G) {
        const int l = task / 192, cg = task % 192;
        const float* W = INP(a, I_ADAW) + (size_t)l * DM * (NADA * DM) + 64 * cg + 4 * cq;
        const float* cin = INP(a, I_C);
        f32x4 acc[4];
#pragma unroll
        for (int b = 0; b < 4; ++b) acc[b] = (f32x4){0.f, 0.f, 0.f, 0.f};
#pragma unroll 4
        for (int it = 0; it < 64; ++it) { const int k = 256 * F.wave + 4 * it + kr;
            const f32x4 wv = *(const f32x4*)(W + (size_t)k * (NADA * DM));
#pragma unroll
            for (int b = 0; b < 4; ++b) { const float cs = siluf_(cin[b * DM + k]); acc[b] += cs * wv; } }
#pragma unroll
        for (int b = 0; b < 4; ++b)
#pragma unroll
            for (int e = 0; e < 4; ++e) acc[b][e] = xor_add<16>(acc[b][e]);
        if ((kr & 1) == 0) {
#pragma unroll
            for (int b = 0; b < 4; ++b) *(LAS f32x4*)(red + ((F.wave * 2 + (kr >> 1)) * 4 + b) * 64 + 4 * cq) = acc[b]; }
        __syncthreads();
        if (F.tid < 256) { const int b = F.tid >> 6, col = F.tid & 63; float s = INP(a, I_ADAB)[(size_t)l * (NADA * DM) + 64 * cg + col];
#pragma unroll
            for (int w = 0; w < 16; ++w) s += red[(w * 4 + b) * 64 + col];
            ((float*)(F.ws + WS_MOD))[((size_t)l * 4 + b) * (NADA * DM) + 64 * cg + col] = s; }
        __syncthreads();
    }
}
DI void p0_convert(const Frame& F, const Args& a) {
    LAS float* scr = (LAS float*)(F.lds + F.wave * 16896);
    const int gw = F.bid * NWAVES + F.wave, NGW = F.G * NWAVES;
    constexpr int I_WIN_ = 32 * 72, I_WOUT_ = 32 * 32, I_GLU_ = 8 * 16, I_F13_ = 32 * 176, I_F2_ = 44 * 32, I_M13_ = 16 * 112, I_M2_ = 56 * 32;
    constexpr int TOTAL = 2 * I_WIN_ + 2 * I_WOUT_ + 2 * I_GLU_ + I_F13_ + I_F2_ + 8 * I_M13_ + 8 * I_M2_;
    for (int it = gw; it < TOTAL; it += NGW) {
        int r = it;
        if (r < 2 * I_WIN_) { const int l = r / I_WIN_; r %= I_WIN_; conv_item(INP(a, I_WIN) + (size_t)l * DM * DIN_SRC, nullptr, DIN_SRC, DM, (bf16*)(F.ws + WS_WIN) + (size_t)l * PROJ_LD * DM, r / 72, r % 72, 1, scr, F.lane); continue; } r -= 2 * I_WIN_;
        if (r < 2 * I_WOUT_) { const int l = r / I_WOUT_; r %= I_WOUT_; conv_item(INP(a, I_WOUT) + (size_t)l * DM * DM, nullptr, DM, DM, (bf16*)(F.ws + WS_WOUT) + (size_t)l * DM * DM, r / 32, r % 32, 0, scr, F.lane); continue; } r -= 2 * I_WOUT_;
        if (r < 2 * I_GLU_) { const int l = r / I_GLU_; r %= I_GLU_; conv_item(INP(a, I_S5WGLU) + (size_t)l * 512 * 1024, nullptr, 1024, 512, (bf16*)(F.ws + WS_WGLU) + (size_t)l * 1024 * 512, r / 16, r % 16, 3, scr, F.lane); continue; } r -= 2 * I_GLU_;
        if (r < I_F13_) { conv_item(INP(a, I_F1), INP(a, I_F3), DFF, DM, (bf16*)(F.ws + WS_F13), r / 176, r % 176, 2, scr, F.lane); continue; } r -= I_F13_;
        if (r < I_F2_) { conv_item8<false>(INP(a, I_F2), nullptr, DM, DFF, (unsigned char*)(F.ws + WS_F2), r / 32, r % 32, SC_W2, (LAS unsigned*)scr, F.lane); continue; } r -= I_F2_;
        if (r < 8 * I_M13_) { const int e = r / I_M13_; r %= I_M13_; conv_item8<true>(INP(a, I_M1) + (size_t)e * DM * DFFE, INP(a, I_M3) + (size_t)e * DM * DFFE, DFFE, DM, (unsigned char*)(F.ws + WS_M13 + (size_t)e * 2 * DFFE * DM), 8 * ((r >> 3) / 112) + (r & 7), (r >> 3) % 112, SC_W13, (LAS unsigned*)scr, F.lane);     continue; } r -= 8 * I_M13_;
        { const int e = r / I_M2_; r %= I_M2_; conv_item8<false>(INP(a, I_M2) + (size_t)e * DFFE * DM, nullptr, DM, DFFE, (unsigned char*)(F.ws + WS_M2 + (size_t)e * DM * DFFE), 8 * ((r >> 3) / 32) + (r & 7), (r >> 3) % 32, SC_W2, (LAS unsigned*)scr, F.lane); }
    }
}

template <bool ROUTER, bool OUT8>
DI void norm_phase(const Frame& F, const Args& a, const float* xin, const float* g, const float* mod  , int shift_idx, int scale_idx, const float* wrouter) {
    bf16* H = (bf16*)(F.ws + WS_H);
    LAS float* wr = (LAS float*)F.lds;
    volatile LAS unsigned* bcnt = F.MISC + 32;
    LAS unsigned* rows = (LAS unsigned*)(F.lds + 65536);
    if (ROUTER) {
        for (int i0 = F.tid; i0 < DM * NE; i0 += 8 * NTHREADS) { float w8[8];
#pragma unroll
            for (int q = 0; q < 8; ++q) w8[q] = wrouter[i0 + NTHREADS * q];
#pragma unroll
            for (int q = 0; q < 8; ++q) { const int i = i0 + NTHREADS * q, d = i >> 3, e = i & 7; wr[e * DM + d] = w8[q]; } }
        if (F.tid < 8) bcnt[F.tid] = 0u;
        __syncthreads();
    }
    const int gw = F.bid * NWAVES + F.wave;
    int rslot = 0;
    f32x4 vnx[8];
    if (gw < T) {
#pragma unroll
        for (int j = 0; j < 8; ++j) vnx[j] = ((const f32x4*)(xin + (size_t)gw * DM) + F.lane)[64 * j]; }
    for (int row = gw; row < T; row += F.G * NWAVES, ++rslot) {
        const int b = row >> 11;
        f32x4 v[8]; float ss = 0.f;
#pragma unroll
        for (int j = 0; j < 8; ++j) v[j] = vnx[j];
        { const int rown = row + F.G * NWAVES < T ? row + F.G * NWAVES : row;
          const f32x4* xn = (const f32x4*)(xin + (size_t)rown * DM) + F.lane;
#pragma unroll
          for (int j = 0; j < 8; ++j) vnx[j] = xn[64 * j]; }
#pragma unroll
        for (int j = 0; j < 8; ++j) ss += (v[j][0] * v[j][0] + v[j][1] * v[j][1]) + (v[j][2] * v[j][2] + v[j][3] * v[j][3]);
        const float rstd = rsqrtf(wave_sum(ss) * (1.f / DM) + EPS);
        const f32x4* gp = (const f32x4*)g + F.lane; const f32x4* sc = (const f32x4*)(mod + (size_t)b * (NADA * DM) + scale_idx * DM) + F.lane; const f32x4* sh = (const f32x4*)(mod + (size_t)b * (NADA * DM) + shift_idx * DM) + F.lane;
        u32x2* o8 = (u32x2*)(H + (size_t)row * DM) + F.lane;
#pragma unroll
        for (int j = 0; j < 8; ++j) { const f32x4 gg = gp[64 * j], s1 = sc[64 * j], s0 = sh[64 * j];
            v[j] = v[j] * rstd * gg * (1.f + s1) + s0;
            if (OUT8) ((unsigned*)((unsigned char*)H + (size_t)row * DM))[F.lane + 64 * j] = pg8::pk4_fp8(v[j][0] * SC_X, v[j][1] * SC_X, v[j][2] * SC_X, v[j][3] * SC_X);
            else { u32x2 w; w.x = pk_bf16(v[j][0], v[j][1]); w.y = pk_bf16(v[j][2], v[j][3]); o8[64 * j] = w; } }
        if (ROUTER) {
            float lg[8];
#pragma unroll
            for (int e = 0; e < 8; ++e) { float s = 0.f;
#pragma unroll
                for (int j = 0; j < 8; ++j) { const f32x4 w4 = *(const LAS f32x4*)(wr + e * DM + 256 * j + 4 * F.lane); s += (v[j][0] * w4[0] + v[j][1] * w4[1]) + (v[j][2] * w4[2] + v[j][3] * w4[3]); }
                lg[e] = wave_sum(s); }
            if (F.lane == 0) {
                int e0 = 0; float v0 = lg[0];
#pragma unroll
                for (int e = 1; e < 8; ++e) if (lg[e] > v0) { v0 = lg[e]; e0 = e; }
                int e1 = -1; float v1 = -3.4e38f;
#pragma unroll
                for (int e = 0; e < 8; ++e) if (e != e0 && lg[e] > v1) { v1 = lg[e]; e1 = e; }
                const float ex = __expf(v1 - v0), g0 = 1.f / (1.f + ex), g1 = ex / (1.f + ex);
                const unsigned p0 = 0u, p1 = 0u;
                LAS unsigned* rec = rows + (F.wave * 4 + rslot) * 8;
                rec[0] = (unsigned)e0; rec[1] = (unsigned)e1; rec[2] = p0; rec[3] = p1; rec[4] = __builtin_bit_cast(unsigned, g0); rec[5] = __builtin_bit_cast(unsigned, g1);
            }
        }
    }
    if (ROUTER) {
        __syncthreads();
        if (F.tid == 0) {
            for (int r = 0; r < 32; ++r) { LAS unsigned* rec = rows + r * 8; const unsigned e0 = rec[0], e1 = rec[1];
                const unsigned q0 = bcnt[e0]; bcnt[e0] = q0 + 1u; const unsigned q1 = bcnt[e1]; bcnt[e1] = q1 + 1u; rec[2] = q0; rec[3] = q1; }
            unsigned* cb = (unsigned*)(F.ws + WS_CNTBLK) + (size_t)F.bid * 32;
            for (int e = 0; e < 8; ++e) cb[e] = bcnt[e];
        }
        __syncthreads();
        if (F.tid < 32) { LAS unsigned* rec = rows + F.tid * 8; const int w = F.tid >> 2, rs = F.tid & 3; const int row = F.bid * NWAVES + w + rs * F.G * NWAVES;
            if (row < T) { unsigned* out = (unsigned*)(F.ws + WS_ROUTE) + (size_t)row * 8;
                out[0] = rec[0]; out[1] = rec[1]; out[2] = rec[2]; out[3] = rec[3]; out[4] = rec[4]; out[5] = rec[5]; } }
        __syncthreads();
    }
}
DI void s5norm_phase(const Frame& F, const float* g) {
    const float* P = (const float*)(F.ws + WS_S5PRE); bf16* MIX = (bf16*)(F.ws + WS_MIX);
    for (int row = F.bid * NWAVES + F.wave; row < T; row += F.G * NWAVES) {
        const f32x4* xr = (const f32x4*)(P + (size_t)row * 512) + F.lane;
        f32x4 v[2]; float ss = 0.f;
#pragma unroll
        for (int j = 0; j < 2; ++j) { v[j] = xr[64 * j]; ss += (v[j][0] * v[j][0] + v[j][1] * v[j][1]) + (v[j][2] * v[j][2] + v[j][3] * v[j][3]); }
        const float rstd = rsqrtf(wave_sum(ss) * (1.f / 512.f) + EPS);
        u32x2* o8 = (u32x2*)(MIX + (size_t)row * DM) + F.lane;
#pragma unroll
        for (int j = 0; j < 2; ++j) { const f32x4 gg = ((const f32x4*)g)[F.lane + 64 * j]; v[j] = v[j] * rstd * gg;
            u32x2 w; w.x = pk_bf16(v[j][0], v[j][1]); w.y = pk_bf16(v[j][2], v[j][3]); o8[64 * j] = w; }
    }
}
DI void moe_tiles(const Frame& F) {
    LAS unsigned* tbl = (LAS unsigned*)F.lds;
    const unsigned* cb = (const unsigned*)(F.ws + WS_CNTBLK);
    __syncthreads();
    for (int i = F.tid; i < F.G * 8; i += NTHREADS) tbl[i] = cb[(i >> 3) * 32 + (i & 7)];
    __syncthreads();
    if (F.tid < 8) { unsigned tot = 0, base = 0;
        for (int b = 0; b < F.G; ++b) { if (b == F.bid) base = tot; tot += tbl[b * 8 + F.tid]; }
        F.MISC[32 + F.tid] = tot; F.MISC[40 + F.tid] = base; }
    __syncthreads();
    if (F.tid == 0) { unsigned s = 0;
        for (int e = 0; e < 8; ++e) { F.MISC[16 + e] = s; s += (F.MISC[32 + e] + 255u) >> 8; }
        F.MISC[24] = s; }
    __syncthreads();
}
DI void dense_tiles(const Frame& F) {
    __syncthreads();
    if (F.tid == 0) { F.MISC[16] = 0u; for (int e = 1; e <= 8; ++e) F.MISC[16 + e] = (unsigned)(T / 256); }
    __syncthreads();
}
DI void moe_sort_phase(const Frame& F) {
    moe_tiles(F);
    const bf16* H = (const bf16*)(F.ws + WS_H); bf16* AS = (bf16*)(F.ws + WS_AS);
    for (int row = F.bid * NWAVES + F.wave; row < T; row += F.G * NWAVES) {
        unsigned* rt = (unsigned*)(F.ws + WS_ROUTE) + (size_t)row * 8;
        const unsigned e0 = rt[0], e1 = rt[1], q0 = rt[2], q1 = rt[3];
        const unsigned p0 = F.MISC[16 + e0] * 256u + F.MISC[40 + e0] + q0, p1 = F.MISC[16 + e1] * 256u + F.MISC[40 + e1] + q1;
        const u32x4* src = (const u32x4*)((const unsigned char*)H + (size_t)row * DM) + F.lane;
        u32x4* d0 = (u32x4*)((unsigned char*)AS + (size_t)p0 * DM) + F.lane; u32x4* d1 = (u32x4*)((unsigned char*)AS + (size_t)p1 * DM) + F.lane;
#pragma unroll
        for (int j = 0; j < 2; ++j) { const u32x4 v = src[64 * j]; d0[64 * j] = v; d1[64 * j] = v; }
        if (F.lane == 0) { rt[6] = p0; rt[7] = p1; }
    }
}
DI void final_phase(const Frame& F, const Args& a, const float* mod) {
    const float* X1 = (const float*)(F.ws + WS_X1); const float* Y = (const float*)(F.ws + WS_Y);
    const f32x4* fng = (const f32x4*)INP(a, I_FNG);
    for (int row = F.bid * NWAVES + F.wave; row < T; row += F.G * NWAVES) {
        const int b = row >> 11;
        const unsigned* rt = (const unsigned*)(F.ws + WS_ROUTE) + (size_t)row * 8;
        const float g0 = __builtin_bit_cast(float, rt[4]), g1 = __builtin_bit_cast(float, rt[5]); const unsigned p0 = rt[6], p1 = rt[7];
        const f32x4* xr = (const f32x4*)(X1 + (size_t)row * DM) + F.lane; const f32x4* y0 = (const f32x4*)(Y + (size_t)p0 * DM) + F.lane; const f32x4* y1 = (const f32x4*)(Y + (size_t)p1 * DM) + F.lane;
        const f32x4* gt = (const f32x4*)(mod + (size_t)b * (NADA * DM) + 5 * DM) + F.lane;
        f32x4 v[8]; float ss = 0.f;
#pragma unroll
        for (int j = 0; j < 8; ++j) {
#if defined(DBG_ROUTE_ONLY)
            v[j] = xr[64 * j] + gt[64 * j] * (g0 * (float)(p0 % 97u) * 0.01f + g1 * (float)(p1 % 89u) * 0.01f + (float)rt[0] * 0.1f - (float)rt[1] * 0.05f);
#elif defined(DBG_SKIP_MOE)
            v[j] = xr[64 * j];
#else
            v[j] = xr[64 * j] + gt[64 * j] * (g0 * y0[64 * j] + g1 * y1[64 * j]);
#endif
            ss += (v[j][0] * v[j][0] + v[j][1] * v[j][1]) + (v[j][2] * v[j][2] + v[j][3] * v[j][3]); }
        const float rstd = rsqrtf(wave_sum(ss) * (1.f / DM) + EPS);
        f32x4* o = (f32x4*)(as_global(a.out) + (size_t)row * DM) + F.lane;
#pragma unroll
        for (int j = 0; j < 8; ++j) o[64 * j] = DBG_OUTSCALE * v[j] * rstd * fng[F.lane + 64 * j];
    }
}

template <bool FULL>
DI void s5_task(const Frame& F, const Args& a, int l, int task, LAS unsigned char* wl) {
    const int lane = F.lane, fr = lane & 15, fq = lane >> 4;
    const int b = task >> 10, g = (task >> 5) & 31, j = task & 31;
    const unsigned char* cb = (const unsigned char*)(F.ws + WS_S5C + (size_t)l * S5C_STRIDE);
    const f32x2 ab = ((const f32x2*)(cb + S5C_ABAR))[g * 64 + lane];
    const bf16* bbar = (const bf16*)(cb + S5C_BBAR) + (size_t)g * 128 * 16;
    const bf16* PJ = (const bf16*)(F.ws + WS_PROJ);
    volatile LAS float* BU = (volatile LAS float*)wl;
    bf16x8 Bf[8];
    const bf16x8 zero8 = (bf16x8){0, 0, 0, 0, 0, 0, 0, 0};
#pragma unroll
    for (int nb = 0; nb < 8; ++nb) Bf[nb] = (fq < 2) ? *(const bf16x8*)(bbar + (16 * nb + fr) * 16 + 8 * fq) : zero8;
    bf16x8 Cf[4]; float dv = 0.f;
    float hr = 0.f, hi = 0.f;
    float* E = (float*)(F.ws + WS_S5E) + (size_t)((b * 32 + g) * 32) * 128;
    if (FULL) {
        const bf16* cmat = (const bf16*)(cb + S5C_CMAT) + (size_t)g * 16 * 128;
#pragma unroll
        for (int ks = 0; ks < 4; ++ks) Cf[ks] = *(const bf16x8*)(cmat + fr * 128 + 32 * ks + 8 * fq);
        dv = INP(a, I_S5D)[l * 512 + g * 16 + fr];
        const f32x2 aL = ((const f32x2*)(cb + S5C_ABARL))[g * 64 + lane];
        int i = 0;
        for (; i + 8 <= j; i += 8) { float er[8], ei[8];
#pragma unroll
            for (int q = 0; q < 8; ++q) { er[q] = E[(i + q) * 128 + lane]; ei[q] = E[(i + q) * 128 + 64 + lane]; }
#pragma unroll
            for (int q = 0; q < 8; ++q) { const float nr = fmaf(aL[0], hr, fmaf(-aL[1], hi, er[q])), ni = fmaf(aL[0], hi, fmaf(aL[1], hr, ei[q])); hr = nr; hi = ni; } }
        for (; i < j; ++i) { const float er = E[i * 128 + lane], ei = E[i * 128 + 64 + lane];
            const float nr = fmaf(aL[0], hr, fmaf(-aL[1], hi, er)), ni = fmaf(aL[0], hi, fmaf(aL[1], hr, ei)); hr = nr; hi = ni; }
    }
    const size_t row0 = (size_t)b * SEQ + 64 * j;
    bf16x8 Afs[4];
#pragma unroll
    for (int sub = 0; sub < 4; ++sub) Afs[sub] = (fq < 2) ? *(const bf16x8*)(PJ + (row0 + 16 * sub + fr) * PROJ_LD + C_U + g * 16 + 8 * fq) : zero8;
#pragma unroll
    for (int sub = 0; sub < 4; ++sub) {
        const size_t r0 = row0 + 16 * sub;
        const bf16x8 Af = Afs[sub];
        f32x4 dd[8];
#pragma unroll
        for (int nb = 0; nb < 8; ++nb) dd[nb] = __builtin_amdgcn_mfma_f32_16x16x32_bf16(Af, Bf[nb], (f32x4){0.f, 0.f, 0.f, 0.f}, 0, 0, 0);
        asm volatile("s_nop 15\n\ts_nop 15" : "+v"(dd[0]), "+v"(dd[1]), "+v"(dd[2]), "+v"(dd[3]), "+v"(dd[4]), "+v"(dd[5]), "+v"(dd[6]), "+v"(dd[7]));
#pragma unroll
        for (int nb = 0; nb < 8; ++nb) {
#pragma unroll
            for (int jj = 0; jj < 4; ++jj) BU[(4 * fq + jj) * 132 + 16 * nb + fr] = dd[nb][jj]; }
        LDS_WAIT();
        volatile LAS bf16* HT = (volatile LAS bf16*)(wl + 8448);
        bf16 uu[4];
        if (FULL) {
#pragma unroll
            for (int jj = 0; jj < 4; ++jj) uu[jj] = PJ[(r0 + 4 * fq + jj) * PROJ_LD + C_U + g * 16 + fr]; }
#pragma unroll
        for (int t = 0; t < 16; ++t) { const float br = BU[t * 132 + lane], bi = BU[t * 132 + 64 + lane];
            const float nr = fmaf(ab[0], hr, fmaf(-ab[1], hi, br)), ni = fmaf(ab[0], hi, fmaf(ab[1], hr, bi)); hr = nr; hi = ni;
            if (FULL) { HT[t * 136 + lane] = f2bf_sw(nr); HT[t * 136 + 64 + lane] = f2bf_sw(ni); } }
        LDS_WAIT();
        if (FULL) {
            bf16x8 hf[4];
#pragma unroll
            for (int ks = 0; ks < 4; ++ks) hf[ks] = *(const LAS bf16x8*)((const LAS bf16*)(wl + 8448) + fr * 136 + 32 * ks + 8 * fq);
            asm volatile("s_waitcnt vmcnt(0) lgkmcnt(0)\n\ts_nop 7" : "+v"(hf[0]), "+v"(hf[1]), "+v"(hf[2]), "+v"(hf[3]));
            f32x4 y = (f32x4){0.f, 0.f, 0.f, 0.f};
#pragma unroll
            for (int ks = 0; ks < 4; ++ks) y = __builtin_amdgcn_mfma_f32_16x16x32_bf16(hf[ks], Cf[ks], y, 0, 0, 0);
            asm volatile("s_nop 15\n\ts_nop 15" : "+v"(y));
            bf16* Z = (bf16*)(F.ws + WS_Z);
#pragma unroll
            for (int jj = 0; jj < 4; ++jj) { const size_t r = r0 + 4 * fq + jj; Z[r * 512 + g * 16 + fr] = f2bf(gelu_tanh(y[jj] + dv * bf2f(uu[jj]))); }
        }
    }
    if (!FULL) { E[j * 128 + lane] = hr; E[j * 128 + 64 + lane] = hi; }
}

DI void lru_gate_task(const Frame& F, const Args& a, int l, int task) {
    const int lane = F.lane, fr = lane & 15, fq = lane >> 4;
    const int b = task >> 9, j = (task >> 3) & 63, hd = task & 7;
    const bf16* PJ = (const bf16*)(F.ws + WS_PROJ);
    const float* cw = INP(a, I_LCONVW) + (size_t)l * 4 * 768; const float* cbias = INP(a, I_LCONVB) + (size_t)l * 768;
    const bf16* waT = (const bf16*)(F.ws + WS_LRUW + (size_t)l * LRUW_STRIDE) + (size_t)hd * 96 * 96; const bf16* wxT = (const bf16*)(F.ws + WS_LRUW + (size_t)l * LRUW_STRIDE + LRUW_X) + (size_t)hd * 96 * 96;
    const size_t rbase = (size_t)b * SEQ + 32 * j;
    bf16x8 X[2][3];
#pragma unroll
    for (int ks = 0; ks < 3; ++ks) {
        const int ch = hd * 96 + 32 * ks + 8 * fq;
        f32x4 w0[4], w1[4];
#pragma unroll
        for (int k = 0; k < 4; ++k) { w0[k] = *(const f32x4*)(cw + k * 768 + ch); w1[k] = *(const f32x4*)(cw + k * 768 + ch + 4); }
        const f32x4 c0 = *(const f32x4*)(cbias + ch), c1 = *(const f32x4*)(cbias + ch + 4);
#pragma unroll
        for (int m = 0; m < 2; ++m) {
            const int ts = 32 * j + 16 * m + fr;
            float xc[8];
#pragma unroll
            for (int e = 0; e < 4; ++e) { xc[e] = c0[e]; xc[4 + e] = c1[e]; }
            u32x4 xt[4];
#pragma unroll
            for (int k = 0; k < 4; ++k) { const int tt = ts - 3 + k; xt[k] = *(const u32x4*)(PJ + ((size_t)b * SEQ + (tt < 0 ? 0 : tt)) * PROJ_LD + C_XL + ch); }
#pragma unroll
            for (int k = 0; k < 4; ++k) { const int tt = ts - 3 + k; const u32x4 z4 = {0u, 0u, 0u, 0u}; const u32x4 xv = tt < 0 ? z4 : xt[k];
                    xc[0] += w0[k][0] * bflo(xv.x); xc[1] += w0[k][1] * bfhi(xv.x); xc[2] += w0[k][2] * bflo(xv.y); xc[3] += w0[k][3] * bfhi(xv.y);
                    xc[4] += w1[k][0] * bflo(xv.z); xc[5] += w1[k][1] * bfhi(xv.z); xc[6] += w1[k][2] * bflo(xv.w); xc[7] += w1[k][3] * bfhi(xv.w); }
            u32x4 pk; pk.x = pk_bf16(xc[0], xc[1]); pk.y = pk_bf16(xc[2], xc[3]); pk.z = pk_bf16(xc[4], xc[5]); pk.w = pk_bf16(xc[6], xc[7]);
            X[m][ks] = __builtin_bit_cast(bf16x8, pk);
        }
        asm volatile("" ::: "memory");
    }
    float* LA = (float*)(F.ws + WS_LRUA); float* LB = (float*)(F.ws + WS_LRUB);
    const float* pba = INP(a, I_LBA) + l * 768; const float* pbx = INP(a, I_LBX) + l * 768; const float* plam = INP(a, I_LLAM) + l * 768;
    for (int nb = 0; nb < 6; ++nb) {
        bf16x8 WA[3], WX[3];
#pragma unroll
        for (int ks = 0; ks < 3; ++ks) { WA[ks] = *(const bf16x8*)(waT + (16 * nb + fr) * 96 + 32 * ks + 8 * fq); WX[ks] = *(const bf16x8*)(wxT + (16 * nb + fr) * 96 + 32 * ks + 8 * fq); }
        const int ch0 = hd * 96 + 16 * nb + 4 * fq;
        const f32x4 ba = *(const f32x4*)(pba + ch0), bx = *(const f32x4*)(pbx + ch0), lam = *(const f32x4*)(plam + ch0);
        const f32x4 cb4 = *(const f32x4*)(cbias + ch0);
        f32x4 cwk[4]; u32x2 xtap[2][4];
#pragma unroll
        for (int k = 0; k < 4; ++k) { cwk[k] = *(const f32x4*)(cw + k * 768 + ch0);
#pragma unroll
            for (int m = 0; m < 2; ++m) { const int tt = 32 * j + 16 * m + fr - 3 + k; xtap[m][k] = *(const u32x2*)(PJ + ((size_t)b * SEQ + (tt < 0 ? 0 : tt)) * PROJ_LD + C_XL + ch0); } }
        asm volatile("" : "+v"(cwk[0]), "+v"(cwk[1]), "+v"(cwk[2]), "+v"(cwk[3]));
        asm volatile("" : "+v"(xtap[0][0]), "+v"(xtap[0][1]), "+v"(xtap[0][2]), "+v"(xtap[0][3]), "+v"(xtap[1][0]), "+v"(xtap[1][1]), "+v"(xtap[1][2]), "+v"(xtap[1][3]));
        f32x4 ls;
#pragma unroll
        for (int e = 0; e < 4; ++e) ls[e] = 8.f * logsigmoid_fast(lam[e]);
#pragma unroll
        for (int m = 0; m < 2; ++m) {
            f32x4 da = (f32x4){0.f, 0.f, 0.f, 0.f}, dx = (f32x4){0.f, 0.f, 0.f, 0.f};
#pragma unroll
            for (int ks = 0; ks < 3; ++ks) { da = __builtin_amdgcn_mfma_f32_16x16x32_bf16(WA[ks], X[m][ks], da, 0, 0, 0); dx = __builtin_amdgcn_mfma_f32_16x16x32_bf16(WX[ks], X[m][ks], dx, 0, 0, 0); }
            asm volatile("s_nop 15\n\ts_nop 15" : "+v"(da), "+v"(dx));
            const int ts = 32 * j + 16 * m + fr;
            f32x4 xc = cb4;
#pragma unroll
            for (int k = 0; k < 4; ++k) { const int tt = ts - 3 + k;
                u32x2 xv = xtap[m][k]; const f32x4 w = cwk[k];
                if (tt < 0) { xv.x = 0u; xv.y = 0u; }
                    xc[0] += w[0] * bflo(xv.x); xc[1] += w[1] * bfhi(xv.x); xc[2] += w[2] * bflo(xv.y); xc[3] += w[3] * bfhi(xv.y); }
            f32x4 av, bv;
#pragma unroll
            for (int e = 0; e < 4; ++e) { const float r = sigmoidf_(da[e] + ba[e]), ig = sigmoidf_(dx[e] + bx[e]); const float la = r * ls[e];
                av[e] = __expf(la); bv[e] = sqrtf(fmaxf(1.f - av[e] * av[e], 0.f)) * ig * xc[e]; }
            const size_t o = (rbase + 16 * m + fr) * 768 + ch0;
            *(f32x4*)(LA + o) = av; *(f32x4*)(LB + o) = bv;
        }
    }
}
DI void lru_scan_task(const Frame& F, int task) {
    const int b = task / 384, rem = task % 384, j = rem / 12, cg = rem % 12;
    float* LA = (float*)(F.ws + WS_LRUA) + ((size_t)b * SEQ + 64 * j) * 768 + 64 * cg + F.lane; float* LB = (float*)(F.ws + WS_LRUB) + ((size_t)b * SEQ + 64 * j) * 768 + 64 * cg + F.lane;
    float h = 0.f, cum = 1.f;
    for (int t0 = 0; t0 < 64; t0 += 32) { float av[32], bv[32];
#pragma unroll
        for (int t = 0; t < 32; ++t) { av[t] = LA[(size_t)(t0 + t) * 768]; bv[t] = LB[(size_t)(t0 + t) * 768]; }
#pragma unroll
        for (int t = 0; t < 32; ++t) { h = fmaf(av[t], h, bv[t]); cum *= av[t]; LB[(size_t)(t0 + t) * 768] = h; LA[(size_t)(t0 + t) * 768] = cum; } }
}
DI void lru_out_task(const Frame& F, const Args& a, int l, int task) {
    const int b = task >> 5, j = task & 31;
    const float* LA = (const float*)(F.ws + WS_LRUA) + (size_t)b * SEQ * 768; const float* LB = (const float*)(F.ws + WS_LRUB) + (size_t)b * SEQ * 768;
    LAS float* HS = (LAS float*)F.lds;
    for (int ch = F.tid; ch < 768; ch += NTHREADS) { float H = 0.f;
        int i = 0;
        for (; i + 8 <= j; i += 8) { float ap[8], e[8];
#pragma unroll
            for (int q = 0; q < 8; ++q) { ap[q] = LA[(size_t)(64 * (i + q) + 63) * 768 + ch]; e[q] = LB[(size_t)(64 * (i + q) + 63) * 768 + ch]; }
#pragma unroll
            for (int q = 0; q < 8; ++q) H = fmaf(ap[q], H, e[q]); }
        for (; i < j; ++i) { const float ap = LA[(size_t)(64 * i + 63) * 768 + ch], e = LB[(size_t)(64 * i + 63) * 768 + ch]; H = fmaf(ap, H, e); }
        HS[ch] = H; }
    __syncthreads();
    const bf16* PJ = (const bf16*)(F.ws + WS_PROJ); bf16* MIX = (bf16*)(F.ws + WS_MIX);
    const float* ng = INP(a, I_LNG) + l * 768;
    const f32x4 g4r[3] = {*(const f32x4*)(ng + 4 * F.lane), *(const f32x4*)(ng + 4 * F.lane + 256), *(const f32x4*)(ng + 4 * F.lane + 512)};
    for (int rr0 = F.wave; rr0 < 64; rr0 += 2 * NWAVES) {
      f32x4 hl2[2][3], ca2[2][3]; u32x2 gv2[2][3];
#pragma unroll
      for (int u = 0; u < 2; ++u) { const size_t t = 64 * j + rr0 + NWAVES * u, row = (size_t)b * SEQ + t;
#pragma unroll
          for (int q = 0; q < 3; ++q) { const int ch = 4 * F.lane + 256 * q; hl2[u][q] = *(const f32x4*)(LB + t * 768 + ch); ca2[u][q] = *(const f32x4*)(LA + t * 768 + ch); gv2[u][q] = *(const u32x2*)(PJ + row * PROJ_LD + C_GL + ch); } }
#pragma unroll
      for (int u = 0; u < 2; ++u) {
        const size_t t = 64 * j + rr0 + NWAVES * u, row = (size_t)b * SEQ + t;
        f32x4 v[3]; float ss = 0.f;
#pragma unroll
        for (int q = 0; q < 3; ++q) { const int ch = 4 * F.lane + 256 * q;
            const f32x4 hl = hl2[u][q], ca = ca2[u][q], hs = *(const LAS f32x4*)(HS + ch);
            const u32x2 gv = gv2[u][q];
            const float gg[4] = {bflo(gv.x), bfhi(gv.x), bflo(gv.y), bfhi(gv.y)};
#pragma unroll
            for (int e = 0; e < 4; ++e) { const float h = fmaf(ca[e], hs[e], hl[e]); v[q][e] = h * gelu_tanh(gg[e]); ss += v[q][e] * v[q][e]; } }
        const float rstd = rsqrtf(wave_sum(ss) * (1.f / 768.f) + EPS);
#pragma unroll
        for (int q = 0; q < 3; ++q) { const int ch = 4 * F.lane + 256 * q; const f32x4 o = v[q] * rstd * g4r[q];
            u32x2 w; w.x = pk_bf16(o[0], o[1]); w.y = pk_bf16(o[2], o[3]); *(u32x2*)(MIX + row * DM + 512 + ch) = w; }
      }
    }
    __syncthreads();
}

constexpr int GL_BC = 0, GL_WG = 24832, GL_K = 31488, GL_V = 57600;
constexpr int GB_Q = 31488, GB_K = 57600, GB_V = 83712;
DI void gla_bcum(const Frame& F, const Args& a, int l, int hd, size_t r0, LAS float* bc, LAS float* wg) {
    const bf16* PJ = (const bf16*)(F.ws + WS_PROJ);
    { const float* pg = INP(a, I_GWG2) + (size_t)l * 16 * 384 + hd * 96; float w3[3];
#pragma unroll
      for (int q = 0; q < 3; ++q) { const int i = F.tid + NTHREADS * q; w3[q] = pg[(i / 96) * 384 + i % 96]; }
#pragma unroll
      for (int q = 0; q < 3; ++q) wg[F.tid + NTHREADS * q] = w3[q]; }
    if (F.tid < 96) wg[1536 + F.tid] = INP(a, I_GBG2)[l * 384 + hd * 96 + F.tid];
    __syncthreads();
    { const int t = F.tid >> 3, dg = F.tid & 7;
      const u32x4 g0 = *(const u32x4*)(PJ + (r0 + t) * PROJ_LD + C_GLOW), g1 = *(const u32x4*)(PJ + (r0 + t) * PROJ_LD + C_GLOW + 8);
      const float gl[16] = {bflo(g0.x), bfhi(g0.x), bflo(g0.y), bfhi(g0.y), bflo(g0.z), bfhi(g0.z), bflo(g0.w), bfhi(g0.w), bflo(g1.x), bfhi(g1.x), bflo(g1.y), bfhi(g1.y), bflo(g1.z), bfhi(g1.z), bflo(g1.w), bfhi(g1.w)};
#pragma unroll
      for (int q = 0; q < 12; ++q) { const int d = dg + 8 * q; float acc = wg[1536 + d];
#pragma unroll
          for (int r = 0; r < 16; ++r) acc = fmaf(gl[r], wg[r * 96 + d], acc);
          bc[t * 97 + d] = logsigmoid_fast(acc) * (1.f / 16.f); } }
    __syncthreads();
    { const int d = F.tid % 96, seg = F.tid / 96; float v[16]; float s_ = 0.f;
      if (F.tid < 384) {
#pragma unroll
          for (int t = 0; t < 16; ++t) { s_ += bc[(16 * seg + t) * 97 + d]; v[t] = s_; }
          wg[1632 + seg * 96 + d] = s_; }
      __syncthreads();
      if (F.tid < 384) { float pre = 0.f;
#pragma unroll
          for (int q = 0; q < 3; ++q) pre += (q < seg) ? wg[1632 + q * 96 + d] : 0.f;
#pragma unroll
          for (int t = 0; t < 16; ++t) bc[(16 * seg + t) * 97 + d] = v[t] + pre; } }
    __syncthreads();
}
constexpr int G2_QD = 31488, G2_KI = 44800, G2_VT = 58112, G2_KO = 85760, G2_AT = 85760, G2_RED = 99584;
DI bf16x8 ldfrag(const LAS bf16* tile, int ST, int r0, int k0, int fr, int fq) { return *(const LAS bf16x8*)(tile + (r0 + fr) * ST + k0 + 8 * fq); }
#define MFMA_GUARD_IN4(a, b, c, d)  asm volatile("s_waitcnt vmcnt(0) lgkmcnt(0)\n\ts_nop 7" : "+v"(a), "+v"(b), "+v"(c), "+v"(d))
#define MFMA_GUARD_OUT(x)           asm volatile("s_nop 15\n\ts_nop 15" : "+v"(x))
DI void gla_stage_vt(const Frame& F, size_t r0, int hd, LAS bf16* VT) {
    const bf16* PJ = (const bf16*)(F.ws + WS_PROJ);
    u32x4 v3[3];
#pragma unroll
    for (int q = 0; q < 3; ++q) { const int it = F.tid + NTHREADS * q, t = it & 63, vc = it >> 6; v3[q] = *(const u32x4*)(PJ + (r0 + t) * PROJ_LD + C_V + hd * 192 + 8 * vc); }
#pragma unroll
    for (int q = 0; q < 3; ++q) { const int it = F.tid + NTHREADS * q, t = it & 63, vc = it >> 6;
        const u32x4 vv = v3[q];
        LAS bf16* p = VT + (8 * vc) * 72 + t;
        p[0 * 72] = (bf16)(vv.x & 0xffffu); p[1 * 72] = (bf16)(vv.x >> 16); p[2 * 72] = (bf16)(vv.y & 0xffffu); p[3 * 72] = (bf16)(vv.y >> 16);
        p[4 * 72] = (bf16)(vv.z & 0xffffu); p[5 * 72] = (bf16)(vv.z >> 16); p[6 * 72] = (bf16)(vv.w & 0xffffu); p[7 * 72] = (bf16)(vv.w >> 16);
        LDS_WAIT(); }
}
DI void gla_a_task(const Frame& F, const Args& a, int l, int unit) {
    const int bh = unit >> 5, n = unit & 31, b = bh >> 2, hd = bh & 3;
    const size_t r0 = (size_t)b * SEQ + 64 * n;
    LAS float* bc = (LAS float*)(F.lds + GL_BC); LAS float* wg = (LAS float*)(F.lds + GL_WG);
    LAS bf16* VT = (LAS bf16*)(F.lds + G2_VT); LAS bf16* KO = (LAS bf16*)(F.lds + G2_KO);
    const bf16* PJ = (const bf16*)(F.ws + WS_PROJ);
    gla_bcum(F, a, l, hd, r0, bc, wg);
    { float* G = (float*)(F.ws + WS_GLABC) + (size_t)unit * 6144;
      for (int i = F.tid; i < 6144; i += NTHREADS) G[i] = bc[(i / 96) * 97 + i % 96]; }
    u32x4 k2[2];
#pragma unroll
    for (int q = 0; q < 2; ++q) { const int it = F.tid + NTHREADS * q, t = it & 63, dc = (it >> 6) % 12; k2[q] = *(const u32x4*)(PJ + (r0 + t) * PROJ_LD + C_K + hd * 96 + 8 * dc); }
#pragma unroll
    for (int q = 0; q < 2; ++q) { const int it = F.tid + NTHREADS * q, t = it & 63, dc = it >> 6;
        if (it < 64 * 12) { const u32x4 kv = k2[q];
        const float kk[8] = {bflo(kv.x), bfhi(kv.x), bflo(kv.y), bfhi(kv.y), bflo(kv.z), bfhi(kv.z), bflo(kv.w), bfhi(kv.w)};
#pragma unroll
        for (int e = 0; e < 8; ++e) { const int d = 8 * dc + e; KO[d * 72 + t] = f2bf_sw(kk[e] * __expf(bc[63 * 97 + d] - bc[t * 97 + d])); } } }
    gla_stage_vt(F, r0, hd, VT);
    __syncthreads();
    const int fr = F.lane & 15, fq = F.lane >> 4;
    float* DT = (float*)(F.ws + WS_GLAD) + (size_t)unit * 96 * 192;
    for (int q = 0; q < 9; ++q) { const int idx = F.wave * 9 + q, mb = idx / 6, nb = idx - 6 * mb;
        bf16x8 a0 = ldfrag(VT, 72, 16 * mb, 0, fr, fq), a1 = ldfrag(VT, 72, 16 * mb, 32, fr, fq), b0 = ldfrag(KO, 72, 16 * nb, 0, fr, fq), b1 = ldfrag(KO, 72, 16 * nb, 32, fr, fq);
        MFMA_GUARD_IN4(a0, a1, b0, b1);
        f32x4 d = __builtin_amdgcn_mfma_f32_16x16x32_bf16(a0, b0, (f32x4){0.f, 0.f, 0.f, 0.f}, 0, 0, 0);
        d = __builtin_amdgcn_mfma_f32_16x16x32_bf16(a1, b1, d, 0, 0, 0);
        MFMA_GUARD_OUT(d);
#pragma unroll
        for (int jj = 0; jj < 4; ++jj) DT[(16 * mb + 4 * fq + jj) * 96 + 16 * nb + fr] = d[jj]; }
    if (F.tid < 96) ((float*)(F.ws + WS_GAMMA))[(size_t)unit * 96 + F.tid] = __expf(bc[63 * 97 + F.tid]);
    __syncthreads();
}
DI void gla_scan_phase(const Frame& F) {
    const float* DL = (const float*)(F.ws + WS_GLAD); const float* GM = (const float*)(F.ws + WS_GAMMA); bf16* ST = (bf16*)(F.ws + WS_GLAS);
    for (int idx = F.bid * NTHREADS + F.tid; idx < 16 * 18432; idx += F.G * NTHREADS) {
        const int bh = idx / 18432, e = idx - bh * 18432, d = e % 96;
        const float* p = DL + (size_t)bh * 32 * 18432 + e; const float* gp = GM + (size_t)bh * 32 * 96 + d; bf16* sp = ST + (size_t)bh * 32 * 18432 + e;
        float S = 0.f; float dl[32], gm[32];
#pragma unroll
        for (int n = 0; n < 32; ++n) { dl[n] = p[(size_t)n * 18432]; gm[n] = gp[n * 96]; }
#pragma unroll
        for (int n = 0; n < 32; ++n) { sp[(size_t)n * 18432] = f2bf_sw(S); S = fmaf(gm[n], S, dl[n]); }
    }
}
DI void gla_b_task(const Frame& F, const Args& a, int l, int unit) {
    const int bh = unit >> 5, n = unit & 31, b = bh >> 2, hd = bh & 3;
    const size_t r0 = (size_t)b * SEQ + 64 * n;
    LAS float* bc = (LAS float*)(F.lds + GL_BC); LAS float* wg = (LAS float*)(F.lds + GL_WG);
    LAS bf16* QD = (LAS bf16*)(F.lds + G2_QD); LAS bf16* KI = (LAS bf16*)(F.lds + G2_KI); LAS bf16* VT = (LAS bf16*)(F.lds + G2_VT); LAS bf16* AT = (LAS bf16*)(F.lds + G2_AT);
    LAS float* red = (LAS float*)(F.lds + G2_RED);
    const bf16* PJ = (const bf16*)(F.ws + WS_PROJ);
    { const float* G = (const float*)(F.ws + WS_GLABC) + (size_t)unit * 6144;
      float g12[12];
#pragma unroll
      for (int q = 0; q < 12; ++q) g12[q] = G[F.tid + NTHREADS * q];
      asm volatile("" : "+v"(g12[0]), "+v"(g12[1]), "+v"(g12[2]), "+v"(g12[3]), "+v"(g12[4]), "+v"(g12[5]), "+v"(g12[6]), "+v"(g12[7]), "+v"(g12[8]), "+v"(g12[9]), "+v"(g12[10]), "+v"(g12[11]));
#pragma unroll
      for (int q = 0; q < 12; ++q) { const int i = F.tid + NTHREADS * q; bc[(i / 96) * 97 + i % 96] = g12[q]; } }
    __syncthreads();
    const float qscale = 0.10206207261596575f;
    u32x4 q2[2], k2[2];
#pragma unroll
    for (int q = 0; q < 2; ++q) { const int it = F.tid + NTHREADS * q, t = it & 63, dc = (it >> 6) % 12;
        q2[q] = *(const u32x4*)(PJ + (r0 + t) * PROJ_LD + C_Q + hd * 96 + 8 * dc); k2[q] = *(const u32x4*)(PJ + (r0 + t) * PROJ_LD + C_K + hd * 96 + 8 * dc); }
    asm volatile("" : "+v"(q2[0]), "+v"(q2[1]), "+v"(k2[0]), "+v"(k2[1]));
#pragma unroll
    for (int q = 0; q < 2; ++q) { const int it = F.tid + NTHREADS * q, t = it & 63, dc = it >> 6;
        if (it < 64 * 12) {
        const u32x4 qv = q2[q], kv = k2[q];
        const float qq[8] = {bflo(qv.x), bfhi(qv.x), bflo(qv.y), bfhi(qv.y), bflo(qv.z), bfhi(qv.z), bflo(qv.w), bfhi(qv.w)};
        const float kk[8] = {bflo(kv.x), bfhi(kv.x), bflo(kv.y), bfhi(kv.y), bflo(kv.z), bfhi(kv.z), bflo(kv.w), bfhi(kv.w)};
        float qo[8], ko[8];
#pragma unroll
        for (int e = 0; e < 8; ++e) { const float bcv = bc[t * 97 + 8 * dc + e]; qo[e] = qq[e] * qscale * __expf(bcv); ko[e] = kk[e] * __expf(-bcv); }
        u32x4 qp, kp; qp.x = pk_bf16(qo[0], qo[1]); qp.y = pk_bf16(qo[2], qo[3]); qp.z = pk_bf16(qo[4], qo[5]); qp.w = pk_bf16(qo[6], qo[7]);
        kp.x = pk_bf16(ko[0], ko[1]); kp.y = pk_bf16(ko[2], ko[3]); kp.z = pk_bf16(ko[4], ko[5]); kp.w = pk_bf16(ko[6], ko[7]);
        *(LAS u32x4*)(QD + t * 104 + 8 * dc) = qp; *(LAS u32x4*)(KI + t * 104 + 8 * dc) = kp; } }
    gla_stage_vt(F, r0, hd, VT);
    __syncthreads();
    const int fr = F.lane & 15, fq = F.lane >> 4;
    { const int mb = F.wave >> 1;
      bf16x8 qa0 = ldfrag(QD, 104, 16 * mb, 0, fr, fq), qa1 = ldfrag(QD, 104, 16 * mb, 32, fr, fq), qa2 = ldfrag(QD, 104, 16 * mb, 64, fr, fq);
#pragma unroll
      for (int h = 0; h < 2; ++h) { const int nb = 2 * (F.wave & 1) + h;
          bf16x8 k0 = ldfrag(KI, 104, 16 * nb, 0, fr, fq), k1 = ldfrag(KI, 104, 16 * nb, 32, fr, fq), k2 = ldfrag(KI, 104, 16 * nb, 64, fr, fq);
          MFMA_GUARD_IN4(k0, k1, k2, qa0); asm volatile("" : "+v"(qa1), "+v"(qa2));
          f32x4 d = __builtin_amdgcn_mfma_f32_16x16x32_bf16(qa0, k0, (f32x4){0.f, 0.f, 0.f, 0.f}, 0, 0, 0);
          d = __builtin_amdgcn_mfma_f32_16x16x32_bf16(qa1, k1, d, 0, 0, 0);
          d = __builtin_amdgcn_mfma_f32_16x16x32_bf16(qa2, k2, d, 0, 0, 0);
          MFMA_GUARD_OUT(d);
#pragma unroll
          for (int jj = 0; jj < 4; ++jj) { const int i = 16 * mb + 4 * fq + jj, jc = 16 * nb + fr; AT[i * 72 + jc] = f2bf_sw(jc <= i ? d[jj] : 0.f); } } }
    __syncthreads();
    const int mb = F.wave & 3, nb0 = 6 * (F.wave >> 2);
    const bf16* SG = (const bf16*)(F.ws + WS_GLAS) + (size_t)unit * 18432;
    bf16x8 at0 = ldfrag(AT, 72, 16 * mb, 0, fr, fq), at1 = ldfrag(AT, 72, 16 * mb, 32, fr, fq);
    bf16x8 qa0 = ldfrag(QD, 104, 16 * mb, 0, fr, fq), qa1 = ldfrag(QD, 104, 16 * mb, 32, fr, fq), qa2 = ldfrag(QD, 104, 16 * mb, 64, fr, fq);
    f32x4 o[6];
    bf16x8 vf[6][2], sf[6][3];
#pragma unroll
    for (int q = 0; q < 6; ++q) { const int nb = nb0 + q; const bf16* sp = SG + (16 * nb + fr) * 96 + 8 * fq;
        sf[q][0] = *(const bf16x8*)(sp); sf[q][1] = *(const bf16x8*)(sp + 32); sf[q][2] = *(const bf16x8*)(sp + 64);
        vf[q][0] = ldfrag(VT, 72, 16 * nb, 0, fr, fq); vf[q][1] = ldfrag(VT, 72, 16 * nb, 32, fr, fq); }
    asm volatile("s_waitcnt vmcnt(0) lgkmcnt(0)\n\ts_nop 7" : "+v"(at0), "+v"(at1), "+v"(qa0), "+v"(qa1), "+v"(qa2));
#pragma unroll
    for (int q = 0; q < 6; ++q) {
        asm volatile("" : "+v"(vf[q][0]), "+v"(vf[q][1]), "+v"(sf[q][0]), "+v"(sf[q][1]), "+v"(sf[q][2]));
        f32x4 d = __builtin_amdgcn_mfma_f32_16x16x32_bf16(at0, vf[q][0], (f32x4){0.f, 0.f, 0.f, 0.f}, 0, 0, 0);
        d = __builtin_amdgcn_mfma_f32_16x16x32_bf16(at1, vf[q][1], d, 0, 0, 0);
        d = __builtin_amdgcn_mfma_f32_16x16x32_bf16(qa0, sf[q][0], d, 0, 0, 0);
        d = __builtin_amdgcn_mfma_f32_16x16x32_bf16(qa1, sf[q][1], d, 0, 0, 0);
        d = __builtin_amdgcn_mfma_f32_16x16x32_bf16(qa2, sf[q][2], d, 0, 0, 0);
        o[q] = d; }
    asm volatile("s_nop 15\n\ts_nop 15" : "+v"(o[0]), "+v"(o[1]), "+v"(o[2]), "+v"(o[3]), "+v"(o[4]), "+v"(o[5]));
    float ss[4];
#pragma unroll
    for (int jj = 0; jj < 4; ++jj) { float s_ = 0.f;
#pragma unroll
        for (int q = 0; q < 6; ++q) s_ += o[q][jj] * o[q][jj];
        s_ = xor_add<1>(s_); s_ = xor_add<2>(s_); s_ = xor_add<4>(s_); s_ = xor_add<8>(s_); ss[jj] = s_; }
    if (fr == 0) {
#pragma unroll
        for (int jj = 0; jj < 4; ++jj) red[(F.wave >> 2) * 64 + 16 * mb + 4 * fq + jj] = ss[jj]; }
    __syncthreads();
    bf16* MIX = (bf16*)(F.ws + WS_MIX);
    const float* hg = INP(a, I_GHG) + l * 192;
#pragma unroll
    for (int jj = 0; jj < 4; ++jj) { const int i = 16 * mb + 4 * fq + jj; const float rstd = rsqrtf((red[i] + red[64 + i]) * (1.f / 192.f) + EPS);
        const size_t row = r0 + i;
#pragma unroll
        for (int q = 0; q < 6; ++q) { const int v = 16 * (nb0 + q) + fr; const float og = bf2f(PJ[row * PROJ_LD + C_OG + hd * 192 + v]);
            MIX[row * DM + 1280 + hd * 192 + v] = f2bf(o[q][jj] * rstd * hg[v] * siluf_(og)); } }
    __syncthreads();
}

#ifdef DBG_HASH
constexpr int CW_HASH = 1024;
struct HashJob { int after_ph; size_t off; size_t bytes; };
__device__ __forceinline__ void hash_phase(const Frame& F, size_t off, size_t bytes, int slot) {
    const unsigned* w = (const unsigned*)(F.ws + off); const size_t n = bytes / 4;
    unsigned acc = 0u;
    for (size_t i = (size_t)F.bid * NTHREADS + F.tid; i < n; i += (size_t)F.G * NTHREADS) acc += w[i] * (unsigned)(2u * (unsigned)i + 1u);
#pragma unroll
    for (int o = 1; o < 64; o <<= 1) acc += __shfl_xor(acc, o);
    if (F.lane == 0) __hip_atomic_fetch_add(F.ctl + CW_HASH + slot * 64, acc, __ATOMIC_RELAXED, __HIP_MEMORY_SCOPE_AGENT);
}
__device__ __forceinline__ void emit_phase(const Frame& F, float* out) {
    const size_t total = (size_t)T * DM, seg = total / 16;
    for (size_t i = (size_t)F.bid * NTHREADS + F.tid; i < total; i += (size_t)F.G * NTHREADS) {
        const int k = (int)(i / seg); const unsigned h = __hip_atomic_load(F.ctl + CW_HASH + k * 64, __ATOMIC_RELAXED, __HIP_MEMORY_SCOPE_AGENT);
        const float amp = __builtin_ldexpf(1.f, -k);
        out[i] = amp * (float)((h >> (unsigned)(i & 31)) & 1u);
    }
}
#endif
#ifndef LB_W
#define LB_W 2
#endif
__global__ void __launch_bounds__(NTHREADS, LB_W) mega_fwd(Args args) {
    extern __shared__ __attribute__((aligned(16))) unsigned char lds_raw[];
    Frame F;
    F.lds = (LAS unsigned char*)lds_raw;
    F.MISC = (volatile LAS unsigned*)(F.lds + LDSCTL_OFF);
    F.wave = __builtin_amdgcn_readfirstlane((int)threadIdx.x >> 6); F.lane = lane_id(); F.tid = F.wave * 64 + F.lane;
    F.G = gridDim.x; F.bid = blockIdx.x;
    F.ws = (GAS unsigned char*)args.ws; F.ctl = (unsigned*)(F.ws + WS_CTL);
#ifdef DBG_POISON
    for (int u = F.tid; u < SCR_BYTES / 4; u += NTHREADS) ((LAS unsigned*)F.lds)[u] = 0xFFFFFFFFu;
#endif
    for (int u = F.tid; u < (LDS_BYTES - LDSCTL_OFF) / 4; u += NTHREADS) ((LAS unsigned*)(F.lds + LDSCTL_OFF))[u] = 0u;
    __syncthreads();
    XcdBarrier bar = xcd_barrier_post(F.ctl + CW_BAR + args.li * XCD_BAR_WORDS, F.MISC + 8, F.wave);
    const int lo = args.ph_lo, hi = args.ph_hi;
#ifdef DBG_HASH
    if (lo >= 200) { emit_phase(F, args.out); return; }
    if (lo >= 100) { hash_phase(F, (size_t)args.hoff, (size_t)args.hbytes, lo - 100); return; }
#endif
#ifndef PHMASK
#define PHMASK 0xFFFF
#endif
#define PH(k, id) if (((PHMASK >> (k)) & 1) && (id) >= lo && (id) < hi)
#define REFRESH() do { int lz_ = lane_id(); asm volatile("" : "+v"(lz_)); F.lane = lz_; F.tid = F.wave * 64 + lz_; asm volatile("" : "+s"(F.ws)); } while (0)
#define SEAM(id) do { if ((id) > lo) xcd_barrier(bar); REFRESH(); } while (0)
    const float* MOD = (const float*)(F.ws + WS_MOD);

    PH(0, 0) { p0_s5_consts(F, args); p0_lru_w(F, args); p0_ada(F, args); p0_convert(F, args); }

    for (int l = 0; l < DEPTH; ++l) {
        const int pb = 1 + 12 * l;
        const float* mod = MOD + (size_t)l * 4 * (NADA * DM);
        const float* xin = (l == 0) ? INP(args, I_X) : (const float*)(F.ws + WS_XCUR);
        PH(1, pb + 0) { SEAM(pb + 0); norm_phase<false, false>(F, args, xin, INP(args, I_NMIXG) + l * DM, mod, 0, 1, nullptr); }
        PH(2, pb + 1) { SEAM(pb + 1);
            pg8::Gemm g{(const bf16*)(F.ws + WS_H), (const bf16*)(F.ws + WS_WIN) + (size_t)l * PROJ_LD * DM, DM}; pg8::StaticOrder S; S.init(T, PROJ_LD, F.G, F.bid);
            pg8::EpiBf16Perm E{(bf16*)(F.ws + WS_PROJ), PROJ_LD};
            pg8::gemm_phase(F.lds, g, S, E, F.wave); }
        PH(3, pb + 2) { SEAM(pb + 2);
#ifndef M1_NO_GLA
            for (int u = F.bid; u < 512; u += F.G) gla_a_task(F, args, l, u);
#endif
            __syncthreads();
#ifndef M1_NO_S5
            for (int bt = F.bid; bt < 512; bt += F.G) s5_task<false>(F, args, l, ((bt >> 7) << 10) | ((8 * (bt & 3) + F.wave) << 5) | ((bt >> 2) & 31), F.lds + F.wave * 16384);
#endif
#ifndef M1_NO_LRU
            for (int t = F.bid * NWAVES + F.wave; t < 2048; t += F.G * NWAVES) lru_gate_task(F, args, l, t);
#endif
 }
        PH(4, pb + 3) { SEAM(pb + 3);
            for (int bt = F.bid; bt < 512; bt += F.G) s5_task<true>(F, args, l, ((bt >> 7) << 10) | ((8 * (bt & 3) + F.wave) << 5) | ((bt >> 2) & 31), F.lds + F.wave * 16384);
            for (int t = F.bid * NWAVES + F.wave; t < 1536; t += F.G * NWAVES) lru_scan_task(F, t);
            gla_scan_phase(F); }
        PH(5, pb + 4) { SEAM(pb + 4);
            { pg8::Gemm g{(const bf16*)(F.ws + WS_Z), (const bf16*)(F.ws + WS_WGLU) + (size_t)l * 1024 * 512, 512}; pg8::StaticOrder S; S.init(T, 1024, F.G, F.bid);
              pg8::EpiGlu E{(float*)(F.ws + WS_S5PRE), INP(args, I_S5BGLU) + l * 1024};
              pg8::gemm_phase(F.lds, g, S, E, F.wave); }
            REFRESH();
            __syncthreads();
#ifndef T_NO_A
            for (int u = (F.bid + 128 >= F.G) ? F.bid + 128 - F.G : F.bid + 128; u < 128; u += F.G) lru_out_task(F, args, l, u);
#endif
#ifndef T_NO_B
            for (int u = F.bid; u < 512; u += F.G) gla_b_task(F, args, l, u);
#endif
 }
        PH(6, pb + 5) { SEAM(pb + 5); s5norm_phase(F, INP(args, I_S5NG) + l * 512); }
        PH(7, pb + 6) { SEAM(pb + 6);
            pg8::Gemm g{(const bf16*)(F.ws + WS_MIX), (const bf16*)(F.ws + WS_WOUT) + (size_t)l * DM * DM, DM}; pg8::StaticOrder S; S.init(T, DM, F.G, F.bid);
            pg8::EpiResid E{(float*)(F.ws + WS_X1), xin, mod + 2 * DM, 1.f};
            pg8::gemm_phase(F.lds, g, S, E, F.wave); }
        PH(8, pb + 7) { SEAM(pb + 7);
            if (l & 1) norm_phase<true, true>(F, args, (const float*)(F.ws + WS_X1), INP(args, I_NFFNG) + l * DM, mod, 3, 4, INP(args, I_ROUTER) + (size_t)(l >> 1) * DM * NE);
            else norm_phase<false, false>(F, args, (const float*)(F.ws + WS_X1), INP(args, I_NFFNG) + l * DM, mod, 3, 4, nullptr); }
        const bool moe = (l & 1) != 0;
        if (moe) { PH(9, pb + 8) { SEAM(pb + 8); moe_sort_phase(F); } }
        if (moe) {
            PH(10, pb + 9) { SEAM(pb + 9); moe_tiles(F);
                pg8::Gemm g{(const bf16*)(F.ws + WS_AS), (const bf16*)(F.ws + WS_M13), DM / 2}; pg8::GroupedOrder S; S.init(F.MISC + 16, 2 * DFFE, F.G, F.bid, (long)2 * DFFE * DM);
                pg8::EpiSwiglu8 E{(unsigned char*)(F.ws + WS_HID), DFFE, 1.f / (SC_X * SC_W13), SC_H};
                pg8::gemm_phase8(F.lds, g, S, E, F.wave); }
            PH(11, pb + 10) { SEAM(pb + 10); moe_tiles(F);
                pg8::Gemm g{(const bf16*)(F.ws + WS_HID), (const bf16*)(F.ws + WS_M2), DFFE / 2}; pg8::GroupedOrder S; S.init(F.MISC + 16, DM, F.G, F.bid, (long)DM * DFFE, 2 * F.G);
                pg8::EpiF32 E{(float*)(F.ws + WS_Y), DM, 1.f / (SC_H * SC_W2)};
                pg8::gemm_phase8(F.lds, g, S, E, F.wave);
                pg8::TailOrder ST; ST.init(F.MISC + 16, DM, 2 * F.G, F.G, F.bid, (long)DM * DFFE, (long)64 * DFFE);
                pg8::EpiF32Narrow EN{(float*)(F.ws + WS_Y), DM, 1.f / (SC_H * SC_W2)};
                pg8::gemm_phase8<true>(F.lds, g, ST, EN, F.wave); }
        } else {
            PH(10, pb + 9) { SEAM(pb + 9);
                pg8::Gemm g{(const bf16*)(F.ws + WS_H), (const bf16*)(F.ws + WS_F13), DM}; pg8::StaticOrder S; S.init(T, 2 * DFF, F.G, F.bid);
                pg8::EpiSwiglu8 E{(unsigned char*)(F.ws + WS_HID), DFF, 1.f, SC_H};
                pg8::gemm_phase(F.lds, g, S, E, F.wave); }
            PH(11, pb + 10) { SEAM(pb + 10);
                pg8::Gemm g{(const bf16*)(F.ws + WS_HID), (const bf16*)(F.ws + WS_F2), DFF / 2}; pg8::StaticOrder S; S.init(T, DM, F.G, F.bid);
                pg8::EpiResid E{(float*)(F.ws + WS_XCUR), (const float*)(F.ws + WS_X1), mod + 5 * DM, 1.f / (SC_H * SC_W2)};
                pg8::gemm_phase8(F.lds, g, S, E, F.wave); }
        }
        if (moe) { PH(12, pb + 11) { SEAM(pb + 11); final_phase(F, args, mod); } }
    }
#undef PH
#undef SEAM
}

extern "C" void kernel_launch(void* const* d_in, const int* in_sizes, int n_in, void* d_out, int out_size, void* d_ws, size_t ws_size, hipStream_t stream) {
    static int grid = 0;
    if (grid == 0) {
        if (n_in != 38 || out_size != T * DM || ws_size < WS_END) { fprintf(stderr, "kernel_launch: unexpected shapes (n_in %d out %d ws %zu)\n", n_in, out_size, ws_size); grid = -1; return; }
        int dev = 0, cus = 0, per_cu = 0;
        if (hipGetDevice(&dev) != hipSuccess || hipDeviceGetAttribute(&cus, hipDeviceAttributeMultiprocessorCount, dev) != hipSuccess) { grid = -1; return; }
        if (hipFuncSetAttribute((const void*)mega_fwd, hipFuncAttributeMaxDynamicSharedMemorySize, LDS_BYTES) != hipSuccess) { fprintf(stderr, "kernel_launch: hipFuncSetAttribute failed\n"); grid = -1; return; }
        if (hipOccupancyMaxActiveBlocksPerMultiprocessor(&per_cu, (const void*)mega_fwd, NTHREADS, LDS_BYTES) != hipSuccess || per_cu < 1) { fprintf(stderr, "kernel_launch: occupancy query says %d\n", per_cu); }
        (void)hipGetLastError();
        grid = cus;
    }
    if (grid < 0) return;
    (void)hipMemsetAsync((char*)d_ws + WS_CTL, 0, CTL_BYTES, stream);
#ifdef DBG_POISON
    (void)hipMemsetAsync((char*)d_ws + CTL_BYTES, 0xFF, WS_END - CTL_BYTES, stream);
#endif
    Args a{};
    for (int i = 0; i < 38; ++i) a.in[i] = (const float*)d_in[i];
    a.out = (float*)d_out; a.ws = (unsigned char*)d_ws; a.pad = 0; a.hoff = 0; a.hbytes = 0;
    constexpr int NPH = 1 + 12 * DEPTH;
#if N_LAUNCH_MODE == 0
    a.ph_lo = 0; a.ph_hi = NPH; a.li = 0;
    hipLaunchKernelGGL(mega_fwd, dim3(grid), dim3(NTHREADS), LDS_BYTES, stream, a);
#else
    int li = 0;
    for (int ph = 0; ph < NPH; ++ph) {
        const int l = (ph - 1) / 12, k = (ph - 1) % 12;
        if (ph > 0) { if ((l & 1) == 0 && (k == 8 || k == 11)) continue; }
        a.ph_lo = ph; a.ph_hi = ph + 1; a.li = li++;
        hipLaunchKernelGGL(mega_fwd, dim3(grid), dim3(NTHREADS), LDS_BYTES, stream, a);
#ifdef DBG_HASH
        {
            static const HashJob jobs[16] = {
                {0, 1 * MiB, 3 * MiB}, {0, WS_WIN, WS_H - WS_WIN},
                {1, WS_H, 32 * MiB}, {2, WS_PROJ, 72 * MiB}, {3, WS_S5E, 2 * MiB}, {3, WS_LRUA, 84 * MiB},
                {4, WS_Z, 8 * MiB}, {4, WS_LRUA, 48 * MiB}, {4, WS_GLAD, 36 * MiB},
                {5, WS_S5PRE, 16 * MiB}, {5, WS_MIX, 32 * MiB}, {6, WS_MIX, 32 * MiB}, {7, WS_X1, 64 * MiB}, {8, WS_H, 32 * MiB}, {10, WS_HID, (size_t)T * DFF * 2}, {11, WS_XCUR, 64 * MiB} };
            for (int k = 0; k < 16; ++k) if (jobs[k].after_ph == ph) { Args h = a; h.ph_lo = 100 + k; h.ph_hi = 101 + k; h.hoff = jobs[k].off; h.hbytes = jobs[k].bytes; hipLaunchKernelGGL(mega_fwd, dim3(grid), dim3(NTHREADS), LDS_BYTES, stream, h); }
        }
#endif
    }
#ifdef DBG_HASH
    { Args h = a; h.ph_lo = 200; h.ph_hi = 201; hipLaunchKernelGGL(mega_fwd, dim3(grid), dim3(NTHREADS), LDS_BYTES, stream, h); }
#endif
#endif
}
```

```cpp
#include <hip/hip_runtime.h>
#include <cstdio>
#include <cstdint>

#ifndef N_LAUNCH_MODE
#define N_LAUNCH_MODE 0
#endif
#ifndef DBG_OUTSCALE
#define DBG_OUTSCALE 1.0f
#endif

#define DI __device__ __forceinline__
#define GAS __attribute__((address_space(1)))
#define LAS __attribute__((address_space(3)))
typedef unsigned short bf16;
typedef float f32x4 __attribute__((ext_vector_type(4)));
typedef float f32x2 __attribute__((ext_vector_type(2)));
typedef short bf16x8 __attribute__((ext_vector_type(8)));
typedef unsigned u32x4 __attribute__((ext_vector_type(4)));
typedef unsigned u32x2 __attribute__((ext_vector_type(2)));

constexpr int DM = 2048, NBATCH = 4, SEQ = 2048, T = NBATCH * SEQ, DEPTH = 2;
constexpr int DIN_SRC = 4368;
constexpr int PROJ_LD = 4608;
constexpr int C_U = 0, C_XL = 512, C_GL = 1280, C_Q = 2048, C_K = 2432, C_V = 2816, C_OG = 3584, C_GLOW = 4352;
constexpr int DFF = 5632, DFFE = 7168, NE = 8;
constexpr int NADA = 6;
constexpr float EPS = 1e-6f;
constexpr int MOE_ROWS = 18432;
constexpr int NWAVES = 8, NTHREADS = 512;
constexpr float SC_X = 16.f, SC_W13 = 256.f, SC_H = 16.f, SC_W2 = 512.f;

constexpr size_t MiB = 1u << 20;
constexpr size_t WS_CTL = 0, CTL_BYTES = 1 * MiB;
constexpr size_t WS_MOD = 1 * MiB;
constexpr size_t WS_S5C = 2 * MiB;
constexpr size_t S5C_STRIDE = 512 * 1024, S5C_ABAR = 0, S5C_ABARL = 16384, S5C_BBAR = 32768, S5C_CMAT = 32768 + 131072;
constexpr size_t WS_LRUW = 3 * MiB;
constexpr size_t LRUW_STRIDE = 512 * 1024, LRUW_X = 147456;
constexpr size_t WS_S5E = 4 * MiB;
constexpr size_t WS_ROUTE = 6 * MiB;
constexpr size_t WS_CNTBLK = 6 * MiB + 512 * 1024;
constexpr size_t WS_GAMMA = 7 * MiB;
constexpr size_t WS_WIN = 8 * MiB;
constexpr size_t WS_WOUT = 44 * MiB;
constexpr size_t WS_WGLU = 60 * MiB;
constexpr size_t WS_F13 = 62 * MiB;
constexpr size_t WS_F2 = 106 * MiB;
constexpr size_t WS_M13 = 128 * MiB;
constexpr size_t WS_M2 = 576 * MiB;
constexpr size_t WS_H = 800 * MiB;
constexpr size_t WS_PROJ = 832 * MiB;
constexpr size_t WS_LRUA = 904 * MiB;
constexpr size_t WS_LRUB = 928 * MiB;
constexpr size_t WS_GLAD = 952 * MiB;
constexpr size_t WS_Z = 988 * MiB;
constexpr size_t WS_S5PRE = 996 * MiB;
constexpr size_t WS_MIX = 1012 * MiB;
constexpr size_t WS_X1 = 1044 * MiB;
constexpr size_t WS_XCUR = 1108 * MiB;
constexpr size_t WS_HID = 1172 * MiB;
constexpr size_t WS_AS = 1424 * MiB;
constexpr size_t WS_Y = 1496 * MiB;
constexpr size_t WS_GLAS = WS_HID;
constexpr size_t WS_GLABC = WS_HID + 32 * MiB;
constexpr size_t WS_END = 1640 * MiB;

constexpr int CW_CNT = 64;
constexpr int CW_BAR = 4096;

constexpr int SCR_BYTES = 143360;
constexpr int LDSCTL_OFF = SCR_BYTES;
constexpr int LDS_BYTES = 147456;

#define LDS_WAIT() asm volatile("s_waitcnt lgkmcnt(0)" ::: "memory")
#define VM_WAIT() asm volatile("s_waitcnt vmcnt(0)" ::: "memory")
DI int lane_id() { unsigned m = ~0u; asm volatile("" : "+s"(m)); return (int)__builtin_amdgcn_mbcnt_hi(m, __builtin_amdgcn_mbcnt_lo(m, 0u)); }
DI unsigned pk_bf16(float lo, float hi) { unsigned r; asm("v_cvt_pk_bf16_f32 %0, %1, %2" : "=v"(r) : "v"(lo), "v"(hi)); return r; }
DI bf16 f2bf(float f) { return (bf16)(pk_bf16(f, 0.f) & 0xffffu); }
DI bf16 f2bf_sw(float f) { unsigned u = __builtin_bit_cast(unsigned, f); return (bf16)((u + 0x7fffu + ((u >> 16) & 1u)) >> 16); }
DI float bf2f(unsigned b) { return __builtin_bit_cast(float, b << 16); }
DI float bflo(unsigned w) { return __builtin_bit_cast(float, w << 16); }
DI float bfhi(unsigned w) { return __builtin_bit_cast(float, w & 0xffff0000u); }
template <int O> DI float xor_add(float v) { return v + __builtin_bit_cast(float, __builtin_amdgcn_ds_swizzle(__builtin_bit_cast(int, v), (O << 10) | 0x1f)); }
DI float half_sum(float v) { v = xor_add<1>(v); v = xor_add<2>(v); v = xor_add<4>(v); v = xor_add<8>(v); v = xor_add<16>(v); return v; }
DI float wave_sum(float v) {
    v = half_sum(v);
    return __builtin_bit_cast(float, __builtin_amdgcn_readlane(__builtin_bit_cast(int, v), 0)) + __builtin_bit_cast(float, __builtin_amdgcn_readlane(__builtin_bit_cast(int, v), 32));
}
DI float sigmoidf_(float x) { return __builtin_amdgcn_rcpf(1.f + __expf(-x)); }
DI float siluf_(float x) { return x * __builtin_amdgcn_rcpf(1.f + __expf(-x)); }
DI float gelu_tanh(float y) { const float u = 1.5957691216057308f * (y + 0.044715f * y * y * y); return y * __builtin_amdgcn_rcpf(1.f + __expf(-u)); }
DI float logsigmoidf_(float x) { return fminf(x, 0.f) - log1pf(__expf(-fabsf(x))); }
DI float logsigmoid_fast(float x) { return fminf(x, 0.f) - __logf(1.f + __expf(-fabsf(x))); }

#define XB_TMO      128
#define XB_XCNT(j)  (256  + 64 * (j))
#define XB_XSUB(j)  (1280 + 64 * (j))
#define XB_XGEN(j)  (2304 + 64 * (j))
#define XB_TOP      3328
#define XB_TOPGEN   3392
#define XCD_BAR_WORDS 3456
#define XB_SPIN_CAP (1u << 18)
__device__ __forceinline__ unsigned xb_ld(unsigned* p)              { return __hip_atomic_load(p, __ATOMIC_RELAXED, __HIP_MEMORY_SCOPE_AGENT); }
__device__ __forceinline__ unsigned xb_add(unsigned* p, unsigned v) { asm volatile("" : "+s"(v)); return __hip_atomic_fetch_add(p, v, __ATOMIC_RELAXED, __HIP_MEMORY_SCOPE_AGENT); }
__device__ __forceinline__ unsigned xb_xcc_id() { return (unsigned)__builtin_amdgcn_s_getreg((3 << 11) | 20) & 0xFu; }
#define XB_SPIN(cond, bar) do { unsigned _sp = 0; while (cond) { __builtin_amdgcn_s_sleep(1); \
    if ((++_sp & 255u) == 0u) { if (xb_ld(&(bar)[XB_TMO])) break; if (_sp > XB_SPIN_CAP) { atomicAdd(&(bar)[XB_TMO], 1u); break; } } } } while (0)
struct XcdBarrier { unsigned* bar; unsigned x; volatile LAS unsigned* st; int wave; };
__device__ __forceinline__ XcdBarrier xcd_barrier_post(unsigned* bar, volatile LAS unsigned* st, int wave) {
    XcdBarrier b; b.bar = bar; b.x = xb_xcc_id(); b.st = st; b.wave = wave;
    if (wave == 0 && lane_id() == 0) (void)xb_add(&bar[XB_XCNT(b.x)], 1u);
    return b;
}
__device__ __forceinline__ void xcd_barrier_complete(unsigned* bar, unsigned x, unsigned& nloc, unsigned& nx) {
    const unsigned G = gridDim.x * gridDim.y * gridDim.z;
    unsigned sum, cnt, mine, sp = 0u;
    for (;;) {
        sum = 0u; cnt = 0u; mine = 0u;
#pragma unroll
        for (unsigned j = 0; j < 16; ++j) { const unsigned c = xb_ld(&bar[XB_XCNT(j)]); sum += c; cnt += (c > 0u) ? 1u : 0u; mine = (j == x) ? c : mine; }
        if (sum == G) break;
        __builtin_amdgcn_s_sleep(1);
        if ((++sp & 255u) == 0u) { if (xb_ld(&bar[XB_TMO])) break; if (sp > XB_SPIN_CAP) { atomicAdd(&bar[XB_TMO], 1u); break; } }
    }
    nloc = mine > 0u ? mine : 1u; nx = cnt > 0u ? cnt : 1u;
}
__device__ __forceinline__ void xcd_barrier(const XcdBarrier& b) {
    asm volatile("s_waitcnt vmcnt(0)" ::: "memory");
    __syncthreads();
    if (b.wave == 0 && lane_id() == 0) {
        unsigned* bar = b.bar;
        __builtin_amdgcn_s_waitcnt(0);
        unsigned nloc = b.st[0], nx = b.st[1];
        if (nloc == 0u) { xcd_barrier_complete(bar, b.x, nloc, nx); b.st[0] = nloc; b.st[1] = nx; }
        const unsigned old = xb_add(&bar[XB_XSUB(b.x)], 1u);
        const unsigned gen = old / nloc;
        if (old + 1u == (gen + 1u) * nloc) {
            __builtin_amdgcn_fence(__ATOMIC_RELEASE, "agent");
            asm volatile("s_waitcnt vmcnt(0)" ::: "memory");
            const unsigned og = xb_add(&bar[XB_TOP], 1u);
            const unsigned tg = og / nx;
            if (og + 1u == (tg + 1u) * nx) xb_add(&bar[XB_TOPGEN], 1u);
            else XB_SPIN(xb_ld(&bar[XB_TOPGEN]) == tg, bar);
            __builtin_amdgcn_fence(__ATOMIC_ACQUIRE, "agent");
            xb_add(&bar[XB_XGEN(b.x)], 1u);
            asm volatile("s_waitcnt vmcnt(0)" ::: "memory");
        } else {
            XB_SPIN(xb_ld(&bar[XB_XGEN(b.x)]) == gen, bar);
            __builtin_amdgcn_fence(__ATOMIC_ACQUIRE, "agent");
            asm volatile("s_waitcnt vmcnt(0)" ::: "memory");
        }
    }
    __syncthreads();
}

namespace pg8 {
constexpr int BM = 256, BK = 64, HALF = 128, HTB = HALF * BK * 2, STAGE_BYTES = 8 * HTB, NXCD = 8, WGM = 5;
__host__ __device__ __forceinline__ int lds_byte(int r, int c) { const int st = (r >> 4) * 2 + (c >> 5), rr = r & 15, cc = c & 31, ob = rr * 64 + cc * 2; return st * 1024 + (ob ^ (((ob >> 9) & 1) << 5)); }
__host__ __device__ __forceinline__ void stage_rc(int b_, int& R, int& C) { const unsigned b = (unsigned)b_, st = b >> 10, sb = b & 1023u, swz = sb ^ (((sb >> 9) & 1u) << 5); R = (int)((st >> 1) * 16u + (swz >> 6)); C = (int)((st & 1u) * 32u + ((swz & 63u) >> 1)); }
__host__ __device__ __forceinline__ int perm32(int rho) { const int n = rho >> 4, i = rho & 15; return 8 * (i >> 2) + 4 * n + (i & 3); }

struct Unit { int pm, pn; long boff; int q; };
struct Gemm { const bf16* A; const bf16* Bt; int K; };

__device__ __forceinline__ int xcd_remap(int wgid, int nwg) { const int q = nwg / NXCD, r = nwg % NXCD, xcd = wgid % NXCD, off = wgid / NXCD; return (xcd < r ? xcd * (q + 1) : r * (q + 1) + (xcd - r) * q) + off; }
struct StaticOrder {
    int nM, nN, nwg, G, c;
    __device__ void init(int M, int N, int G_, int c_) { nM = M / BM; nN = N / BM; nwg = nM * nN; G = G_; c = c_; }
    __device__ bool next(int i, Unit& u) const {
        const long L = (long)i * G + c; if (L >= nwg) return false;
        const int wgid = xcd_remap((int)L, nwg);
        const int nig = WGM * nN, gid = wgid / nig, fm = gid * WGM, gsz = (nM - fm) < WGM ? (nM - fm) : WGM;
        u.pm = fm + ((wgid % nig) % gsz); u.pn = (wgid % nig) / gsz; u.boff = 0; return true;
    }
};
struct GroupedOrder {
    volatile LAS unsigned* ts; int nN, nwg, lim, G, c; long estride;
    __device__ void init(volatile LAS unsigned* ts_, int N, int G_, int c_, long estride_, int lim_ = 1 << 30) { ts = ts_; nN = N / BM; nwg = __builtin_amdgcn_readfirstlane((int)ts_[8] * nN); lim = nwg < lim_ ? nwg : lim_; G = G_; c = c_; estride = estride_; }
    __device__ bool next(int i, Unit& u) const {
        const long L = (long)i * G + c; if (L >= lim) return false;
        const int wgid = xcd_remap((int)L, nwg);
        int e = 0;
#pragma unroll
        for (int k = 1; k < 8; ++k) if (wgid >= (int)ts[k] * nN) e = k;
        const int t0 = (int)ts[e], te = (int)ts[e + 1] - t0, Lp = wgid - t0 * nN;
        u.pn = __builtin_amdgcn_readfirstlane(Lp / te); u.pm = __builtin_amdgcn_readfirstlane(t0 + Lp % te); u.boff = (long)__builtin_amdgcn_readfirstlane(e) * estride; return true;
    }
};

struct TailOrder {
    volatile LAS unsigned* ts; int nN, nwg, first, G, c; long estride, qstride;
    __device__ void init(volatile LAS unsigned* ts_, int N, int first_, int G_, int c_, long estride_, long qstride_) { ts = ts_; nN = N / BM; nwg = __builtin_amdgcn_readfirstlane((int)ts_[8] * nN); first = first_; G = G_; c = c_; estride = estride_; qstride = qstride_; }
    __device__ bool next(int i, Unit& u) const {
        const int s = i * G + c, L = first + (s & 7) + 8 * (s >> 5), q = (s >> 3) & 3;
        if (L >= nwg) return false;
        const int wgid = xcd_remap(L, nwg);
        int e = 0;
#pragma unroll
        for (int k = 1; k < 8; ++k) if (wgid >= (int)ts[k] * nN) e = k;
        const int t0 = (int)ts[e], te = (int)ts[e + 1] - t0, Lp = wgid - t0 * nN;
        u.pn = __builtin_amdgcn_readfirstlane(Lp / te); u.pm = __builtin_amdgcn_readfirstlane(t0 + Lp % te); u.q = q; u.boff = (long)__builtin_amdgcn_readfirstlane(e) * estride + (long)q * qstride; return true;
    }
};

__device__ __forceinline__ void glds16(const char* sbase, unsigned voff, unsigned m0v) {
    unsigned keep;
    asm volatile("s_mov_b32 %0, m0\n\ts_mov_b32 m0, %3\n\ts_nop 0\n\tglobal_load_lds_dwordx4 %1, %2\n\ts_mov_b32 m0, %0" : "=&s"(keep) : "v"(voff), "s"(sbase), "s"(m0v) : "memory");
}
template <class Epi, class Sched>
__device__ __forceinline__ void gemm_phase(LAS unsigned char* lds, const Gemm g, const Sched& S, const Epi& E, const int wid) {
    int lane = lane_id(); asm volatile("" : "+v"(lane));
    const int tid = wid * 64 + lane, wr = wid >> 2, wc = wid & 3, fr = lane & 15, fq = lane >> 4;
    const int K = g.K, nt = K / BK;
    unsigned voffA; { int R, C; stage_rc(tid * 16, R, C); voffA = (unsigned)(R * K + C) * 2u; }
    const size_t rstep = (size_t)64 * K * 2;
    const size_t kstep = (size_t)(BK * 2);
    const size_t hstep = (size_t)HALF * K * 2;
    const size_t tstep = 2 * hstep;
    const unsigned ldsb = (unsigned)(unsigned long)lds + (unsigned)wid * 1024u;
    const int aoff = lds_byte(wr * 64 + fr, fq * 8), boff = lds_byte(wc * 32 + fr, fq * 8);
#define PG8_SA(b, h) (((b) * 2 + (h)) * HTB)
#define PG8_SB(b, h) ((4 + (b) * 2 + (h)) * HTB)
#define PG8_STAGE(bufoff, gbase) do { _Pragma("unroll") for (int _i = 0; _i < 2; ++_i) glds16((const char*)(gbase) + _i * rstep, voffA, ldsb + (unsigned)((bufoff) + _i * 8192)); } while (0)
#define PG8_LDA(dst, b, h) do { _Pragma("unroll") for (int m = 0; m < 4; ++m) _Pragma("unroll") for (int k = 0; k < 2; ++k) dst[m][k] = *(const LAS bf16x8*)(lds + PG8_SA(b, h) + aoff + m * 2048 + k * 1024); } while (0)
#define PG8_LDB(dst, b, h) do { _Pragma("unroll") for (int n = 0; n < 2; ++n) _Pragma("unroll") for (int k = 0; k < 2; ++k) dst[n][k] = *(const LAS bf16x8*)(lds + PG8_SB(b, h) + boff + n * 2048 + k * 1024); } while (0)
#define PG8_MMA(ai, bj, At, Bt) do { __builtin_amdgcn_s_setprio(1); _Pragma("unroll") for (int m = 0; m < 4; ++m) _Pragma("unroll") for (int n = 0; n < 2; ++n) _Pragma("unroll") for (int k = 0; k < 2; ++k) \
        acc[ai][bj][m][n] = __builtin_amdgcn_mfma_f32_16x16x32_bf16(Bt[n][k], At[m][k], acc[ai][bj][m][n], 0, 0, 0); __builtin_amdgcn_s_setprio(0); } while (0)
#define PG8_WAIT_V(n) asm volatile("s_waitcnt vmcnt(" #n ")" ::: "memory")
#define PG8_WAIT_L(n) asm volatile("s_waitcnt lgkmcnt(" #n ")" ::: "memory")
#define PG8_BAR __builtin_amdgcn_s_barrier()
#define PG8_SCHED __builtin_amdgcn_sched_barrier(0)
    Unit cur, nxt; int ui = 0;
    if (!S.next(0, cur)) return;
    f32x4 acc[2][2][4][2];
#pragma unroll
    for (int a = 0; a < 2; ++a)
#pragma unroll
        for (int b = 0; b < 2; ++b)
#pragma unroll
            for (int m = 0; m < 4; ++m)
#pragma unroll
                for (int n = 0; n < 2; ++n) acc[a][b][m][n] = (f32x4){0.f, 0.f, 0.f, 0.f};
    bf16x8 At[4][2], B0[2][2], B1[2][2];
    const char* cA = (const char*)g.A + (size_t)cur.pm * tstep; const char* cB = (const char*)g.Bt + cur.boff + (size_t)cur.pn * tstep;
    PG8_STAGE(PG8_SB(0, 0), cB); PG8_STAGE(PG8_SB(0, 1), cB + hstep); PG8_STAGE(PG8_SA(0, 0), cA); PG8_STAGE(PG8_SA(0, 1), cA + hstep);
    if (wr == 1) PG8_BAR;
    PG8_WAIT_V(2); PG8_BAR;
    PG8_STAGE(PG8_SB(1, 0), cB + kstep); PG8_STAGE(PG8_SA(1, 0), cA + kstep); PG8_STAGE(PG8_SB(1, 1), cB + hstep + kstep);
    PG8_WAIT_V(6); PG8_BAR;
    for (;;) {
        const bool has_next = S.next(ui + 1, nxt);
        const char* nA = has_next ? (const char*)g.A + (size_t)nxt.pm * tstep : cA; const char* nB = has_next ? (const char*)g.Bt + nxt.boff + (size_t)nxt.pn * tstep : cB;
        for (int t = 0; t < nt; t += 2) {
            const bool last = (t == nt - 2);
            const char* a1 = cA + (size_t)(t + 1) * kstep;
            const char* a2 = last ? nA : cA + (size_t)(t + 2) * kstep; const char* b2 = last ? nB : cB + (size_t)(t + 2) * kstep;
            const char* a3 = a2 + kstep; const char* b3 = b2 + kstep;
            PG8_LDB(B0, 0, 0); PG8_LDB(B1, 0, 1); PG8_SCHED; PG8_LDA(At, 0, 0); PG8_STAGE(PG8_SA(1, 1), a1 + hstep);
            PG8_WAIT_V(8); PG8_WAIT_L(0); PG8_BAR; PG8_MMA(0, 0, At, B0); PG8_MMA(0, 1, At, B1); PG8_BAR; PG8_SCHED;
            PG8_LDA(At, 0, 1); PG8_STAGE(PG8_SB(0, 0), b2); PG8_STAGE(PG8_SB(0, 1), b2 + hstep); PG8_STAGE(PG8_SA(0, 0), a2);
            PG8_WAIT_V(8); PG8_WAIT_L(0); PG8_BAR; PG8_MMA(1, 0, At, B0); PG8_MMA(1, 1, At, B1); PG8_BAR; PG8_SCHED;
            PG8_LDB(B0, 1, 0); PG8_LDB(B1, 1, 1); PG8_SCHED; PG8_LDA(At, 1, 0); PG8_STAGE(PG8_SA(0, 1), a2 + hstep);
            PG8_WAIT_V(8); PG8_WAIT_L(0); PG8_BAR; PG8_MMA(0, 0, At, B0); PG8_MMA(0, 1, At, B1); PG8_BAR; PG8_SCHED;
            PG8_LDA(At, 1, 1); PG8_STAGE(PG8_SB(1, 0), b3); PG8_STAGE(PG8_SB(1, 1), b3 + hstep); PG8_STAGE(PG8_SA(1, 0), a3);
            PG8_WAIT_V(8); PG8_WAIT_L(0); PG8_BAR; PG8_MMA(1, 0, At, B0); PG8_MMA(1, 1, At, B1); PG8_BAR; PG8_SCHED;
        }
        if (wr == 0) PG8_BAR;
        { int lz = lane_id(); asm volatile("" : "+v"(lz)); E(acc, cur, wid >> 2, wid & 3, lz & 15, lz >> 4); }
        if (!has_next) break;
        { float z0 = 0.f; asm volatile("" : "+v"(z0));
#pragma unroll
        for (int a = 0; a < 2; ++a)
#pragma unroll
            for (int b = 0; b < 2; ++b)
#pragma unroll
                for (int m = 0; m < 4; ++m)
#pragma unroll
                    for (int n = 0; n < 2; ++n) acc[a][b][m][n] = (f32x4){z0, z0, z0, z0}; }
        cur = nxt; cA = nA; cB = nB; ++ui;
        if (wr == 1) PG8_BAR;
    }
    PG8_WAIT_V(0);
    PG8_BAR;
#undef PG8_SA
#undef PG8_SB
#undef PG8_STAGE
#undef PG8_LDA
#undef PG8_LDB
#undef PG8_MMA
#undef PG8_WAIT_V
#undef PG8_WAIT_L
#undef PG8_BAR
#undef PG8_SCHED
}

typedef int i32x8 __attribute__((ext_vector_type(8)));
typedef int i32x4 __attribute__((ext_vector_type(4)));
__device__ __forceinline__ i32x8 ld32(const LAS unsigned char* p) { const i32x4 a = *(const LAS i32x4*)p, b = *(const LAS i32x4*)(p + 1024); return __builtin_shufflevector(a, b, 0, 1, 2, 3, 4, 5, 6, 7); }
template <bool NARROW = false, class Epi, class Sched>
__device__ __forceinline__ void gemm_phase8(LAS unsigned char* lds, const Gemm g, const Sched& S, const Epi& E, const int wid) {
    int lane = lane_id(); asm volatile("" : "+v"(lane));
    const int tid = wid * 64 + lane, wr = wid >> 2, wc = wid & 3, fr = lane & 15, fq = lane >> 4;
    const int K = g.K, nt = K / BK;
    unsigned voffA; { int R, C; stage_rc(tid * 16, R, C); voffA = (unsigned)(R * K + C) * 2u; }
    const size_t rstep = (size_t)64 * K * 2;
    const size_t kstep = (size_t)(BK * 2);
    const size_t hstep = (size_t)HALF * K * 2;
    const size_t tstep = 2 * hstep;
    const size_t bh = NARROW ? 0 : hstep;
    const unsigned ldsb = (unsigned)(unsigned long)lds + (unsigned)wid * 1024u;
    const int aoff = lds_byte(wr * 64 + fr, fq * 8), boff = NARROW ? lds_byte(wc * 16 + fr, fq * 8) : lds_byte(wc * 32 + fr, fq * 8);
#define PG8_SA(b, h) (((b) * 2 + (h)) * HTB)
#define PG8_SB(b, h) ((4 + (b) * 2 + (h)) * HTB)
#define PG8_STAGE(bufoff, gbase) do { _Pragma("unroll") for (int _i = 0; _i < 2; ++_i) glds16((const char*)(gbase) + _i * rstep, voffA, ldsb + (unsigned)((bufoff) + _i * 8192)); } while (0)
#define PG8_LDA(dst, b, h) do { _Pragma("unroll") for (int m = 0; m < 4; ++m) dst[m] = ld32(lds + PG8_SA(b, h) + aoff + m * 2048); } while (0)
#define PG8_LDB(dst, b, h) do { _Pragma("unroll") for (int n = 0; n < (NARROW ? 1 : 2); ++n) dst[n] = ld32(lds + PG8_SB(b, h) + boff + n * 2048); } while (0)
#define PG8_MMA(ai, bj, At, Bt) do { __builtin_amdgcn_s_setprio(1); _Pragma("unroll") for (int m = 0; m < 4; ++m) _Pragma("unroll") for (int n = 0; n < (NARROW ? 1 : 2); ++n) \
        asm volatile("v_mfma_scale_f32_16x16x128_f8f6f4 %0, %1, %2, %0, %3, %3 op_sel_hi:[0,0,0]" : "+v"(acc[ai][bj][m][n]) : "v"(Bt[n]), "v"(At[m]), "v"(mxscale)); __builtin_amdgcn_s_setprio(0); } while (0)
#define PG8_WAIT_V(n) asm volatile("s_waitcnt vmcnt(" #n ")" ::: "memory")
#define PG8_WAIT_L(n) asm volatile("s_waitcnt lgkmcnt(" #n ")" ::: "memory")
#define PG8_BAR __builtin_amdgcn_s_barrier()
#define PG8_SCHED __builtin_amdgcn_sched_barrier(0)
    const int mxscale = 0x7F7F7F7F;
    Unit cur, nxt; int ui = 0;
    if (!S.next(0, cur)) return;
    f32x4 acc[2][2][4][2];
#pragma unroll
    for (int a = 0; a < 2; ++a)
#pragma unroll
        for (int b = 0; b < 2; ++b)
#pragma unroll
            for (int m = 0; m < 4; ++m)
#pragma unroll
                for (int n = 0; n < 2; ++n) acc[a][b][m][n] = (f32x4){0.f, 0.f, 0.f, 0.f};
    i32x8 At[4], B0[2], B1[2];
    const char* cA = (const char*)g.A + (size_t)cur.pm * tstep; const char* cB = (const char*)g.Bt + cur.boff + (size_t)cur.pn * tstep;
    PG8_STAGE(PG8_SB(0, 0), cB); PG8_STAGE(PG8_SB(0, 1), cB + bh); PG8_STAGE(PG8_SA(0, 0), cA); PG8_STAGE(PG8_SA(0, 1), cA + hstep);
    if (wr == 1) PG8_BAR;
    PG8_WAIT_V(2); PG8_BAR;
    PG8_STAGE(PG8_SB(1, 0), cB + kstep); PG8_STAGE(PG8_SA(1, 0), cA + kstep); PG8_STAGE(PG8_SB(1, 1), cB + bh + kstep);
    PG8_WAIT_V(6); PG8_BAR;
    for (;;) {
        const bool has_next = S.next(ui + 1, nxt);
        const char* nA = has_next ? (const char*)g.A + (size_t)nxt.pm * tstep : cA; const char* nB = has_next ? (const char*)g.Bt + nxt.boff + (size_t)nxt.pn * tstep : cB;
        for (int t = 0; t < nt; t += 2) {
            const bool last = (t == nt - 2);
            const char* a1 = cA + (size_t)(t + 1) * kstep;
            const char* a2 = last ? nA : cA + (size_t)(t + 2) * kstep; const char* b2 = last ? nB : cB + (size_t)(t + 2) * kstep;
            const char* a3 = a2 + kstep; const char* b3 = b2 + kstep;
            PG8_LDB(B0, 0, 0); if constexpr (!NARROW) PG8_LDB(B1, 0, 1); PG8_SCHED; PG8_LDA(At, 0, 0); PG8_STAGE(PG8_SA(1, 1), a1 + hstep);
            PG8_WAIT_V(8); PG8_WAIT_L(0); PG8_BAR; PG8_MMA(0, 0, At, B0); if constexpr (!NARROW) PG8_MMA(0, 1, At, B1); PG8_BAR; PG8_SCHED;
            PG8_LDA(At, 0, 1); PG8_STAGE(PG8_SB(0, 0), b2); PG8_STAGE(PG8_SB(0, 1), b2 + bh); PG8_STAGE(PG8_SA(0, 0), a2);
            PG8_WAIT_V(8); PG8_WAIT_L(0); PG8_BAR; PG8_MMA(1, 0, At, B0); if constexpr (!NARROW) PG8_MMA(1, 1, At, B1); PG8_BAR; PG8_SCHED;
            PG8_LDB(B0, 1, 0); if constexpr (!NARROW) PG8_LDB(B1, 1, 1); PG8_SCHED; PG8_LDA(At, 1, 0); PG8_STAGE(PG8_SA(0, 1), a2 + hstep);
            PG8_WAIT_V(8); PG8_WAIT_L(0); PG8_BAR; PG8_MMA(0, 0, At, B0); if constexpr (!NARROW) PG8_MMA(0, 1, At, B1); PG8_BAR; PG8_SCHED;
            PG8_LDA(At, 1, 1); PG8_STAGE(PG8_SB(1, 0), b3); PG8_STAGE(PG8_SB(1, 1), b3 + bh); PG8_STAGE(PG8_SA(1, 0), a3);
            PG8_WAIT_V(8); PG8_WAIT_L(0); PG8_BAR; PG8_MMA(1, 0, At, B0); if constexpr (!NARROW) PG8_MMA(1, 1, At, B1); PG8_BAR; PG8_SCHED;
        }
        if (wr == 0) PG8_BAR;
        asm volatile("s_nop 15\n\ts_nop 15" ::: "memory");
        { int lz = lane_id(); asm volatile("" : "+v"(lz)); E(acc, cur, wid >> 2, wid & 3, lz & 15, lz >> 4); }
        if (!has_next) break;
        { float z0 = 0.f; asm volatile("" : "+v"(z0));
#pragma unroll
        for (int a = 0; a < 2; ++a)
#pragma unroll
            for (int b = 0; b < 2; ++b)
#pragma unroll
                for (int m = 0; m < 4; ++m)
#pragma unroll
                    for (int n = 0; n < 2; ++n) acc[a][b][m][n] = (f32x4){z0, z0, z0, z0}; }
        cur = nxt; cA = nA; cB = nB; ++ui;
        if (wr == 1) PG8_BAR;
    }
    PG8_WAIT_V(0);
    PG8_BAR;
#undef PG8_SA
#undef PG8_SB
#undef PG8_STAGE
#undef PG8_LDA
#undef PG8_LDB
#undef PG8_MMA
#undef PG8_WAIT_V
#undef PG8_WAIT_L
#undef PG8_BAR
#undef PG8_SCHED
}

struct EpiBf16Perm {
    bf16* O; int ldc;
    __device__ __forceinline__ void operator()(const f32x4 (&acc)[2][2][4][2], const Unit& u, int wr, int wc, int fr, int fq) const {
        const int row0 = u.pm * BM + wr * 64 + fr, col0 = u.pn * BM + wc * 32 + 8 * fq;
#pragma unroll
        for (int ai = 0; ai < 2; ++ai)
#pragma unroll
            for (int m = 0; m < 4; ++m) { bf16* rowp = O + (size_t)(row0 + ai * HALF + m * 16) * ldc + col0;
#pragma unroll
                for (int bj = 0; bj < 2; ++bj) { const f32x4 v0 = acc[ai][bj][m][0], v1 = acc[ai][bj][m][1];
                    u32x4 w; w.x = pk_bf16(v0[0], v0[1]); w.y = pk_bf16(v0[2], v0[3]); w.z = pk_bf16(v1[0], v1[1]); w.w = pk_bf16(v1[2], v1[3]);
                    *(u32x4*)(rowp + bj * HALF) = w; } }
    }
};
struct EpiSwiglu {
    bf16* O; int ldo;
    __device__ __forceinline__ void operator()(const f32x4 (&acc)[2][2][4][2], const Unit& u, int wr, int wc, int fr, int fq) const {
        const int row0 = u.pm * BM + wr * 64 + fr, col0 = u.pn * HALF + wc * 16 + 4 * fq;
#pragma unroll
        for (int ai = 0; ai < 2; ++ai)
#pragma unroll
            for (int m = 0; m < 4; ++m) { bf16* rowp = O + (size_t)(row0 + ai * HALF + m * 16) * ldo + col0;
#pragma unroll
                for (int bj = 0; bj < 2; ++bj) { const f32x4 a = acc[ai][bj][m][0], b = acc[ai][bj][m][1];
                    u32x2 w; w.x = pk_bf16(siluf_(a[0]) * b[0], siluf_(a[1]) * b[1]); w.y = pk_bf16(siluf_(a[2]) * b[2], siluf_(a[3]) * b[3]);
                    *(u32x2*)(rowp + bj * 64) = w; } }
    }
};
DI unsigned pk4_fp8(float a, float b, float c, float d) {
    float cm = 448.f; asm volatile("" : "+s"(cm));
    a = __builtin_amdgcn_fmed3f(a, -cm, cm); b = __builtin_amdgcn_fmed3f(b, -cm, cm); c = __builtin_amdgcn_fmed3f(c, -cm, cm); d = __builtin_amdgcn_fmed3f(d, -cm, cm);
    int w = __builtin_amdgcn_cvt_pk_fp8_f32(a, b, 0, false); w = __builtin_amdgcn_cvt_pk_fp8_f32(c, d, w, true); return (unsigned)w; }
struct EpiSwiglu8 {
    unsigned char* O; int ldo; float inv, oscale;
    __device__ __forceinline__ void operator()(const f32x4 (&acc)[2][2][4][2], const Unit& u, int wr, int wc, int fr, int fq) const {
        const int row0 = u.pm * BM + wr * 64 + fr, col0 = u.pn * HALF + wc * 16 + 4 * fq;
#pragma unroll
        for (int ai = 0; ai < 2; ++ai)
#pragma unroll
            for (int m = 0; m < 4; ++m) { unsigned char* rowp = O + (size_t)(row0 + ai * HALF + m * 16) * ldo + col0;
#pragma unroll
                for (int bj = 0; bj < 2; ++bj) { const f32x4 a = acc[ai][bj][m][0] * inv, b = acc[ai][bj][m][1] * (inv * oscale);
                    *(unsigned*)(rowp + bj * 64) = pk4_fp8(siluf_(a[0]) * b[0], siluf_(a[1]) * b[1], siluf_(a[2]) * b[2], siluf_(a[3]) * b[3]); } }
    }
};
struct EpiGlu {
    float* O; const float* bias;
    __device__ __forceinline__ void operator()(const f32x4 (&acc)[2][2][4][2], const Unit& u, int wr, int wc, int fr, int fq) const {
        const int row0 = u.pm * BM + wr * 64 + fr, col0 = u.pn * HALF + wc * 16 + 4 * fq;
        f32x4 bv[2], bg[2];
#pragma unroll
        for (int bj = 0; bj < 2; ++bj) { bv[bj] = *(const f32x4*)(bias + col0 + bj * 64); bg[bj] = *(const f32x4*)(bias + 512 + col0 + bj * 64); }
#pragma unroll
        for (int ai = 0; ai < 2; ++ai)
#pragma unroll
            for (int m = 0; m < 4; ++m) { float* rowp = O + (size_t)(row0 + ai * HALF + m * 16) * 512 + col0;
#pragma unroll
                for (int bj = 0; bj < 2; ++bj) { const f32x4 a = acc[ai][bj][m][0] + bv[bj], b = acc[ai][bj][m][1] + bg[bj];
                    f32x4 o; o[0] = a[0] * sigmoidf_(b[0]); o[1] = a[1] * sigmoidf_(b[1]); o[2] = a[2] * sigmoidf_(b[2]); o[3] = a[3] * sigmoidf_(b[3]);
                    *(f32x4*)(rowp + bj * 64) = o; } }
    }
};
struct EpiResid {
    float* O; const float* X; const float* gate; float scale;
    __device__ __forceinline__ void operator()(const f32x4 (&acc)[2][2][4][2], const Unit& u, int wr, int wc, int fr, int fq) const {
        const int row0 = u.pm * BM + wr * 64 + fr, col0 = u.pn * BM + wc * 32 + 4 * fq;
        const float* gp = gate + (size_t)(u.pm >> 3) * (NADA * DM) + col0;
        f32x4 gv[2][2];
#pragma unroll
        for (int bj = 0; bj < 2; ++bj)
#pragma unroll
            for (int n = 0; n < 2; ++n) gv[bj][n] = *(const f32x4*)(gp + bj * HALF + n * 16) * scale;
#pragma unroll
        for (int ai = 0; ai < 2; ++ai)
#pragma unroll
            for (int m = 0; m < 4; ++m) { const size_t off = (size_t)(row0 + ai * HALF + m * 16) * DM + col0;
#pragma unroll
                for (int bj = 0; bj < 2; ++bj)
#pragma unroll
                    for (int n = 0; n < 2; ++n) { const f32x4 xv = *(const f32x4*)(X + off + bj * HALF + n * 16);
                        *(f32x4*)(O + off + bj * HALF + n * 16) = xv + gv[bj][n] * acc[ai][bj][m][n]; } }
    }
};
struct EpiOut {
    float* O; const float* X; const float* gate; float scale;
    __device__ __forceinline__ void operator()(const f32x4 (&acc)[2][2][4][2], const Unit& u, int wr, int wc, int fr, int fq) const {
        const int row0 = u.pm * BM + wr * 64 + fr, col0 = u.pn * BM + wc * 32 + 4 * fq;
        f32x4 gv[2][2];
        if (X) { const float* gp = gate + (size_t)(u.pm >> 3) * (NADA * DM) + col0;
#pragma unroll
            for (int bj = 0; bj < 2; ++bj)
#pragma unroll
                for (int n = 0; n < 2; ++n) gv[bj][n] = *(const f32x4*)(gp + bj * HALF + n * 16) * scale; }
        else {
#pragma unroll
            for (int bj = 0; bj < 2; ++bj)
#pragma unroll
                for (int n = 0; n < 2; ++n) gv[bj][n] = (f32x4){scale, scale, scale, scale}; }
#pragma unroll
        for (int ai = 0; ai < 2; ++ai)
#pragma unroll
            for (int m = 0; m < 4; ++m) { const size_t off = (size_t)(row0 + ai * HALF + m * 16) * DM + col0;
#pragma unroll
                for (int bj = 0; bj < 2; ++bj)
#pragma unroll
                    for (int n = 0; n < 2; ++n) { f32x4 o = gv[bj][n] * acc[ai][bj][m][n]; if (X) o += *(const f32x4*)(X + off + bj * HALF + n * 16);
                        *(f32x4*)(O + off + bj * HALF + n * 16) = o; } }
    }
};
struct EpiF32 {
    float* O; int ldc; float scale;
    __device__ __forceinline__ void operator()(const f32x4 (&acc)[2][2][4][2], const Unit& u, int wr, int wc, int fr, int fq) const {
        const int row0 = u.pm * BM + wr * 64 + fr, col0 = u.pn * BM + wc * 32 + 4 * fq;
#pragma unroll
        for (int ai = 0; ai < 2; ++ai)
#pragma unroll
            for (int m = 0; m < 4; ++m) { float* rowp = O + (size_t)(row0 + ai * HALF + m * 16) * ldc + col0;
#pragma unroll
                for (int bj = 0; bj < 2; ++bj)
#pragma unroll
                    for (int n = 0; n < 2; ++n) *(f32x4*)(rowp + bj * HALF + n * 16) = acc[ai][bj][m][n] * scale; }
    }
};
struct EpiF32Narrow {
    float* O; int ldc; float scale;
    __device__ __forceinline__ void operator()(const f32x4 (&acc)[2][2][4][2], const Unit& u, int wr, int wc, int fr, int fq) const {
        const int row0 = u.pm * BM + wr * 64 + fr, col0 = u.pn * BM + 64 * u.q + wc * 16 + 4 * fq;
#pragma unroll
        for (int ai = 0; ai < 2; ++ai)
#pragma unroll
            for (int m = 0; m < 4; ++m) *(f32x4*)(O + (size_t)(row0 + ai * HALF + m * 16) * ldc + col0) = acc[ai][0][m][0] * scale;
    }
};
}

struct Args { const float* in[38]; float* out; unsigned char* ws; unsigned long long hoff, hbytes; int ph_lo, ph_hi, li, pad; };
enum { I_X = 0, I_C, I_ADAW, I_ADAB, I_NMIXG, I_NFFNG, I_WIN, I_S5ARE, I_S5AIM, I_S5LOGDT, I_S5BRE, I_S5BIM, I_S5CRE, I_S5CIM, I_S5D, I_S5WGLU, I_S5BGLU, I_S5NG,
       I_LCONVW, I_LCONVB, I_LWA, I_LBA, I_LWX, I_LBX, I_LLAM, I_LNG, I_GWG2, I_GBG2, I_GHG, I_WOUT, I_F1, I_F3, I_F2, I_ROUTER, I_M1, I_M3, I_M2, I_FNG };

#define GAS __attribute__((address_space(1)))
template <class T> DI T* as_global(T* p) { return (T*)(GAS T*)p; }
DI const float* INP(const Args& a, int i) { asm volatile("" : "+s"(i)); return as_global(a.in[i]); }
struct Frame {
    LAS unsigned char* lds;
    volatile LAS unsigned* MISC;
    unsigned* ctl;
    GAS unsigned char* ws;
    int tid, lane, wave, G, bid;
};

DI void conv_item(const float* src0, const float* src1, int ldsrc, int K, bf16* dst, int kb, int pb, int mode, LAS float* scr, int lane) {
    const int p = pb * 64 + lane, g = p >> 5, rho = p & 31, n = rho >> 4, i = rho & 15;
    const float* sp = src0; bool valid = true;
    if (mode == 0) sp = src0 + p;
    else if (mode == 1) { const int lc = (g << 5) + pg8::perm32(rho); const int sc = lc < 3584 ? lc : (lc < 4352 ? lc + 16 : (lc < 4368 ? lc - 4352 + 3584 : -1)); valid = sc >= 0; sp = src0 + (valid ? sc : 0); }
    else if (mode == 2) sp = (n ? src1 : src0) + 16 * g + i;
    else sp = src0 + n * 512 + 16 * g + i;
    const int k0 = kb * 64;
    sp += (size_t)k0 * ldsrc;
#pragma unroll 16
    for (int kk = 0; kk < 64; ++kk) { const float v = valid ? sp[(size_t)kk * ldsrc] : 0.f; scr[kk * 65 + lane] = v; }
    LDS_WAIT();
    const int c = lane & 7;
#pragma unroll
    for (int j = 0; j < 8; ++j) { const int rr = (lane >> 3) + 8 * j; const LAS float* s = scr + (8 * c) * 65 + rr;
        u32x4 o; o.x = pk_bf16(s[0 * 65], s[1 * 65]); o.y = pk_bf16(s[2 * 65], s[3 * 65]); o.z = pk_bf16(s[4 * 65], s[5 * 65]); o.w = pk_bf16(s[6 * 65], s[7 * 65]);
        *(u32x4*)(dst + (size_t)(pb * 64 + rr) * K + k0 + 8 * c) = o; }
    LDS_WAIT();
}

template <bool GATED>
DI void conv_item8(const float* src0, const float* src1, int ldsrc, int K8, unsigned char* dst, int kb, int cb, float scale, LAS unsigned* scr, int lane) {
    constexpr int NC = GATED ? 128 : 64, ST = NC + 1;
    const int k0 = kb * 128;
    const float* p0 = src0 + (size_t)k0 * ldsrc + 64 * cb + lane;
    const float* p1 = GATED ? src1 + (size_t)k0 * ldsrc + 64 * cb + lane : src0;
#pragma unroll 4
    for (int kq = 0; kq < 32; ++kq) {
        const float* r0 = p0 + (size_t)(4 * kq) * ldsrc;
        scr[kq * ST + lane] = pg8::pk4_fp8(r0[0] * scale, r0[ldsrc] * scale, r0[2 * (size_t)ldsrc] * scale, r0[3 * (size_t)ldsrc] * scale);
        if (GATED) { const float* r1 = p1 + (size_t)(4 * kq) * ldsrc;
            scr[kq * ST + 64 + lane] = pg8::pk4_fp8(r1[0] * scale, r1[ldsrc] * scale, r1[2 * (size_t)ldsrc] * scale, r1[3 * (size_t)ldsrc] * scale); }
    }
    LDS_WAIT();
    const int c = lane & 7;
#pragma unroll
    for (int j = 0; j < NC / 8; ++j) { const int rr = (lane >> 3) + 8 * j;
        const int col = GATED ? (((rr >> 4) & 1) * 64 + (rr >> 5) * 16 + (rr & 15)) : rr;
        const LAS unsigned* q = scr + (4 * c) * ST + col;
        u32x4 o; o.x = q[0]; o.y = q[ST]; o.z = q[2 * ST]; o.w = q[3 * ST];
        *(u32x4*)(dst + (size_t)(NC * cb + rr) * K8 + k0 + 16 * c) = o; }
    LDS_WAIT();
}

DI void sincos_d(double x, double& s, double& c) {
    const double k = rint(x * 0.63661977236758134308);
    const double r = fma(-k, 6.123233995736766e-17, fma(-k, 1.5707963267948966, x));
    const double r2 = r * r;
    double sp = -1.0 / 1307674368000.0;
    sp = fma(sp, r2, 1.0 / 6227020800.0); sp = fma(sp, r2, -1.0 / 39916800.0); sp = fma(sp, r2, 1.0 / 362880.0); sp = fma(sp, r2, -1.0 / 5040.0); sp = fma(sp, r2, 1.0 / 120.0); sp = fma(sp, r2, -1.0 / 6.0); sp = fma(sp, r2, 1.0);
    const double sr = sp * r;
    double cp = 1.0 / 20922789888000.0;
    cp = fma(cp, r2, -1.0 / 87178291200.0); cp = fma(cp, r2, 1.0 / 479001600.0); cp = fma(cp, r2, -1.0 / 3628800.0); cp = fma(cp, r2, 1.0 / 40320.0); cp = fma(cp, r2, -1.0 / 720.0); cp = fma(cp, r2, 1.0 / 24.0); cp = fma(cp, r2, -0.5); cp = fma(cp, r2, 1.0);
    const int q = ((int)k) & 3;
    s = (q == 0) ? sr : (q == 1) ? cp : (q == 2) ? -sr : -cp;
    c = (q == 0) ? cp : (q == 1) ? -sr : (q == 2) ? -cp : sr;
}

DI void p0_s5_consts(const Frame& F, const Args& a) {
    const int gt = F.bid * NTHREADS + F.tid;
    if (gt >= DEPTH * 32 * 64) return;
    const int l = gt >> 11, g = (gt >> 6) & 31, p = gt & 63;
    unsigned char* base = (unsigned char*)(F.ws + WS_S5C + (size_t)l * S5C_STRIDE);
    const double ar = INP(a, I_S5ARE)[(l * 32 + g) * 64 + p], ai = INP(a, I_S5AIM)[(l * 32 + g) * 64 + p];
    const double dt = exp((double)INP(a, I_S5LOGDT)[l * 32 + g]);
    const double mag = exp(ar * dt); double sn, cs; sincos_d(ai * dt, sn, cs);
    const double abr = mag * cs, abi = mag * sn;
    const double nr = abr - 1.0, ni = abi, den = ar * ar + ai * ai;
    const double fre = (nr * ar + ni * ai) / den, fim = (ni * ar - nr * ai) / den;
    float* abar = (float*)(base + S5C_ABAR); abar[(g * 64 + p) * 2] = (float)abr; abar[(g * 64 + p) * 2 + 1] = (float)abi;
    double pr = abr, pi = abi;
#pragma unroll
    for (int s = 0; s < 6; ++s) { const double tr = pr * pr - pi * pi, ti = 2.0 * pr * pi; pr = tr; pi = ti; }
    float* abarL = (float*)(base + S5C_ABARL); abarL[(g * 64 + p) * 2] = (float)pr; abarL[(g * 64 + p) * 2 + 1] = (float)pi;
    bf16* bbar = (bf16*)(base + S5C_BBAR);
    const float* bre = INP(a, I_S5BRE) + ((size_t)(l * 32 + g) * 64 + p) * 16; const float* bim = INP(a, I_S5BIM) + ((size_t)(l * 32 + g) * 64 + p) * 16;
#pragma unroll
    for (int c = 0; c < 16; ++c) { const double br = bre[c], bi = bim[c];
        bbar[((size_t)g * 128 + p) * 16 + c] = f2bf((float)(fre * br - fim * bi));
        bbar[((size_t)g * 128 + 64 + p) * 16 + c] = f2bf((float)(fre * bi + fim * br)); }
    bf16* cmat = (bf16*)(base + S5C_CMAT);
    const float* cre = INP(a, I_S5CRE) + (size_t)(l * 32 + g) * 16 * 64; const float* cim = INP(a, I_S5CIM) + (size_t)(l * 32 + g) * 16 * 64;
#pragma unroll
    for (int c = 0; c < 16; ++c) { cmat[((size_t)g * 16 + c) * 128 + p] = f2bf(cre[c * 64 + p]); cmat[((size_t)g * 16 + c) * 128 + 64 + p] = f2bf(-cim[c * 64 + p]); }
}
DI void p0_lru_w(const Frame& F, const Args& a) {
    const int total = DEPTH * 2 * 8 * 96 * 96;
    const float* pwa = INP(a, I_LWA); const float* pwx = INP(a, I_LWX);
    for (int idx = F.bid * NTHREADS + F.tid; idx < total; idx += F.G * NTHREADS) {
        int r = idx; const int i = r % 96; r /= 96; const int j = r % 96; r /= 96; const int h = r % 8; r /= 8; const int which = r & 1, l = r >> 1;
        const float* src = (which ? pwx : pwa) + (((size_t)l * 8 + h) * 96 + i) * 96 + j;
        bf16* dst = (bf16*)(F.ws + WS_LRUW + (size_t)l * LRUW_STRIDE + (which ? LRUW_X : 0));
        dst[((size_t)h * 96 + j) * 96 + i] = f2bf(*src);
    }
}
DI void p0_ada(const Frame& F, const Args& a) {
    LAS float* red = (LAS float*)F.lds;
    const int cq = F.lane & 15, kr = F.lane >> 4;
    for (int task = F.bid; task < DEPTH * 192; task += F.G) {
        const int l = task / 192, cg = task % 192;
        const float* W = INP(a, I_ADAW) + (size_t)l * DM * (NADA * DM) + 64 * cg + 4 * cq;
        const float* cin = INP(a, I_C);
        f32x4 acc[4];
#pragma unroll
        for (int b = 0; b < 4; ++b) acc[b] = (f32x4){0.f, 0.f, 0.f, 0.f};
#pragma unroll 4
        for (int it = 0; it < 64; ++it) { const int k = 256 * F.wave + 4 * it + kr;
            const f32x4 wv = *(const f32x4*)(W + (size_t)k * (NADA * DM));
#pragma unroll
            for (int b = 0; b < 4; ++b) { const float cs = siluf_(cin[b * DM + k]); acc[b] += cs * wv; } }
#pragma unroll
        for (int b = 0; b < 4; ++b)
#pragma unroll
            for (int e = 0; e < 4; ++e) acc[b][e] = xor_add<16>(acc[b][e]);
        if ((kr & 1) == 0) {
#pragma unroll
            for (int b = 0; b < 4; ++b) *(LAS f32x4*)(red + ((F.wave * 2 + (kr >> 1)) * 4 + b) * 64 + 4 * cq) = acc[b]; }
        __syncthreads();
        if (F.tid < 256) { const int b = F.tid >> 6, col = F.tid & 63; float s = INP(a, I_ADAB)[(size_t)l * (NADA * DM) + 64 * cg + col];
#pragma unroll
            for (int w = 0; w < 16; ++w) s += red[(w * 4 + b) * 64 + col];
            ((float*)(F.ws + WS_MOD))[((size_t)l * 4 + b) * (NADA * DM) + 64 * cg + col] = s; }
        __syncthreads();
    }
}
DI void p0_convert(const Frame& F, const Args& a) {
    LAS float* scr = (LAS float*)(F.lds + F.wave * 16896);
    const int gw = F.bid * NWAVES + F.wave, NGW = F.G * NWAVES;
    constexpr int I_WIN_ = 32 * 72, I_WOUT_ = 32 * 32, I_GLU_ = 8 * 16, I_F13_ = 32 * 176, I_F2_ = 44 * 32, I_M13_ = 16 * 112, I_M2_ = 56 * 32;
    constexpr int TOTAL = 2 * I_WIN_ + 2 * I_WOUT_ + 2 * I_GLU_ + I_F13_ + I_F2_ + 8 * I_M13_ + 8 * I_M2_;
    for (int it = gw; it < TOTAL; it += NGW) {
        int r = it;
        if (r < 2 * I_WIN_) { const int l = r / I_WIN_; r %= I_WIN_; conv_item(INP(a, I_WIN) + (size_t)l * DM * DIN_SRC, nullptr, DIN_SRC, DM, (bf16*)(F.ws + WS_WIN) + (size_t)l * PROJ_LD * DM, r / 72, r % 72, 1, scr, F.lane); continue; } r -= 2 * I_WIN_;
        if (r < 2 * I_WOUT_) { const int l = r / I_WOUT_; r %= I_WOUT_; conv_item(INP(a, I_WOUT) + (size_t)l * DM * DM, nullptr, DM, DM, (bf16*)(F.ws + WS_WOUT) + (size_t)l * DM * DM, r / 32, r % 32, 0, scr, F.lane); continue; } r -= 2 * I_WOUT_;
        if (r < 2 * I_GLU_) { const int l = r / I_GLU_; r %= I_GLU_; conv_item(INP(a, I_S5WGLU) + (size_t)l * 512 * 1024, nullptr, 1024, 512, (bf16*)(F.ws + WS_WGLU) + (size_t)l * 1024 * 512, r / 16, r % 16, 3, scr, F.lane); continue; } r -= 2 * I_GLU_;
        if (r < I_F13_) { conv_item(INP(a, I_F1), INP(a, I_F3), DFF, DM, (bf16*)(F.ws + WS_F13), r / 176, r % 176, 2, scr, F.lane); continue; } r -= I_F13_;
        if (r < I_F2_) { conv_item8<false>(INP(a, I_F2), nullptr, DM, DFF, (unsigned char*)(F.ws + WS_F2), r / 32, r % 32, SC_W2, (LAS unsigned*)scr, F.lane); continue; } r -= I_F2_;
        if (r < 8 * I_M13_) { const int e = r / I_M13_; r %= I_M13_; conv_item8<true>(INP(a, I_M1) + (size_t)e * DM * DFFE, INP(a, I_M3) + (size_t)e * DM * DFFE, DFFE, DM, (unsigned char*)(F.ws + WS_M13 + (size_t)e * 2 * DFFE * DM), 8 * ((r >> 3) / 112) + (r & 7), (r >> 3) % 112, SC_W13, (LAS unsigned*)scr, F.lane);     continue; } r -= 8 * I_M13_;
        { const int e = r / I_M2_; r %= I_M2_; conv_item8<false>(INP(a, I_M2) + (size_t)e * DFFE * DM, nullptr, DM, DFFE, (unsigned char*)(F.ws + WS_M2 + (size_t)e * DM * DFFE), 8 * ((r >> 3) / 32) + (r & 7), (r >> 3) % 32, SC_W2, (LAS unsigned*)scr, F.lane); }
    }
}

template <bool ROUTER, bool OUT8>
DI void norm_phase(const Frame& F, const Args& a, const float* xin, const float* g, const float* mod  , int shift_idx, int scale_idx, const float* wrouter) {
    bf16* H = (bf16*)(F.ws + WS_H);
    LAS float* wr = (LAS float*)F.lds;
    volatile LAS unsigned* bcnt = F.MISC + 32;
    LAS unsigned* rows = (LAS unsigned*)(F.lds + 65536);
    if (ROUTER) {
        for (int i0 = F.tid; i0 < DM * NE; i0 += 8 * NTHREADS) { float w8[8];
#pragma unroll
            for (int q = 0; q < 8; ++q) w8[q] = wrouter[i0 + NTHREADS * q];
#pragma unroll
            for (int q = 0; q < 8; ++q) { const int i = i0 + NTHREADS * q, d = i >> 3, e = i & 7; wr[e * DM + d] = w8[q]; } }
        if (F.tid < 8) bcnt[F.tid] = 0u;
        __syncthreads();
    }
    const int gw = F.bid * NWAVES + F.wave;
    int rslot = 0;
    f32x4 vnx[8];
    if (gw < T) {
#pragma unroll
        for (int j = 0; j < 8; ++j) vnx[j] = ((const f32x4*)(xin + (size_t)gw * DM) + F.lane)[64 * j]; }
    for (int row = gw; row < T; row += F.G * NWAVES, ++rslot) {
        const int b = row >> 11;
        f32x4 v[8]; float ss = 0.f;
#pragma unroll
        for (int j = 0; j < 8; ++j) v[j] = vnx[j];
        { const int rown = row + F.G * NWAVES < T ? row + F.G * NWAVES : row;
          const f32x4* xn = (const f32x4*)(xin + (size_t)rown * DM) + F.lane;
#pragma unroll
          for (int j = 0; j < 8; ++j) vnx[j] = xn[64 * j]; }
#pragma unroll
        for (int j = 0; j < 8; ++j) ss += (v[j][0] * v[j][0] + v[j][1] * v[j][1]) + (v[j][2] * v[j][2] + v[j][3] * v[j][3]);
        const float rstd = rsqrtf(wave_sum(ss) * (1.f / DM) + EPS);
        const f32x4* gp = (const f32x4*)g + F.lane; const f32x4* sc = (const f32x4*)(mod + (size_t)b * (NADA * DM) + scale_idx * DM) + F.lane; const f32x4* sh = (const f32x4*)(mod + (size_t)b * (NADA * DM) + shift_idx * DM) + F.lane;
        u32x2* o8 = (u32x2*)(H + (size_t)row * DM) + F.lane;
#pragma unroll
        for (int j = 0; j < 8; ++j) { const f32x4 gg = gp[64 * j], s1 = sc[64 * j], s0 = sh[64 * j];
            v[j] = v[j] * rstd * gg * (1.f + s1) + s0;
            if (OUT8) ((unsigned*)((unsigned char*)H + (size_t)row * DM))[F.lane + 64 * j] = pg8::pk4_fp8(v[j][0] * SC_X, v[j][1] * SC_X, v[j][2] * SC_X, v[j][3] * SC_X);
            else { u32x2 w; w.x = pk_bf16(v[j][0], v[j][1]); w.y = pk_bf16(v[j][2], v[j][3]); o8[64 * j] = w; } }
        if (ROUTER) {
            float lg[8];
#pragma unroll
            for (int e = 0; e < 8; ++e) { float s = 0.f;
#pragma unroll
                for (int j = 0; j < 8; ++j) { const f32x4 w4 = *(const LAS f32x4*)(wr + e * DM + 256 * j + 4 * F.lane); s += (v[j][0] * w4[0] + v[j][1] * w4[1]) + (v[j][2] * w4[2] + v[j][3] * w4[3]); }
                lg[e] = wave_sum(s); }
            if (F.lane == 0) {
                int e0 = 0; float v0 = lg[0];
#pragma unroll
                for (int e = 1; e < 8; ++e) if (lg[e] > v0) { v0 = lg[e]; e0 = e; }
                int e1 = -1; float v1 = -3.4e38f;
#pragma unroll
                for (int e = 0; e < 8; ++e) if (e != e0 && lg[e] > v1) { v1 = lg[e]; e1 = e; }
                const float ex = __expf(v1 - v0), g0 = 1.f / (1.f + ex), g1 = ex / (1.f + ex);
                const unsigned p0 = 0u, p1 = 0u;
                LAS unsigned* rec = rows + (F.wave * 4 + rslot) * 8;
                rec[0] = (unsigned)e0; rec[1] = (unsigned)e1; rec[2] = p0; rec[3] = p1; rec[4] = __builtin_bit_cast(unsigned, g0); rec[5] = __builtin_bit_cast(unsigned, g1);
            }
        }
    }
    if (ROUTER) {
        __syncthreads();
        if (F.tid == 0) {
            for (int r = 0; r < 32; ++r) { LAS unsigned* rec = rows + r * 8; const unsigned e0 = rec[0], e1 = rec[1];
                const unsigned q0 = bcnt[e0]; bcnt[e0] = q0 + 1u; const unsigned q1 = bcnt[e1]; bcnt[e1] = q1 + 1u; rec[2] = q0; rec[3] = q1; }
            unsigned* cb = (unsigned*)(F.ws + WS_CNTBLK) + (size_t)F.bid * 32;
            for (int e = 0; e < 8; ++e) cb[e] = bcnt[e];
        }
        __syncthreads();
        if (F.tid < 32) { LAS unsigned* rec = rows + F.tid * 8; const int w = F.tid >> 2, rs = F.tid & 3; const int row = F.bid * NWAVES + w + rs * F.G * NWAVES;
            if (row < T) { unsigned* out = (unsigned*)(F.ws + WS_ROUTE) + (size_t)row * 8;
                out[0] = rec[0]; out[1] = rec[1]; out[2] = rec[2]; out[3] = rec[3]; out[4] = rec[4]; out[5] = rec[5]; } }
        __syncthreads();
    }
}
DI void s5norm_phase(const Frame& F, const float* g) {
    const float* P = (const float*)(F.ws + WS_S5PRE); bf16* MIX = (bf16*)(F.ws + WS_MIX);
    for (int row = F.bid * NWAVES + F.wave; row < T; row += F.G * NWAVES) {
        const f32x4* xr = (const f32x4*)(P + (size_t)row * 512) + F.lane;
        f32x4 v[2]; float ss = 0.f;
#pragma unroll
        for (int j = 0; j < 2; ++j) { v[j] = xr[64 * j]; ss += (v[j][0] * v[j][0] + v[j][1] * v[j][1]) + (v[j][2] * v[j][2] + v[j][3] * v[j][3]); }
        const float rstd = rsqrtf(wave_sum(ss) * (1.f / 512.f) + EPS);
        u32x2* o8 = (u32x2*)(MIX + (size_t)row * DM) + F.lane;
#pragma unroll
        for (int j = 0; j < 2; ++j) { const f32x4 gg = ((const f32x4*)g)[F.lane + 64 * j]; v[j] = v[j] * rstd * gg;
            u32x2 w; w.x = pk_bf16(v[j][0], v[j][1]); w.y = pk_bf16(v[j][2], v[j][3]); o8[64 * j] = w; }
    }
}
DI void moe_tiles(const Frame& F) {
    LAS unsigned* tbl = (LAS unsigned*)F.lds;
    const unsigned* cb = (const unsigned*)(F.ws + WS_CNTBLK);
    __syncthreads();
    for (int i = F.tid; i < F.G * 8; i += NTHREADS) tbl[i] = cb[(i >> 3) * 32 + (i & 7)];
    __syncthreads();
    if (F.tid < 8) { unsigned tot = 0, base = 0;
        for (int b = 0; b < F.G; ++b) { if (b == F.bid) base = tot; tot += tbl[b * 8 + F.tid]; }
        F.MISC[32 + F.tid] = tot; F.MISC[40 + F.tid] = base; }
    __syncthreads();
    if (F.tid == 0) { unsigned s = 0;
        for (int e = 0; e < 8; ++e) { F.MISC[16 + e] = s; s += (F.MISC[32 + e] + 255u) >> 8; }
        F.MISC[24] = s; }
    __syncthreads();
}
DI void dense_tiles(const Frame& F) {
    __syncthreads();
    if (F.tid == 0) { F.MISC[16] = 0u; for (int e = 1; e <= 8; ++e) F.MISC[16 + e] = (unsigned)(T / 256); }
    __syncthreads();
}
DI void moe_sort_phase(const Frame& F) {
    moe_tiles(F);
    const bf16* H = (const bf16*)(F.ws + WS_H); bf16* AS = (bf16*)(F.ws + WS_AS);
    for (int row = F.bid * NWAVES + F.wave; row < T; row += F.G * NWAVES) {
        unsigned* rt = (unsigned*)(F.ws + WS_ROUTE) + (size_t)row * 8;
        const unsigned e0 = rt[0], e1 = rt[1], q0 = rt[2], q1 = rt[3];
        const unsigned p0 = F.MISC[16 + e0] * 256u + F.MISC[40 + e0] + q0, p1 = F.MISC[16 + e1] * 256u + F.MISC[40 + e1] + q1;
        const u32x4* src = (const u32x4*)((const unsigned char*)H + (size_t)row * DM) + F.lane;
        u32x4* d0 = (u32x4*)((unsigned char*)AS + (size_t)p0 * DM) + F.lane; u32x4* d1 = (u32x4*)((unsigned char*)AS + (size_t)p1 * DM) + F.lane;
#pragma unroll
        for (int j = 0; j < 2; ++j) { const u32x4 v = src[64 * j]; d0[64 * j] = v; d1[64 * j] = v; }
        if (F.lane == 0) { rt[6] = p0; rt[7] = p1; }
    }
}
DI void final_phase(const Frame& F, const Args& a, const float* mod) {
    const float* X1 = (const float*)(F.ws + WS_X1); const float* Y = (const float*)(F.ws + WS_Y);
    const f32x4* fng = (const f32x4*)INP(a, I_FNG);
    for (int row = F.bid * NWAVES + F.wave; row < T; row += F.G * NWAVES) {
        const int b = row >> 11;
        const unsigned* rt = (const unsigned*)(F.ws + WS_ROUTE) + (size_t)row * 8;
        const float g0 = __builtin_bit_cast(float, rt[4]), g1 = __builtin_bit_cast(float, rt[5]); const unsigned p0 = rt[6], p1 = rt[7];
        const f32x4* xr = (const f32x4*)(X1 + (size_t)row * DM) + F.lane; const f32x4* y0 = (const f32x4*)(Y + (size_t)p0 * DM) + F.lane; const f32x4* y1 = (const f32x4*)(Y + (size_t)p1 * DM) + F.lane;
        const f32x4* gt = (const f32x4*)(mod + (size_t)b * (NADA * DM) + 5 * DM) + F.lane;
        f32x4 v[8]; float ss = 0.f;
#pragma unroll
        for (int j = 0; j < 8; ++j) {
#if defined(DBG_ROUTE_ONLY)
            v[j] = xr[64 * j] + gt[64 * j] * (g0 * (float)(p0 % 97u) * 0.01f + g1 * (float)(p1 % 89u) * 0.01f + (float)rt[0] * 0.1f - (float)rt[1] * 0.05f);
#elif defined(DBG_SKIP_MOE)
            v[j] = xr[64 * j];
#else
            v[j] = xr[64 * j] + gt[64 * j] * (g0 * y0[64 * j] + g1 * y1[64 * j]);
#endif
            ss += (v[j][0] * v[j][0] + v[j][1] * v[j][1]) + (v[j][2] * v[j][2] + v[j][3] * v[j][3]); }
        const float rstd = rsqrtf(wave_sum(ss) * (1.f / DM) + EPS);
        f32x4* o = (f32x4*)(as_global(a.out) + (size_t)row * DM) + F.lane;
#pragma unroll
        for (int j = 0; j < 8; ++j) o[64 * j] = DBG_OUTSCALE * v[j] * rstd * fng[F.lane + 64 * j];
    }
}

template <bool FULL>
DI void s5_task(const Frame& F, const Args& a, int l, int task, LAS unsigned char* wl) {
    const int lane = F.lane, fr = lane & 15, fq = lane >> 4;
    const int b = task >> 10, g = (task >> 5) & 31, j = task & 31;
    const unsigned char* cb = (const unsigned char*)(F.ws + WS_S5C + (size_t)l * S5C_STRIDE);
    const f32x2 ab = ((const f32x2*)(cb + S5C_ABAR))[g * 64 + lane];
    const bf16* bbar = (const bf16*)(cb + S5C_BBAR) + (size_t)g * 128 * 16;
    const bf16* PJ = (const bf16*)(F.ws + WS_PROJ);
    volatile LAS float* BU = (volatile LAS float*)wl;
    bf16x8 Bf[8];
    const bf16x8 zero8 = (bf16x8){0, 0, 0, 0, 0, 0, 0, 0};
#pragma unroll
    for (int nb = 0; nb < 8; ++nb) Bf[nb] = (fq < 2) ? *(const bf16x8*)(bbar + (16 * nb + fr) * 16 + 8 * fq) : zero8;
    bf16x8 Cf[4]; float dv = 0.f;
    float hr = 0.f, hi = 0.f;
    float* E = (float*)(F.ws + WS_S5E) + (size_t)((b * 32 + g) * 32) * 128;
    if (FULL) {
        const bf16* cmat = (const bf16*)(cb + S5C_CMAT) + (size_t)g * 16 * 128;
#pragma unroll
        for (int ks = 0; ks < 4; ++ks) Cf[ks] = *(const bf16x8*)(cmat + fr * 128 + 32 * ks + 8 * fq);
        dv = INP(a, I_S5D)[l * 512 + g * 16 + fr];
        const f32x2 aL = ((const f32x2*)(cb + S5C_ABARL))[g * 64 + lane];
        int i = 0;
        for (; i + 8 <= j; i += 8) { float er[8], ei[8];
#pragma unroll
            for (int q = 0; q < 8; ++q) { er[q] = E[(i + q) * 128 + lane]; ei[q] = E[(i + q) * 128 + 64 + lane]; }
#pragma unroll
            for (int q = 0; q < 8; ++q) { const float nr = fmaf(aL[0], hr, fmaf(-aL[1], hi, er[q])), ni = fmaf(aL[0], hi, fmaf(aL[1], hr, ei[q])); hr = nr; hi = ni; } }
        for (; i < j; ++i) { const float er = E[i * 128 + lane], ei = E[i * 128 + 64 + lane];
            const float nr = fmaf(aL[0], hr, fmaf(-aL[1], hi, er)), ni = fmaf(aL[0], hi, fmaf(aL[1], hr, ei)); hr = nr; hi = ni; }
    }
    const size_t row0 = (size_t)b * SEQ + 64 * j;
    bf16x8 Afs[4];
#pragma unroll
    for (int sub = 0; sub < 4; ++sub) Afs[sub] = (fq < 2) ? *(const bf16x8*)(PJ + (row0 + 16 * sub + fr) * PROJ_LD + C_U + g * 16 + 8 * fq) : zero8;
#pragma unroll
    for (int sub = 0; sub < 4; ++sub) {
        const size_t r0 = row0 + 16 * sub;
        const bf16x8 Af = Afs[sub];
        f32x4 dd[8];
#pragma unroll
        for (int nb = 0; nb < 8; ++nb) dd[nb] = __builtin_amdgcn_mfma_f32_16x16x32_bf16(Af, Bf[nb], (f32x4){0.f, 0.f, 0.f, 0.f}, 0, 0, 0);
        asm volatile("s_nop 15\n\ts_nop 15" : "+v"(dd[0]), "+v"(dd[1]), "+v"(dd[2]), "+v"(dd[3]), "+v"(dd[4]), "+v"(dd[5]), "+v"(dd[6]), "+v"(dd[7]));
#pragma unroll
        for (int nb = 0; nb < 8; ++nb) {
#pragma unroll
            for (int jj = 0; jj < 4; ++jj) BU[(4 * fq + jj) * 132 + 16 * nb + fr] = dd[nb][jj]; }
        LDS_WAIT();
        volatile LAS bf16* HT = (volatile LAS bf16*)(wl + 8448);
        bf16 uu[4];
        if (FULL) {
#pragma unroll
            for (int jj = 0; jj < 4; ++jj) uu[jj] = PJ[(r0 + 4 * fq + jj) * PROJ_LD + C_U + g * 16 + fr]; }
#pragma unroll
        for (int t = 0; t < 16; ++t) { const float br = BU[t * 132 + lane], bi = BU[t * 132 + 64 + lane];
            const float nr = fmaf(ab[0], hr, fmaf(-ab[1], hi, br)), ni = fmaf(ab[0], hi, fmaf(ab[1], hr, bi)); hr = nr; hi = ni;
            if (FULL) { HT[t * 136 + lane] = f2bf_sw(nr); HT[t * 136 + 64 + lane] = f2bf_sw(ni); } }
        LDS_WAIT();
        if (FULL) {
            bf16x8 hf[4];
#pragma unroll
            for (int ks = 0; ks < 4; ++ks) hf[ks] = *(const LAS bf16x8*)((const LAS bf16*)(wl + 8448) + fr * 136 + 32 * ks + 8 * fq);
            asm volatile("s_waitcnt vmcnt(0) lgkmcnt(0)\n\ts_nop 7" : "+v"(hf[0]), "+v"(hf[1]), "+v"(hf[2]), "+v"(hf[3]));
            f32x4 y = (f32x4){0.f, 0.f, 0.f, 0.f};
#pragma unroll
            for (int ks = 0; ks < 4; ++ks) y = __builtin_amdgcn_mfma_f32_16x16x32_bf16(hf[ks], Cf[ks], y, 0, 0, 0);
            asm volatile("s_nop 15\n\ts_nop 15" : "+v"(y));
            bf16* Z = (bf16*)(F.ws + WS_Z);
#pragma unroll
            for (int jj = 0; jj < 4; ++jj) { const size_t r = r0 + 4 * fq + jj; Z[r * 512 + g * 16 + fr] = f2bf(gelu_tanh(y[jj] + dv * bf2f(uu[jj]))); }
        }
    }
    if (!FULL) { E[j * 128 + lane] = hr; E[j * 128 + 64 + lane] = hi; }
}

DI void lru_gate_task(const Frame& F, const Args& a, int l, int task) {
    const int lane = F.lane, fr = lane & 15, fq = lane >> 4;
    const int b = task >> 9, j = (task >> 3) & 63, hd = task & 7;
    const bf16* PJ = (const bf16*)(F.ws + WS_PROJ);
    const float* cw = INP(a, I_LCONVW) + (size_t)l * 4 * 768; const float* cbias = INP(a, I_LCONVB) + (size_t)l * 768;
    const bf16* waT = (const bf16*)(F.ws + WS_LRUW + (size_t)l * LRUW_STRIDE) + (size_t)hd * 96 * 96; const bf16* wxT = (const bf16*)(F.ws + WS_LRUW + (size_t)l * LRUW_STRIDE + LRUW_X) + (size_t)hd * 96 * 96;
    const size_t rbase = (size_t)b * SEQ + 32 * j;
    bf16x8 X[2][3];
#pragma unroll
    for (int ks = 0; ks < 3; ++ks) {
        const int ch = hd * 96 + 32 * ks + 8 * fq;
        f32x4 w0[4], w1[4];
#pragma unroll
        for (int k = 0; k < 4; ++k) { w0[k] = *(const f32x4*)(cw + k * 768 + ch); w1[k] = *(const f32x4*)(cw + k * 768 + ch + 4); }
        const f32x4 c0 = *(const f32x4*)(cbias + ch), c1 = *(const f32x4*)(cbias + ch + 4);
#pragma unroll
        for (int m = 0; m < 2; ++m) {
            const int ts = 32 * j + 16 * m + fr;
            float xc[8];
#pragma unroll
            for (int e = 0; e < 4; ++e) { xc[e] = c0[e]; xc[4 + e] = c1[e]; }
            u32x4 xt[4];
#pragma unroll
            for (int k = 0; k < 4; ++k) { const int tt = ts - 3 + k; xt[k] = *(const u32x4*)(PJ + ((size_t)b * SEQ + (tt < 0 ? 0 : tt)) * PROJ_LD + C_XL + ch); }
#pragma unroll
            for (int k = 0; k < 4; ++k) { const int tt = ts - 3 + k; const u32x4 z4 = {0u, 0u, 0u, 0u}; const u32x4 xv = tt < 0 ? z4 : xt[k];
                    xc[0] += w0[k][0] * bflo(xv.x); xc[1] += w0[k][1] * bfhi(xv.x); xc[2] += w0[k][2] * bflo(xv.y); xc[3] += w0[k][3] * bfhi(xv.y);
                    xc[4] += w1[k][0] * bflo(xv.z); xc[5] += w1[k][1] * bfhi(xv.z); xc[6] += w1[k][2] * bflo(xv.w); xc[7] += w1[k][3] * bfhi(xv.w); }
            u32x4 pk; pk.x = pk_bf16(xc[0], xc[1]); pk.y = pk_bf16(xc[2], xc[3]); pk.z = pk_bf16(xc[4], xc[5]); pk.w = pk_bf16(xc[6], xc[7]);
            X[m][ks] = __builtin_bit_cast(bf16x8, pk);
        }
        asm volatile("" ::: "memory");
    }
    float* LA = (float*)(F.ws + WS_LRUA); float* LB = (float*)(F.ws + WS_LRUB);
    const float* pba = INP(a, I_LBA) + l * 768; const float* pbx = INP(a, I_LBX) + l * 768; const float* plam = INP(a, I_LLAM) + l * 768;
    for (int nb = 0; nb < 6; ++nb) {
        bf16x8 WA[3], WX[3];
#pragma unroll
        for (int ks = 0; ks < 3; ++ks) { WA[ks] = *(const bf16x8*)(waT + (16 * nb + fr) * 96 + 32 * ks + 8 * fq); WX[ks] = *(const bf16x8*)(wxT + (16 * nb + fr) * 96 + 32 * ks + 8 * fq); }
        const int ch0 = hd * 96 + 16 * nb + 4 * fq;
        const f32x4 ba = *(const f32x4*)(pba + ch0), bx = *(const f32x4*)(pbx + ch0), lam = *(const f32x4*)(plam + ch0);
        const f32x4 cb4 = *(const f32x4*)(cbias + ch0);
        f32x4 cwk[4]; u32x2 xtap[2][4];
#pragma unroll
        for (int k = 0; k < 4; ++k) { cwk[k] = *(const f32x4*)(cw + k * 768 + ch0);
#pragma unroll
            for (int m = 0; m < 2; ++m) { const int tt = 32 * j + 16 * m + fr - 3 + k; xtap[m][k] = *(const u32x2*)(PJ + ((size_t)b * SEQ + (tt < 0 ? 0 : tt)) * PROJ_LD + C_XL + ch0); } }
        asm volatile("" : "+v"(cwk[0]), "+v"(cwk[1]), "+v"(cwk[2]), "+v"(cwk[3]));
        asm volatile("" : "+v"(xtap[0][0]), "+v"(xtap[0][1]), "+v"(xtap[0][2]), "+v"(xtap[0][3]), "+v"(xtap[1][0]), "+v"(xtap[1][1]), "+v"(xtap[1][2]), "+v"(xtap[1][3]));
        f32x4 ls;
#pragma unroll
        for (int e = 0; e < 4; ++e) ls[e] = 8.f * logsigmoid_fast(lam[e]);
#pragma unroll
        for (int m = 0; m < 2; ++m) {
            f32x4 da = (f32x4){0.f, 0.f, 0.f, 0.f}, dx = (f32x4){0.f, 0.f, 0.f, 0.f};
#pragma unroll
            for (int ks = 0; ks < 3; ++ks) { da = __builtin_amdgcn_mfma_f32_16x16x32_bf16(WA[ks], X[m][ks], da, 0, 0, 0); dx = __builtin_amdgcn_mfma_f32_16x16x32_bf16(WX[ks], X[m][ks], dx, 0, 0, 0); }
            asm volatile("s_nop 15\n\ts_nop 15" : "+v"(da), "+v"(dx));
            const int ts = 32 * j + 16 * m + fr;
            f32x4 xc = cb4;
#pragma unroll
            for (int k = 0; k < 4; ++k) { const int tt = ts - 3 + k;
                u32x2 xv = xtap[m][k]; const f32x4 w = cwk[k];
                if (tt < 0) { xv.x = 0u; xv.y = 0u; }
                    xc[0] += w[0] * bflo(xv.x); xc[1] += w[1] * bfhi(xv.x); xc[2] += w[2] * bflo(xv.y); xc[3] += w[3] * bfhi(xv.y); }
            f32x4 av, bv;
#pragma unroll
            for (int e = 0; e < 4; ++e) { const float r = sigmoidf_(da[e] + ba[e]), ig = sigmoidf_(dx[e] + bx[e]); const float la = r * ls[e];
                av[e] = __expf(la); bv[e] = sqrtf(fmaxf(1.f - av[e] * av[e], 0.f)) * ig * xc[e]; }
            const size_t o = (rbase + 16 * m + fr) * 768 + ch0;
            *(f32x4*)(LA + o) = av; *(f32x4*)(LB + o) = bv;
        }
    }
}
DI void lru_scan_task(const Frame& F, int task) {
    const int b = task / 384, rem = task % 384, j = rem / 12, cg = rem % 12;
    float* LA = (float*)(F.ws + WS_LRUA) + ((size_t)b * SEQ + 64 * j) * 768 + 64 * cg + F.lane; float* LB = (float*)(F.ws + WS_LRUB) + ((size_t)b * SEQ + 64 * j) * 768 + 64 * cg + F.lane;
    float h = 0.f, cum = 1.f;
    for (int t0 = 0; t0 < 64; t0 += 32) { float av[32], bv[32];
#pragma unroll
        for (int t = 0; t < 32; ++t) { av[t] = LA[(size_t)(t0 + t) * 768]; bv[t] = LB[(size_t)(t0 + t) * 768]; }
#pragma unroll
        for (int t = 0; t < 32; ++t) { h = fmaf(av[t], h, bv[t]); cum *= av[t]; LB[(size_t)(t0 + t) * 768] = h; LA[(size_t)(t0 + t) * 768] = cum; } }
}
DI void lru_out_task(const Frame& F, const Args& a, int l, int task) {
    const int b = task >> 5, j = task & 31;
    const float* LA = (const float*)(F.ws + WS_LRUA) + (size_t)b * SEQ * 768; const float* LB = (const float*)(F.ws + WS_LRUB) + (size_t)b * SEQ * 768;
    LAS float* HS = (LAS float*)F.lds;
    for (int ch = F.tid; ch < 768; ch += NTHREADS) { float H = 0.f;
        int i = 0;
        for (; i + 8 <= j; i += 8) { float ap[8], e[8];
#pragma unroll
            for (int q = 0; q < 8; ++q) { ap[q] = LA[(size_t)(64 * (i + q) + 63) * 768 + ch]; e[q] = LB[(size_t)(64 * (i + q) + 63) * 768 + ch]; }
#pragma unroll
            for (int q = 0; q < 8; ++q) H = fmaf(ap[q], H, e[q]); }
        for (; i < j; ++i) { const float ap = LA[(size_t)(64 * i + 63) * 768 + ch], e = LB[(size_t)(64 * i + 63) * 768 + ch]; H = fmaf(ap, H, e); }
        HS[ch] = H; }
    __syncthreads();
    const bf16* PJ = (const bf16*)(F.ws + WS_PROJ); bf16* MIX = (bf16*)(F.ws + WS_MIX);
    const float* ng = INP(a, I_LNG) + l * 768;
    const f32x4 g4r[3] = {*(const f32x4*)(ng + 4 * F.lane), *(const f32x4*)(ng + 4 * F.lane + 256), *(const f32x4*)(ng + 4 * F.lane + 512)};
    for (int rr0 = F.wave; rr0 < 64; rr0 += 2 * NWAVES) {
      f32x4 hl2[2][3], ca2[2][3]; u32x2 gv2[2][3];
#pragma unroll
      for (int u = 0; u < 2; ++u) { const size_t t = 64 * j + rr0 + NWAVES * u, row = (size_t)b * SEQ + t;
#pragma unroll
          for (int q = 0; q < 3; ++q) { const int ch = 4 * F.lane + 256 * q; hl2[u][q] = *(const f32x4*)(LB + t * 768 + ch); ca2[u][q] = *(const f32x4*)(LA + t * 768 + ch); gv2[u][q] = *(const u32x2*)(PJ + row * PROJ_LD + C_GL + ch); } }
#pragma unroll
      for (int u = 0; u < 2; ++u) {
        const size_t t = 64 * j + rr0 + NWAVES * u, row = (size_t)b * SEQ + t;
        f32x4 v[3]; float ss = 0.f;
#pragma unroll
        for (int q = 0; q < 3; ++q) { const int ch = 4 * F.lane + 256 * q;
            const f32x4 hl = hl2[u][q], ca = ca2[u][q], hs = *(const LAS f32x4*)(HS + ch);
            const u32x2 gv = gv2[u][q];
            const float gg[4] = {bflo(gv.x), bfhi(gv.x), bflo(gv.y), bfhi(gv.y)};
#pragma unroll
            for (int e = 0; e < 4; ++e) { const float h = fmaf(ca[e], hs[e], hl[e]); v[q][e] = h * gelu_tanh(gg[e]); ss += v[q][e] * v[q][e]; } }
        const float rstd = rsqrtf(wave_sum(ss) * (1.f / 768.f) + EPS);
#pragma unroll
        for (int q = 0; q < 3; ++q) { const int ch = 4 * F.lane + 256 * q; const f32x4 o = v[q] * rstd * g4r[q];
            u32x2 w; w.x = pk_bf16(o[0], o[1]); w.y = pk_bf16(o[2], o[3]); *(u32x2*)(MIX + row * DM + 512 + ch) = w; }
      }
    }
    __syncthreads();
}

constexpr int GL_BC = 0, GL_WG = 24832, GL_K = 31488, GL_V = 57600;
constexpr int GB_Q = 31488, GB_K = 57600, GB_V = 83712;
DI void gla_bcum(const Frame& F, const Args& a, int l, int hd, size_t r0, LAS float* bc, LAS float* wg) {
    const bf16* PJ = (const bf16*)(F.ws + WS_PROJ);
    { const float* pg = INP(a, I_GWG2) + (size_t)l * 16 * 384 + hd * 96; float w3[3];
#pragma unroll
      for (int q = 0; q < 3; ++q) { const int i = F.tid + NTHREADS * q; w3[q] = pg[(i / 96) * 384 + i % 96]; }
#pragma unroll
      for (int q = 0; q < 3; ++q) wg[F.tid + NTHREADS * q] = w3[q]; }
    if (F.tid < 96) wg[1536 + F.tid] = INP(a, I_GBG2)[l * 384 + hd * 96 + F.tid];
    __syncthreads();
    { const int t = F.tid >> 3, dg = F.tid & 7;
      const u32x4 g0 = *(const u32x4*)(PJ + (r0 + t) * PROJ_LD + C_GLOW), g1 = *(const u32x4*)(PJ + (r0 + t) * PROJ_LD + C_GLOW + 8);
      const float gl[16] = {bflo(g0.x), bfhi(g0.x), bflo(g0.y), bfhi(g0.y), bflo(g0.z), bfhi(g0.z), bflo(g0.w), bfhi(g0.w), bflo(g1.x), bfhi(g1.x), bflo(g1.y), bfhi(g1.y), bflo(g1.z), bfhi(g1.z), bflo(g1.w), bfhi(g1.w)};
#pragma unroll
      for (int q = 0; q < 12; ++q) { const int d = dg + 8 * q; float acc = wg[1536 + d];
#pragma unroll
          for (int r = 0; r < 16; ++r) acc = fmaf(gl[r], wg[r * 96 + d], acc);
          bc[t * 97 + d] = logsigmoid_fast(acc) * (1.f / 16.f); } }
    __syncthreads();
    { const int d = F.tid % 96, seg = F.tid / 96; float v[16]; float s_ = 0.f;
      if (F.tid < 384) {
#pragma unroll
          for (int t = 0; t < 16; ++t) { s_ += bc[(16 * seg + t) * 97 + d]; v[t] = s_; }
          wg[1632 + seg * 96 + d] = s_; }
      __syncthreads();
      if (F.tid < 384) { float pre = 0.f;
#pragma unroll
          for (int q = 0; q < 3; ++q) pre += (q < seg) ? wg[1632 + q * 96 + d] : 0.f;
#pragma unroll
          for (int t = 0; t < 16; ++t) bc[(16 * seg + t) * 97 + d] = v[t] + pre; } }
    __syncthreads();
}
constexpr int G2_QD = 31488, G2_KI = 44800, G2_VT = 58112, G2_KO = 85760, G2_AT = 85760, G2_RED = 99584;
DI bf16x8 ldfrag(const LAS bf16* tile, int ST, int r0, int k0, int fr, int fq) { return *(const LAS bf16x8*)(tile + (r0 + fr) * ST + k0 + 8 * fq); }
#define MFMA_GUARD_IN4(a, b, c, d)  asm volatile("s_waitcnt vmcnt(0) lgkmcnt(0)\n\ts_nop 7" : "+v"(a), "+v"(b), "+v"(c), "+v"(d))
#define MFMA_GUARD_OUT(x)           asm volatile("s_nop 15\n\ts_nop 15" : "+v"(x))
DI void gla_stage_vt(const Frame& F, size_t r0, int hd, LAS bf16* VT) {
    const bf16* PJ = (const bf16*)(F.ws + WS_PROJ);
    u32x4 v3[3];
#pragma unroll
    for (int q = 0; q < 3; ++q) { const int it = F.tid + NTHREADS * q, t = it & 63, vc = it >> 6; v3[q] = *(const u32x4*)(PJ + (r0 + t) * PROJ_LD + C_V + hd * 192 + 8 * vc); }
#pragma unroll
    for (int q = 0; q < 3; ++q) { const int it = F.tid + NTHREADS * q, t = it & 63, vc = it >> 6;
        const u32x4 vv = v3[q];
        LAS bf16* p = VT + (8 * vc) * 72 + t;
        p[0 * 72] = (bf16)(vv.x & 0xffffu); p[1 * 72] = (bf16)(vv.x >> 16); p[2 * 72] = (bf16)(vv.y & 0xffffu); p[3 * 72] = (bf16)(vv.y >> 16);
        p[4 * 72] = (bf16)(vv.z & 0xffffu); p[5 * 72] = (bf16)(vv.z >> 16); p[6 * 72] = (bf16)(vv.w & 0xffffu); p[7 * 72] = (bf16)(vv.w >> 16);
        LDS_WAIT(); }
}
DI void gla_a_task(const Frame& F, const Args& a, int l, int unit) {
    const int bh = unit >> 5, n = unit & 31, b = bh >> 2, hd = bh & 3;
    const size_t r0 = (size_t)b * SEQ + 64 * n;
    LAS float* bc = (LAS float*)(F.lds + GL_BC); LAS float* wg = (LAS float*)(F.lds + GL_WG);
    LAS bf16* VT = (LAS bf16*)(F.lds + G2_VT); LAS bf16* KO = (LAS bf16*)(F.lds + G2_KO);
    const bf16* PJ = (const bf16*)(F.ws + WS_PROJ);
    gla_bcum(F, a, l, hd, r0, bc, wg);
    { float* G = (float*)(F.ws + WS_GLABC) + (size_t)unit * 6144;
      for (int i = F.tid; i < 6144; i += NTHREADS) G[i] = bc[(i / 96) * 97 + i % 96]; }
    u32x4 k2[2];
#pragma unroll
    for (int q = 0; q < 2; ++q) { const int it = F.tid + NTHREADS * q, t = it & 63, dc = (it >> 6) % 12; k2[q] = *(const u32x4*)(PJ + (r0 + t) * PROJ_LD + C_K + hd * 96 + 8 * dc); }
#pragma unroll
    for (int q = 0; q < 2; ++q) { const int it = F.tid + NTHREADS * q, t = it & 63, dc = it >> 6;
        if (it < 64 * 12) { const u32x4 kv = k2[q];
        const float kk[8] = {bflo(kv.x), bfhi(kv.x), bflo(kv.y), bfhi(kv.y), bflo(kv.z), bfhi(kv.z), bflo(kv.w), bfhi(kv.w)};
#pragma unroll
        for (int e = 0; e < 8; ++e) { const int d = 8 * dc + e; KO[d * 72 + t] = f2bf_sw(kk[e] * __expf(bc[63 * 97 + d] - bc[t * 97 + d])); } } }
    gla_stage_vt(F, r0, hd, VT);
    __syncthreads();
    const int fr = F.lane & 15, fq = F.lane >> 4;
    float* DT = (float*)(F.ws + WS_GLAD) + (size_t)unit * 96 * 192;
    for (int q = 0; q < 9; ++q) { const int idx = F.wave * 9 + q, mb = idx / 6, nb = idx - 6 * mb;
        bf16x8 a0 = ldfrag(VT, 72, 16 * mb, 0, fr, fq), a1 = ldfrag(VT, 72, 16 * mb, 32, fr, fq), b0 = ldfrag(KO, 72, 16 * nb, 0, fr, fq), b1 = ldfrag(KO, 72, 16 * nb, 32, fr, fq);
        MFMA_GUARD_IN4(a0, a1, b0, b1);
        f32x4 d = __builtin_amdgcn_mfma_f32_16x16x32_bf16(a0, b0, (f32x4){0.f, 0.f, 0.f, 0.f}, 0, 0, 0);
        d = __builtin_amdgcn_mfma_f32_16x16x32_bf16(a1, b1, d, 0, 0, 0);
        MFMA_GUARD_OUT(d);
#pragma unroll
        for (int jj = 0; jj < 4; ++jj) DT[(16 * mb + 4 * fq + jj) * 96 + 16 * nb + fr] = d[jj]; }
    if (F.tid < 96) ((float*)(F.ws + WS_GAMMA))[(size_t)unit * 96 + F.tid] = __expf(bc[63 * 97 + F.tid]);
    __syncthreads();
}
DI void gla_scan_phase(const Frame& F) {
    const float* DL = (const float*)(F.ws + WS_GLAD); const float* GM = (const float*)(F.ws + WS_GAMMA); bf16* ST = (bf16*)(F.ws + WS_GLAS);
    for (int idx = F.bid * NTHREADS + F.tid; idx < 16 * 18432; idx += F.G * NTHREADS) {
        const int bh = idx / 18432, e = idx - bh * 18432, d = e % 96;
        const float* p = DL + (size_t)bh * 32 * 18432 + e; const float* gp = GM + (size_t)bh * 32 * 96 + d; bf16* sp = ST + (size_t)bh * 32 * 18432 + e;
        float S = 0.f; float dl[32], gm[32];
#pragma unroll
        for (int n = 0; n < 32; ++n) { dl[n] = p[(size_t)n * 18432]; gm[n] = gp[n * 96]; }
#pragma unroll
        for (int n = 0; n < 32; ++n) { sp[(size_t)n * 18432] = f2bf_sw(S); S = fmaf(gm[n], S, dl[n]); }
    }
}
DI void gla_b_task(const Frame& F, const Args& a, int l, int unit) {
    const int bh = unit >> 5, n = unit & 31, b = bh >> 2, hd = bh & 3;
    const size_t r0 = (size_t)b * SEQ + 64 * n;
    LAS float* bc = (LAS float*)(F.lds + GL_BC); LAS float* wg = (LAS float*)(F.lds + GL_WG);
    LAS bf16* QD = (LAS bf16*)(F.lds + G2_QD); LAS bf16* KI = (LAS bf16*)(F.lds + G2_KI); LAS bf16* VT = (LAS bf16*)(F.lds + G2_VT); LAS bf16* AT = (LAS bf16*)(F.lds + G2_AT);
    LAS float* red = (LAS float*)(F.lds + G2_RED);
    const bf16* PJ = (const bf16*)(F.ws + WS_PROJ);
    { const float* G = (const float*)(F.ws + WS_GLABC) + (size_t)unit * 6144;
      float g12[12];
#pragma unroll
      for (int q = 0; q < 12; ++q) g12[q] = G[F.tid + NTHREADS * q];
      asm volatile("" : "+v"(g12[0]), "+v"(g12[1]), "+v"(g12[2]), "+v"(g12[3]), "+v"(g12[4]), "+v"(g12[5]), "+v"(g12[6]), "+v"(g12[7]), "+v"(g12[8]), "+v"(g12[9]), "+v"(g12[10]), "+v"(g12[11]));
#pragma unroll
      for (int q = 0; q < 12; ++q) { const int i = F.tid + NTHREADS * q; bc[(i / 96) * 97 + i % 96] = g12[q]; } }
    __syncthreads();
    const float qscale = 0.10206207261596575f;
    u32x4 q2[2], k2[2];
#pragma unroll
    for (int q = 0; q < 2; ++q) { const int it = F.tid + NTHREADS * q, t = it & 63, dc = (it >> 6) % 12;
        q2[q] = *(const u32x4*)(PJ + (r0 + t) * PROJ_LD + C_Q + hd * 96 + 8 * dc); k2[q] = *(const u32x4*)(PJ + (r0 + t) * PROJ_LD + C_K + hd * 96 + 8 * dc); }
    asm volatile("" : "+v"(q2[0]), "+v"(q2[1]), "+v"(k2[0]), "+v"(k2[1]));
#pragma unroll
    for (int q = 0; q < 2; ++q) { const int it = F.tid + NTHREADS * q, t = it & 63, dc = it >> 6;
        if (it < 64 * 12) {
        const u32x4 qv = q2[q], kv = k2[q];
        const float qq[8] = {bflo(qv.x), bfhi(qv.x), bflo(qv.y), bfhi(qv.y), bflo(qv.z), bfhi(qv.z), bflo(qv.w), bfhi(qv.w)};
        const float kk[8] = {bflo(kv.x), bfhi(kv.x), bflo(kv.y), bfhi(kv.y), bflo(kv.z), bfhi(kv.z), bflo(kv.w), bfhi(kv.w)};
        float qo[8], ko[8];
#pragma unroll
        for (int e = 0; e < 8; ++e) { const float bcv = bc[t * 97 + 8 * dc + e]; qo[e] = qq[e] * qscale * __expf(bcv); ko[e] = kk[e] * __expf(-bcv); }
        u32x4 qp, kp; qp.x = pk_bf16(qo[0], qo[1]); qp.y = pk_bf16(qo[2], qo[3]); qp.z = pk_bf16(qo[4], qo[5]); qp.w = pk_bf16(qo[6], qo[7]);
        kp.x = pk_bf16(ko[0], ko[1]); kp.y = pk_bf16(ko[2], ko[3]); kp.z = pk_bf16(ko[4], ko[5]); kp.w = pk_bf16(ko[6], ko[7]);
        *(LAS u32x4*)(QD + t * 104 + 8 * dc) = qp; *(LAS u32x4*)(KI + t * 104 + 8 * dc) = kp; } }
    gla_stage_vt(F, r0, hd, VT);
    __syncthreads();
    const int fr = F.lane & 15, fq = F.lane >> 4;
    { const int mb = F.wave >> 1;
      bf16x8 qa0 = ldfrag(QD, 104, 16 * mb, 0, fr, fq), qa1 = ldfrag(QD, 104, 16 * mb, 32, fr, fq), qa2 = ldfrag(QD, 104, 16 * mb, 64, fr, fq);
#pragma unroll
      for (int h = 0; h < 2; ++h) { const int nb = 2 * (F.wave & 1) + h;
          bf16x8 k0 = ldfrag(KI, 104, 16 * nb, 0, fr, fq), k1 = ldfrag(KI, 104, 16 * nb, 32, fr, fq), k2 = ldfrag(KI, 104, 16 * nb, 64, fr, fq);
          MFMA_GUARD_IN4(k0, k1, k2, qa0); asm volatile("" : "+v"(qa1), "+v"(qa2));
          f32x4 d = __builtin_amdgcn_mfma_f32_16x16x32_bf16(qa0, k0, (f32x4){0.f, 0.f, 0.f, 0.f}, 0, 0, 0);
          d = __builtin_amdgcn_mfma_f32_16x16x32_bf16(qa1, k1, d, 0, 0, 0);
          d = __builtin_amdgcn_mfma_f32_16x16x32_bf16(qa2, k2, d, 0, 0, 0);
          MFMA_GUARD_OUT(d);
#pragma unroll
          for (int jj = 0; jj < 4; ++jj) { const int i = 16 * mb + 4 * fq + jj, jc = 16 * nb + fr; AT[i * 72 + jc] = f2bf_sw(jc <= i ? d[jj] : 0.f); } } }
    __syncthreads();
    const int mb = F.wave & 3, nb0 = 6 * (F.wave >> 2);
    const bf16* SG = (const bf16*)(F.ws + WS_GLAS) + (size_t)unit * 18432;
    bf16x8 at0 = ldfrag(AT, 72, 16 * mb, 0, fr, fq), at1 = ldfrag(AT, 72, 16 * mb, 32, fr, fq);
    bf16x8 qa0 = ldfrag(QD, 104, 16 * mb, 0, fr, fq), qa1 = ldfrag(QD, 104, 16 * mb, 32, fr, fq), qa2 = ldfrag(QD, 104, 16 * mb, 64, fr, fq);
    f32x4 o[6];
    bf16x8 vf[6][2], sf[6][3];
#pragma unroll
    for (int q = 0; q < 6; ++q) { const int nb = nb0 + q; const bf16* sp = SG + (16 * nb + fr) * 96 + 8 * fq;
        sf[q][0] = *(const bf16x8*)(sp); sf[q][1] = *(const bf16x8*)(sp + 32); sf[q][2] = *(const bf16x8*)(sp + 64);
        vf[q][0] = ldfrag(VT, 72, 16 * nb, 0, fr, fq); vf[q][1] = ldfrag(VT, 72, 16 * nb, 32, fr, fq); }
    asm volatile("s_waitcnt vmcnt(0) lgkmcnt(0)\n\ts_nop 7" : "+v"(at0), "+v"(at1), "+v"(qa0), "+v"(qa1), "+v"(qa2));
#pragma unroll
    for (int q = 0; q < 6; ++q) {
        asm volatile("" : "+v"(vf[q][0]), "+v"(vf[q][1]), "+v"(sf[q][0]), "+v"(sf[q][1]), "+v"(sf[q][2]));
        f32x4 d = __builtin_amdgcn_mfma_f32_16x16x32_bf16(at0, vf[q][0], (f32x4){0.f, 0.f, 0.f, 0.f}, 0, 0, 0);
        d = __builtin_amdgcn_mfma_f32_16x16x32_bf16(at1, vf[q][1], d, 0, 0, 0);
        d = __builtin_amdgcn_mfma_f32_16x16x32_bf16(qa0, sf[q][0], d, 0, 0, 0);
        d = __builtin_amdgcn_mfma_f32_16x16x32_bf16(qa1, sf[q][1], d, 0, 0, 0);
        d = __builtin_amdgcn_mfma_f32_16x16x32_bf16(qa2, sf[q][2], d, 0, 0, 0);
        o[q] = d; }
    asm volatile("s_nop 15\n\ts_nop 15" : "+v"(o[0]), "+v"(o[1]), "+v"(o[2]), "+v"(o[3]), "+v"(o[4]), "+v"(o[5]));
    float ss[4];
#pragma unroll
    for (int jj = 0; jj < 4; ++jj) { float s_ = 0.f;
#pragma unroll
        for (int q = 0; q < 6; ++q) s_ += o[q][jj] * o[q][jj];
        s_ = xor_add<1>(s_); s_ = xor_add<2>(s_); s_ = xor_add<4>(s_); s_ = xor_add<8>(s_); ss[jj] = s_; }
    if (fr == 0) {
#pragma unroll
        for (int jj = 0; jj < 4; ++jj) red[(F.wave >> 2) * 64 + 16 * mb + 4 * fq + jj] = ss[jj]; }
    __syncthreads();
    bf16* MIX = (bf16*)(F.ws + WS_MIX);
    const float* hg = INP(a, I_GHG) + l * 192;
#pragma unroll
    for (int jj = 0; jj < 4; ++jj) { const int i = 16 * mb + 4 * fq + jj; const float rstd = rsqrtf((red[i] + red[64 + i]) * (1.f / 192.f) + EPS);
        const size_t row = r0 + i;
#pragma unroll
        for (int q = 0; q < 6; ++q) { const int v = 16 * (nb0 + q) + fr; const float og = bf2f(PJ[row * PROJ_LD + C_OG + hd * 192 + v]);
            MIX[row * DM + 1280 + hd * 192 + v] = f2bf(o[q][jj] * rstd * hg[v] * siluf_(og)); } }
    __syncthreads();
}

#ifdef DBG_HASH
constexpr int CW_HASH = 1024;
struct HashJob { int after_ph; size_t off; size_t bytes; };
__device__ __forceinline__ void hash_phase(const Frame& F, size_t off, size_t bytes, int slot) {
    const unsigned* w = (const unsigned*)(F.ws + off); const size_t n = bytes / 4;
    unsigned acc = 0u;
    for (size_t i = (size_t)F.bid * NTHREADS + F.tid; i < n; i += (size_t)F.G * NTHREADS) acc += w[i] * (unsigned)(2u * (unsigned)i + 1u);
#pragma unroll
    for (int o = 1; o < 64; o <<= 1) acc += __shfl_xor(acc, o);
    if (F.lane == 0) __hip_atomic_fetch_add(F.ctl + CW_HASH + slot * 64, acc, __ATOMIC_RELAXED, __HIP_MEMORY_SCOPE_AGENT);
}
__device__ __forceinline__ void emit_phase(const Frame& F, float* out) {
    const size_t total = (size_t)T * DM, seg = total / 16;
    for (size_t i = (size_t)F.bid * NTHREADS + F.tid; i < total; i += (size_t)F.G * NTHREADS) {
        const int k = (int)(i / seg); const unsigned h = __hip_atomic_load(F.ctl + CW_HASH + k * 64, __ATOMIC_RELAXED, __HIP_MEMORY_SCOPE_AGENT);
        const float amp = __builtin_ldexpf(1.f, -k);
        out[i] = amp * (float)((h >> (unsigned)(i & 31)) & 1u);
    }
}
#endif
#ifndef LB_W
#define LB_W 2
#endif
__global__ void __launch_bounds__(NTHREADS, LB_W) mega_fwd(Args args) {
    extern __shared__ __attribute__((aligned(16))) unsigned char lds_raw[];
    Frame F;
    F.lds = (LAS unsigned char*)lds_raw;
    F.MISC = (volatile LAS unsigned*)(F.lds + LDSCTL_OFF);
    F.wave = __builtin_amdgcn_readfirstlane((int)threadIdx.x >> 6); F.lane = lane_id(); F.tid = F.wave * 64 + F.lane;
    F.G = gridDim.x; F.bid = blockIdx.x;
    F.ws = (GAS unsigned char*)args.ws; F.ctl = (unsigned*)(F.ws + WS_CTL);
#ifdef DBG_POISON
    for (int u = F.tid; u < SCR_BYTES / 4; u += NTHREADS) ((LAS unsigned*)F.lds)[u] = 0xFFFFFFFFu;
#endif
    for (int u = F.tid; u < (LDS_BYTES - LDSCTL_OFF) / 4; u += NTHREADS) ((LAS unsigned*)(F.lds + LDSCTL_OFF))[u] = 0u;
    __syncthreads();
    XcdBarrier bar = xcd_barrier_post(F.ctl + CW_BAR + args.li * XCD_BAR_WORDS, F.MISC + 8, F.wave);
    const int lo = args.ph_lo, hi = args.ph_hi;
#ifdef DBG_HASH
    if (lo >= 200) { emit_phase(F, args.out); return; }
    if (lo >= 100) { hash_phase(F, (size_t)args.hoff, (size_t)args.hbytes, lo - 100); return; }
#endif
#ifndef PHMASK
#define PHMASK 0xFFFF
#endif
#define PH(k, id) if (((PHMASK >> (k)) & 1) && (id) >= lo && (id) < hi)
#define REFRESH() do { int lz_ = lane_id(); asm volatile("" : "+v"(lz_)); F.lane = lz_; F.tid = F.wave * 64 + lz_; asm volatile("" : "+s"(F.ws)); } while (0)
#define SEAM(id) do { if ((id) > lo) xcd_barrier(bar); REFRESH(); } while (0)
    const float* MOD = (const float*)(F.ws + WS_MOD);

    PH(0, 0) { p0_s5_consts(F, args); p0_lru_w(F, args); p0_ada(F, args); p0_convert(F, args); }

    for (int l = 0; l < DEPTH; ++l) {
        const int pb = 1 + 12 * l;
        const float* mod = MOD + (size_t)l * 4 * (NADA * DM);
        const float* xin = (l == 0) ? INP(args, I_X) : (const float*)(F.ws + WS_XCUR);
        PH(1, pb + 0) { SEAM(pb + 0); norm_phase<false, false>(F, args, xin, INP(args, I_NMIXG) + l * DM, mod, 0, 1, nullptr); }
        PH(2, pb + 1) { SEAM(pb + 1);
            pg8::Gemm g{(const bf16*)(F.ws + WS_H), (const bf16*)(F.ws + WS_WIN) + (size_t)l * PROJ_LD * DM, DM}; pg8::StaticOrder S; S.init(T, PROJ_LD, F.G, F.bid);
            pg8::EpiBf16Perm E{(bf16*)(F.ws + WS_PROJ), PROJ_LD};
            pg8::gemm_phase(F.lds, g, S, E, F.wave); }
        PH(3, pb + 2) { SEAM(pb + 2);
#ifndef M1_NO_GLA
            for (int u = F.bid; u < 512; u += F.G) gla_a_task(F, args, l, u);
#endif
            __syncthreads();
#ifndef M1_NO_S5
            for (int bt = F.bid; bt < 512; bt += F.G) s5_task<false>(F, args, l, ((bt >> 7) << 10) | ((8 * (bt & 3) + F.wave) << 5) | ((bt >> 2) & 31), F.lds + F.wave * 16384);
#endif
#ifndef M1_NO_LRU
            for (int t = F.bid * NWAVES + F.wave; t < 2048; t += F.G * NWAVES) lru_gate_task(F, args, l, t);
#endif
 }
        PH(4, pb + 3) { SEAM(pb + 3);
            for (int bt = F.bid; bt < 512; bt += F.G) s5_task<true>(F, args, l, ((bt >> 7) << 10) | ((8 * (bt & 3) + F.wave) << 5) | ((bt >> 2) & 31), F.lds + F.wave * 16384);
            for (int t = F.bid * NWAVES + F.wave; t < 1536; t += F.G * NWAVES) lru_scan_task(F, t);
            gla_scan_phase(F); }
        PH(5, pb + 4) { SEAM(pb + 4);
            { pg8::Gemm g{(const bf16*)(F.ws + WS_Z), (const bf16*)(F.ws + WS_WGLU) + (size_t)l * 1024 * 512, 512}; pg8::StaticOrder S; S.init(T, 1024, F.G, F.bid);
              pg8::EpiGlu E{(float*)(F.ws + WS_S5PRE), INP(args, I_S5BGLU) + l * 1024};
              pg8::gemm_phase(F.lds, g, S, E, F.wave); }
            REFRESH();
            __syncthreads();
#ifndef T_NO_A
            for (int u = (F.bid + 128 >= F.G) ? F.bid + 128 - F.G : F.bid + 128; u < 128; u += F.G) lru_out_task(F, args, l, u);
#endif
#ifndef T_NO_B
            for (int u = F.bid; u < 512; u += F.G) gla_b_task(F, args, l, u);
#endif
 }
        PH(6, pb + 5) { SEAM(pb + 5); s5norm_phase(F, INP(args, I_S5NG) + l * 512); }
        PH(7, pb + 6) { SEAM(pb + 6);
            pg8::Gemm g{(const bf16*)(F.ws + WS_MIX), (const bf16*)(F.ws + WS_WOUT) + (size_t)l * DM * DM, DM}; pg8::StaticOrder S; S.init(T, DM, F.G, F.bid);
            pg8::EpiResid E{(float*)(F.ws + WS_X1), xin, mod + 2 * DM, 1.f};
            pg8::gemm_phase(F.lds, g, S, E, F.wave); }
        PH(8, pb + 7) { SEAM(pb + 7);
            if (l & 1) norm_phase<true, true>(F, args, (const float*)(F.ws + WS_X1), INP(args, I_NFFNG) + l * DM, mod, 3, 4, INP(args, I_ROUTER) + (size_t)(l >> 1) * DM * NE);
            else norm_phase<false, false>(F, args, (const float*)(F.ws + WS_X1), INP(args, I_NFFNG) + l * DM, mod, 3, 4, nullptr); }
        const bool moe = (l & 1) != 0;
        if (moe) { PH(9, pb + 8) { SEAM(pb + 8); moe_sort_phase(F); } }
        if (moe) {
            PH(10, pb + 9) { SEAM(pb + 9); moe_tiles(F);
                pg8::Gemm g{(const bf16*)(F.ws + WS_AS), (const bf16*)(F.ws + WS_M13), DM / 2}; pg8::GroupedOrder S; S.init(F.MISC + 16, 2 * DFFE, F.G, F.bid, (long)2 * DFFE * DM);
                pg8::EpiSwiglu8 E{(unsigned char*)(F.ws + WS_HID), DFFE, 1.f / (SC_X * SC_W13), SC_H};
                pg8::gemm_phase8(F.lds, g, S, E, F.wave); }
            PH(11, pb + 10) { SEAM(pb + 10); moe_tiles(F);
                pg8::Gemm g{(const bf16*)(F.ws + WS_HID), (const bf16*)(F.ws + WS_M2), DFFE / 2}; pg8::GroupedOrder S; S.init(F.MISC + 16, DM, F.G, F.bid, (long)DM * DFFE, 2 * F.G);
                pg8::EpiF32 E{(float*)(F.ws + WS_Y), DM, 1.f / (SC_H * SC_W2)};
                pg8::gemm_phase8(F.lds, g, S, E, F.wave);
                pg8::TailOrder ST; ST.init(F.MISC + 16, DM, 2 * F.G, F.G, F.bid, (long)DM * DFFE, (long)64 * DFFE);
                pg8::EpiF32Narrow EN{(float*)(F.ws + WS_Y), DM, 1.f / (SC_H * SC_W2)};
                pg8::gemm_phase8<true>(F.lds, g, ST, EN, F.wave); }
        } else {
            PH(10, pb + 9) { SEAM(pb + 9);
                pg8::Gemm g{(const bf16*)(F.ws + WS_H), (const bf16*)(F.ws + WS_F13), DM}; pg8::StaticOrder S; S.init(T, 2 * DFF, F.G, F.bid);
                pg8::EpiSwiglu8 E{(unsigned char*)(F.ws + WS_HID), DFF, 1.f, SC_H};
                pg8::gemm_phase(F.lds, g, S, E, F.wave); }
            PH(11, pb + 10) { SEAM(pb + 10);
                pg8::Gemm g{(const bf16*)(F.ws + WS_HID), (const bf16*)(F.ws + WS_F2), DFF / 2}; pg8::StaticOrder S; S.init(T, DM, F.G, F.bid);
                pg8::EpiResid E{(float*)(F.ws + WS_XCUR), (const float*)(F.ws + WS_X1), mod + 5 * DM, 1.f / (SC_H * SC_W2)};
                pg8::gemm_phase8(F.lds, g, S, E, F.wave); }
        }
        if (moe) { PH(12, pb + 11) { SEAM(pb + 11); final_phase(F, args, mod); } }
    }
#undef PH
#undef SEAM
}

extern "C" void kernel_launch(void* const* d_in, const int* in_sizes, int n_in, void* d_out, int out_size, void* d_ws, size_t ws_size, hipStream_t stream) {
    static int grid = 0;
    if (grid == 0) {
        if (n_in != 38 || out_size != T * DM || ws_size < WS_END) { fprintf(stderr, "kernel_launch: unexpected shapes (n_in %d out %d ws %zu)\n", n_in, out_size, ws_size); grid = -1; return; }
        int dev = 0, cus = 0, per_cu = 0;
        if (hipGetDevice(&dev) != hipSuccess || hipDeviceGetAttribute(&cus, hipDeviceAttributeMultiprocessorCount, dev) != hipSuccess) { grid = -1; return; }
        if (hipFuncSetAttribute((const void*)mega_fwd, hipFuncAttributeMaxDynamicSharedMemorySize, LDS_BYTES) != hipSuccess) { fprintf(stderr, "kernel_launch: hipFuncSetAttribute failed\n"); grid = -1; return; }
        if (hipOccupancyMaxActiveBlocksPerMultiprocessor(&per_cu, (const void*)mega_fwd, NTHREADS, LDS_BYTES) != hipSuccess || per_cu < 1) { fprintf(stderr, "kernel_launch: occupancy query says %d\n", per_cu); }
        (void)hipGetLastError();
        grid = cus;
    }
    if (grid < 0) return;
    (void)hipMemsetAsync((char*)d_ws + WS_CTL, 0, CTL_BYTES, stream);
#ifdef DBG_POISON
    (void)hipMemsetAsync((char*)d_ws + CTL_BYTES, 0xFF, WS_END - CTL_BYTES, stream);
#endif
    Args a{};
    for (int i = 0; i < 38; ++i) a.in[i] = (const float*)d_in[i];
    a.out = (float*)d_out; a.ws = (unsigned char*)d_ws; a.pad = 0; a.hoff = 0; a.hbytes = 0;
    constexpr int NPH = 1 + 12 * DEPTH;
#if N_LAUNCH_MODE == 0
    a.ph_lo = 0; a.ph_hi = NPH; a.li = 0;
    hipLaunchKernelGGL(mega_fwd, dim3(grid), dim3(NTHREADS), LDS_BYTES, stream, a);
#else
    int li = 0;
    for (int ph = 0; ph < NPH; ++ph) {
        const int l = (ph - 1) / 12, k = (ph - 1) % 12;
        if (ph > 0) { if ((l & 1) == 0 && (k == 8 || k == 11)) continue; }
        a.ph_lo = ph; a.ph_hi = ph + 1; a.li = li++;
        hipLaunchKernelGGL(mega_fwd, dim3(grid), dim3(NTHREADS), LDS_BYTES, stream, a);
#ifdef DBG_HASH
        {
            static const HashJob jobs[16] = {
                {0, 1 * MiB, 3 * MiB}, {0, WS_WIN, WS_H - WS_WIN},
                {1, WS_H, 32 * MiB}, {2, WS_PROJ, 72 * MiB}, {3, WS_S5E, 2 * MiB}, {3, WS_LRUA, 84 * MiB},
                {4, WS_Z, 8 * MiB}, {4, WS_LRUA, 48 * MiB}, {4, WS_GLAD, 36 * MiB},
                {5, WS_S5PRE, 16 * MiB}, {5, WS_MIX, 32 * MiB}, {6, WS_MIX, 32 * MiB}, {7, WS_X1, 64 * MiB}, {8, WS_H, 32 * MiB}, {10, WS_HID, (size_t)T * DFF * 2}, {11, WS_XCUR, 64 * MiB} };
            for (int k = 0; k < 16; ++k) if (jobs[k].after_ph == ph) { Args h = a; h.ph_lo = 100 + k; h.ph_hi = 101 + k; h.hoff = jobs[k].off; h.hbytes = jobs[k].bytes; hipLaunchKernelGGL(mega_fwd, dim3(grid), dim3(NTHREADS), LDS_BYTES, stream, h); }
        }
#endif
    }
#ifdef DBG_HASH
    { Args h = a; h.ph_lo = 200; h.ph_hi = 201; hipLaunchKernelGGL(mega_fwd, dim3(grid), dim3(NTHREADS), LDS_BYTES, stream, h); }
#endif
#endif
}
```
